# Optimizing an MI355X kernel written in HIP

```python
import jax, jax.numpy as jnp
from jax import lax
import numpy as np

D_MODEL = 4096
BATCH = 2
SEQ = 4096
DEPTH = 2

HEAD_DIM = 128
NSA_HEADS = (D_MODEL // 2) // HEAD_DIM
NSA_KV_HEADS = 4
NSA_HPG = NSA_HEADS // NSA_KV_HEADS
NSA_WIDTH = NSA_HEADS * HEAD_DIM
KV_WIDTH = NSA_KV_HEADS * HEAD_DIM
CMP_STRIDE = 16
CMP_BLOCK = 2 * CMP_STRIDE
CMP_HIDDEN = 256
SLC_BLOCK = 64
SLC_TOPK = 16
WINDOW = 512
N_GATES = 3 * NSA_HEADS
ATTN_SCALE = HEAD_DIM ** -0.5
ROPE_THETA = 500000.0
ROPE_DIM = HEAD_DIM // 4
POOL_WIDTH = D_MODEL - NSA_WIDTH
POOL_WINDOWS = (2, 4, 8, 16)
POOL_GROUP = POOL_WIDTH // len(POOL_WINDOWS)
IN_EVEN = NSA_WIDTH + 6 * KV_WIDTH + N_GATES + POOL_WIDTH
OUT_EVEN = NSA_WIDTH + POOL_WIDTH
GMLP_CHUNK = 128
GMLP_WIDTH = 3 * D_MODEL
GMLP_GROUPS = 16
GMLP_GROUP_DIM = GMLP_WIDTH // GMLP_GROUPS
FFN_HIDDEN = -(-8 * D_MODEL // (3 * 256)) * 256
WIN_Q_BLOCK = 128
SLC_Q_BLOCK = 64
N_EVEN = (DEPTH + 1) // 2
N_ODD = DEPTH // 2
EPS = 1e-6
NEG = -1e30

kernel_name = 'hybrid_nsa_pool_gmlp_trunk'


def rms_norm(x, g):
    xf = x.astype(jnp.float32)
    y = xf * lax.rsqrt(jnp.mean(xf * xf, axis=-1, keepdims=True) + EPS)
    return (y * g.astype(jnp.float32)).astype(x.dtype)


def partial_rope(x, pos):
    half = ROPE_DIM // 2
    inv_freq = ROPE_THETA ** (-jnp.arange(half, dtype=jnp.float32) * 2.0 / ROPE_DIM)
    ang = pos.astype(jnp.float32)[:, None] * inv_freq[None, :]
    cos = jnp.cos(ang)[None, :, None, :]
    sin = jnp.sin(ang)[None, :, None, :]
    xf = x.astype(jnp.float32)
    x1 = xf[..., :half]
    x2 = xf[..., half:ROPE_DIM]
    out = jnp.concatenate([x1 * cos - x2 * sin, x2 * cos + x1 * sin, xf[..., ROPE_DIM:]], axis=-1)
    return out.astype(x.dtype)


def compress(k, pe, w1, w2):
    B, T, G, D = k.shape
    chunks = k.reshape(B, T // CMP_STRIDE, CMP_STRIDE, G, D)
    blocks = jnp.concatenate([chunks[:, :-1], chunks[:, 1:]], axis=2)
    blocks = blocks + pe[None, None, :, None, :]
    hid = jax.nn.gelu(jnp.einsum('bnlgd,ldh->bngh', blocks, w1))
    return jnp.einsum('bngh,hd->bngd', hid, w2)


def cmp_attention(q, kc, vc, pos):
    NC = kc.shape[1]
    s = jnp.einsum('btghd,bngd->bghtn', q, kc).astype(jnp.float32) * ATTN_SCALE
    blk_end = jnp.arange(NC) * CMP_STRIDE + CMP_BLOCK - 1
    valid = blk_end[None, :] <= pos[:, None]
    s = jnp.where(valid, s, NEG)
    p = jnp.where(valid, jax.nn.softmax(s, axis=-1), 0.0)
    o = jnp.einsum('bghtn,bngd->btghd', p.astype(vc.dtype), vc)
    return o, p


def select_blocks(p_cmp, pos, n_slc):
    imp = p_cmp.sum(axis=2)
    B, G, T, _ = imp.shape
    r = SLC_BLOCK // CMP_STRIDE
    padded = jnp.pad(imp, ((0, 0), (0, 0), (0, 0), (1, 1)))
    main = padded[..., : r * n_slc].reshape(B, G, T, n_slc, r)
    nxt = padded[..., r: r * n_slc + 1: r]
    score = main.sum(-1) - 0.5 * main[..., 0] + 0.5 * nxt
    blk = jnp.arange(n_slc)[None, :]
    cur = (pos // SLC_BLOCK)[:, None]
    forced = (blk == cur) | (blk == 0)
    score = jnp.where(forced, -NEG, jnp.where(blk > cur, NEG, score))
    _, idx = lax.top_k(score, min(SLC_TOPK, n_slc))
    return idx


def slc_attention(q, ks, vs, idx, pos):
    B, T, G, HPG, D = q.shape
    n_slc = T // SLC_BLOCK
    kb = ks.reshape(B, n_slc, SLC_BLOCK, G, D).transpose(0, 3, 1, 2, 4)
    vb = vs.reshape(B, n_slc, SLC_BLOCK, G, D).transpose(0, 3, 1, 2, 4)
    nq = T // SLC_Q_BLOCK
    k = idx.shape[-1]
    q_blocks = q.reshape(B, nq, SLC_Q_BLOCK, G, HPG, D).transpose(1, 0, 2, 3, 4, 5)
    i_blocks = idx.reshape(B, G, nq, SLC_Q_BLOCK, k).transpose(2, 0, 1, 3, 4)
    p_blocks = pos.reshape(nq, SLC_Q_BLOCK)
    gather = jax.vmap(jax.vmap(lambda blocks, ids: blocks[ids]))

    def one(args):
        qc, ic, pc = args
        kg = gather(kb, ic)
        vg = gather(vb, ic)
        s = jnp.einsum('bqghd,bgqkld->bghqkl', qc, kg).astype(jnp.float32) * ATTN_SCALE
        kpos = ic[..., None] * SLC_BLOCK + jnp.arange(SLC_BLOCK)
        valid = kpos <= pc[None, None, :, None, None]
        s = jnp.where(valid[:, :, None], s, NEG)
        s = s.reshape(B, G, HPG, SLC_Q_BLOCK, k * SLC_BLOCK)
        p = jax.nn.softmax(s, axis=-1).reshape(B, G, HPG, SLC_Q_BLOCK, k, SLC_BLOCK)
        return jnp.einsum('bghqkl,bgqkld->bqghd', p.astype(vg.dtype), vg)

    o = lax.map(one, (q_blocks, i_blocks, p_blocks))
    return o.transpose(1, 0, 2, 3, 4, 5).reshape(B, T, G, HPG, D)


def win_attention(q, kw, vw):
    B, T, G, HPG, D = q.shape
    kp = jnp.pad(kw, ((0, 0), (WINDOW, 0), (0, 0), (0, 0)))
    vp = jnp.pad(vw, ((0, 0), (WINDOW, 0), (0, 0), (0, 0)))
    nq = T // WIN_Q_BLOCK
    span = WINDOW + WIN_Q_BLOCK
    q_blocks = q.reshape(B, nq, WIN_Q_BLOCK, G, HPG, D).transpose(1, 0, 2, 3, 4, 5)

    def one(args):
        qc, i = args
        s0 = i * WIN_Q_BLOCK
        kc = lax.dynamic_slice_in_dim(kp, s0, span, axis=1)
        vc = lax.dynamic_slice_in_dim(vp, s0, span, axis=1)
        qpos = s0 + jnp.arange(WIN_Q_BLOCK)
        kpos = s0 - WINDOW + jnp.arange(span)
        valid = ((kpos[None, :] <= qpos[:, None]) & (kpos[None, :] > qpos[:, None] - WINDOW)
                 & (kpos[None, :] >= 0))
        s = jnp.einsum('bqghd,bkgd->bghqk', qc, kc).astype(jnp.float32) * ATTN_SCALE
        s = jnp.where(valid, s, NEG)
        p = jax.nn.softmax(s, axis=-1)
        return jnp.einsum('bghqk,bkgd->bqghd', p.astype(vc.dtype), vc)

    o = lax.map(one, (q_blocks, jnp.arange(nq)))
    return o.transpose(1, 0, 2, 3, 4, 5).reshape(B, T, G, HPG, D)


def pool_mixer(p, w, scale):
    B, T, C = p.shape
    xg = p.reshape(B, T, len(POOL_WINDOWS), POOL_GROUP).astype(jnp.float32)
    c = jnp.pad(jnp.cumsum(xg, axis=1), ((0, 0), (1, 0), (0, 0), (0, 0)))
    outs = []
    for gi, w_len in enumerate(POOL_WINDOWS):
        cg = c[:, :, gi]
        lag = jnp.pad(cg, ((0, 0), (w_len, 0), (0, 0)))[:, 1:T + 1]
        count = jnp.minimum(jnp.arange(T) + 1, w_len).astype(jnp.float32)
        outs.append((cg[:, 1:] - lag) / count[None, :, None] - xg[:, :, gi])
    y = jnp.stack(outs, axis=2).astype(p.dtype)
    y = jnp.einsum('btgc,gcd->btgd', y, w).reshape(B, T, C)
    return y * scale


def even_mixer(h, pos, w_in, pe_k, pe_v, w1_k, w2_k, w1_v, w2_v, pool_w, pool_scale, w_out):
    B, T, _ = h.shape
    z = h @ w_in
    splits = np.cumsum([NSA_WIDTH] + [KV_WIDTH] * 6 + [N_GATES]).tolist()
    q, kc, vc, ks, vs, kw, vw, gates, pin = jnp.split(z, splits, axis=-1)
    kvshape = (B, T, NSA_KV_HEADS, HEAD_DIM)
    q = partial_rope(q.reshape(B, T, NSA_HEADS, HEAD_DIM), pos)
    q = q.reshape(B, T, NSA_KV_HEADS, NSA_HPG, HEAD_DIM)
    kc = partial_rope(kc.reshape(kvshape), pos)
    ks = partial_rope(ks.reshape(kvshape), pos)
    kw = partial_rope(kw.reshape(kvshape), pos)
    vc, vs, vw = vc.reshape(kvshape), vs.reshape(kvshape), vw.reshape(kvshape)
    k_cmp = compress(kc, pe_k, w1_k, w2_k)
    v_cmp = compress(vc, pe_v, w1_v, w2_v)
    o_cmp, p_cmp = cmp_attention(q, k_cmp, v_cmp, pos)
    idx = select_blocks(p_cmp, pos, T // SLC_BLOCK)
    o_slc = slc_attention(q, ks, vs, idx, pos)
    o_win = win_attention(q, kw, vw)
    g = jax.nn.sigmoid(gates.astype(jnp.float32)).astype(h.dtype)
    g = g.reshape(B, T, NSA_KV_HEADS, NSA_HPG, 3)
    o = g[..., 0:1] * o_cmp + g[..., 1:2] * o_slc + g[..., 2:3] * o_win
    o = o.reshape(B, T, NSA_WIDTH)
    y_pool = pool_mixer(pin, pool_w, pool_scale)
    return jnp.concatenate([o, y_pool], axis=-1) @ w_out


def odd_mixer(h, w_in, ln_g, ln_b, ws, bs, w_out):
    B, T, _ = h.shape
    z = jax.nn.gelu(h @ w_in)
    u, v = jnp.split(z, 2, axis=-1)
    vf = v.astype(jnp.float32)
    mu = jnp.mean(vf, axis=-1, keepdims=True)
    var = jnp.mean(jnp.square(vf - mu), axis=-1, keepdims=True)
    v = ((vf - mu) * lax.rsqrt(var + EPS) * ln_g + ln_b).astype(h.dtype)
    nc = T // GMLP_CHUNK
    v = v.reshape(B, nc, GMLP_CHUNK, GMLP_GROUPS, GMLP_GROUP_DIM)
    mask = jnp.tril(jnp.ones((GMLP_CHUNK, GMLP_CHUNK), dtype=ws.dtype))
    s = jnp.einsum('gts,bcsgd->bctgd', ws * mask, v) + bs.T[None, None, :, :, None]
    y = u * s.reshape(B, T, GMLP_WIDTH)
    return y @ w_out


def swiglu(h, wg, wu, wd):
    return (jax.nn.silu(h @ wg) * (h @ wu)) @ wd


def setup_inputs(seed: int = 0) -> dict:
    key = jax.random.key(seed)
    ks = jax.random.split(key, 24)
    f32 = jnp.float32

    def nrm(k, shape, fan_in):
        return jax.random.normal(k, shape, f32) * (fan_in ** -0.5)

    def gain(k, shape):
        return 1.0 + 0.02 * jax.random.normal(k, shape, f32)

    def small(k, shape):
        return 0.02 * jax.random.normal(k, shape, f32)

    return {
        'x': jax.random.normal(ks[0], (BATCH, SEQ, D_MODEL), f32),
        'norm_mix_even': gain(ks[1], (N_EVEN, D_MODEL)),
        'w_in_even': nrm(ks[2], (N_EVEN, D_MODEL, IN_EVEN), D_MODEL),
        'cmp_pe_k': small(ks[3], (N_EVEN, CMP_BLOCK, HEAD_DIM)),
        'cmp_pe_v': small(ks[4], (N_EVEN, CMP_BLOCK, HEAD_DIM)),
        'cmp_w1_k': nrm(ks[5], (N_EVEN, CMP_BLOCK, HEAD_DIM, CMP_HIDDEN), CMP_BLOCK * HEAD_DIM),
        'cmp_w2_k': nrm(ks[6], (N_EVEN, CMP_HIDDEN, HEAD_DIM), CMP_HIDDEN),
        'cmp_w1_v': nrm(ks[7], (N_EVEN, CMP_BLOCK, HEAD_DIM, CMP_HIDDEN), CMP_BLOCK * HEAD_DIM),
        'cmp_w2_v': nrm(ks[8], (N_EVEN, CMP_HIDDEN, HEAD_DIM), CMP_HIDDEN),
        'pool_w': nrm(ks[9], (N_EVEN, len(POOL_WINDOWS), POOL_GROUP, POOL_GROUP), POOL_GROUP),
        'pool_scale': gain(ks[10], (N_EVEN, POOL_WIDTH)),
        'w_out_even': nrm(ks[11], (N_EVEN, OUT_EVEN, D_MODEL), OUT_EVEN),
        'norm_mix_odd': gain(ks[12], (N_ODD, D_MODEL)),
        'w_in_odd': nrm(ks[13], (N_ODD, D_MODEL, 2 * GMLP_WIDTH), D_MODEL),
        'gmlp_ln_g': gain(ks[14], (N_ODD, GMLP_WIDTH)),
        'gmlp_ln_b': small(ks[15], (N_ODD, GMLP_WIDTH)),
        'gmlp_ws': nrm(ks[16], (N_ODD, GMLP_GROUPS, GMLP_CHUNK, GMLP_CHUNK), GMLP_CHUNK),
        'gmlp_bs': gain(ks[17], (N_ODD, GMLP_GROUPS, GMLP_CHUNK)),
        'w_out_odd': nrm(ks[18], (N_ODD, GMLP_WIDTH, D_MODEL), GMLP_WIDTH),
        'norm_ffn': gain(ks[19], (DEPTH, D_MODEL)),
        'w_ffn_gate': nrm(ks[20], (DEPTH, D_MODEL, FFN_HIDDEN), D_MODEL),
        'w_ffn_up': nrm(ks[21], (DEPTH, D_MODEL, FFN_HIDDEN), D_MODEL),
        'w_ffn_down': nrm(ks[22], (DEPTH, FFN_HIDDEN, D_MODEL), FFN_HIDDEN),
        'norm_final': gain(ks[23], (D_MODEL,)),
    }


def reference(x, norm_mix_even, w_in_even, cmp_pe_k, cmp_pe_v, cmp_w1_k, cmp_w2_k, cmp_w1_v,
              cmp_w2_v, pool_w, pool_scale, w_out_even, norm_mix_odd, w_in_odd, gmlp_ln_g,
              gmlp_ln_b, gmlp_ws, gmlp_bs, w_out_odd, norm_ffn, w_ffn_gate, w_ffn_up, w_ffn_down,
              norm_final):
    pos = jnp.arange(x.shape[1])
    for layer in range(DEPTH):
        j = layer // 2
        if layer % 2 == 0:
            h = rms_norm(x, norm_mix_even[j])
            x = x + even_mixer(h, pos, w_in_even[j], cmp_pe_k[j], cmp_pe_v[j], cmp_w1_k[j],
                               cmp_w2_k[j], cmp_w1_v[j], cmp_w2_v[j], pool_w[j], pool_scale[j],
                               w_out_even[j])
        else:
            h = rms_norm(x, norm_mix_odd[j])
            x = x + odd_mixer(h, w_in_odd[j], gmlp_ln_g[j], gmlp_ln_b[j], gmlp_ws[j], gmlp_bs[j],
                              w_out_odd[j])
        h = rms_norm(x, norm_ffn[layer])
        x = x + swiglu(h, w_ffn_gate[layer], w_ffn_up[layer], w_ffn_down[layer])
    return rms_norm(x, norm_final)
```

```cpp
#include <hip/hip_runtime.h>
#include <cstdio>
#include <cstdint>

#ifndef MK_ONE_LAUNCH
#define MK_ONE_LAUNCH 1
#endif

#define LAS __attribute__((address_space(3)))
#define GAS __attribute__((address_space(1)))
typedef unsigned short bf16_t;
typedef short bf16x8 __attribute__((ext_vector_type(8)));
typedef short s16x4 __attribute__((ext_vector_type(4)));
typedef float f32x2 __attribute__((ext_vector_type(2)));
typedef float f32x4 __attribute__((ext_vector_type(4)));
typedef float f32x16 __attribute__((ext_vector_type(16)));
typedef unsigned u32x2 __attribute__((ext_vector_type(2)));
typedef unsigned u32x4 __attribute__((ext_vector_type(4)));

constexpr int NB = 2, T = 4096, DM = 4096, M = NB * T;
constexpr int NH = 16, NG = 4, HD = 128;
constexpr int IN_EVEN = 7216, IN_EVEN_P = 7424;
constexpr int FF = 11008, GW = 12288;
constexpr float EPS = 1e-6f;
constexpr size_t KVSZ = (size_t)NB * NG * T * HD;

constexpr size_t O_CTL = 0, CTL_ZERO_BYTES = 64u << 10;
constexpr size_t O_ROPE = 1u << 20;
constexpr size_t O_WM = O_ROPE + (512u << 10);
constexpr size_t O_STATS = O_WM + (512u << 10);
constexpr size_t O_KCMP = O_STATS + (64u << 10);
constexpr size_t O_VCMPT = O_KCMP + (512u << 10);
constexpr size_t O_SEL = O_VCMPT + (512u << 10);
constexpr size_t O_GATES = O_SEL + (256u << 10);
constexpr size_t O_W = 8u << 20;
constexpr size_t O_W_INE = O_W;
constexpr size_t O_W_OUTE = O_W_INE + (size_t)IN_EVEN_P * DM * 2;
constexpr size_t O_W_GU0 = O_W_OUTE + (size_t)DM * DM * 2;
constexpr size_t O_W_DN0 = O_W_GU0 + (size_t)2 * FF * DM * 2;
constexpr size_t O_W_GU1 = O_W_DN0 + (size_t)DM * FF * 2;
constexpr size_t O_W_DN1 = O_W_GU1 + (size_t)2 * FF * DM * 2;
constexpr size_t O_W_INO = O_W_DN1 + (size_t)DM * FF * 2;
constexpr size_t O_W_OUTO = O_W_INO + (size_t)2 * GW * DM * 2;
constexpr size_t O_W_POOL = O_W_OUTO + (size_t)DM * GW * 2;
constexpr size_t O_W_C1K = O_W_POOL + (size_t)4 * 512 * 512 * 2;
constexpr size_t O_W_C1V = O_W_C1K + (size_t)256 * 4096 * 2;
constexpr size_t O_W_C2K = O_W_C1V + (size_t)256 * 4096 * 2;
constexpr size_t O_W_C2V = O_W_C2K + (size_t)128 * 256 * 2;
constexpr size_t O_XB = O_W_C2V + (size_t)128 * 256 * 2;
constexpr size_t O_XB1 = O_XB + (size_t)M * DM * 2;
constexpr size_t O_HN = O_XB + (size_t)M * DM * 4;
constexpr size_t O_A = O_HN + (size_t)M * DM * 2;
constexpr size_t O_QH = O_A;
constexpr size_t O_KV = O_QH + (size_t)M * 2048 * 2;
constexpr size_t O_PIN = O_KV + 6 * KVSZ * 2;
constexpr size_t O_POOLED = O_PIN + (size_t)M * 2048 * 2;
constexpr size_t O_OACC = O_POOLED + (size_t)M * 2048 * 2;
constexpr size_t O_CAT = O_OACC + (size_t)M * 2048 * 4;
constexpr size_t O_A_END_EVEN = O_CAT + (size_t)M * DM * 2;
constexpr size_t O_H = O_A;
constexpr size_t O_U = O_A;
constexpr size_t O_V = O_U + (size_t)M * GW * 2;
constexpr size_t O_A_END_ODD = O_V + (size_t)M * GW * 2;
constexpr size_t O_VPART = O_A_END_ODD > O_A_END_EVEN ? O_A_END_ODD : O_A_END_EVEN;
constexpr size_t O_SSQP = O_VPART + (size_t)M * 192 * 2 * 4;
constexpr size_t WS_END = O_SSQP + (size_t)M * 64 * 4;
static_assert(O_GATES + (size_t)M * 48 * 4 <= O_W, "small buffers fit below the weights");
static_assert((O_W_OUTE % 256) == 0 && (O_W_GU0 % 256) == 0 && (O_W_DN0 % 256) == 0 && (O_W_INO % 256) == 0 && (O_XB % 256) == 0 && (O_A % 256) == 0 && (O_V % 256) == 0, "alignment");

constexpr int CW_TMO = 0, CW_BAR = 4096;
constexpr size_t O_CBIAS = 384u << 10;
constexpr size_t O_SSQ = 448u << 10;
constexpr size_t O_VSUMS = 256u << 10;

constexpr int RING_OFF = 0, RING_BYTES = 131072;
constexpr int LDS_BYTES = 147456;
constexpr int LDSCTL_OFF = LDS_BYTES - 1024, MISC_OFF = LDSCTL_OFF + 320;
constexpr int ROWSC_OFF = LDSCTL_OFF - 2048;
constexpr int NWAVES = 8;

typedef __bf16 bf16x2_t __attribute__((ext_vector_type(2)));
__device__ __forceinline__ unsigned cvt_pk_bf16(float lo, float hi) { f32x2 v = {lo, hi}; bf16x2_t b = __builtin_convertvector(v, bf16x2_t); return __builtin_bit_cast(unsigned, b); }
__device__ __forceinline__ float bf2f(unsigned short b) { return __uint_as_float(((unsigned)b) << 16); }
__device__ __forceinline__ float bflo(unsigned w) { return __uint_as_float(w << 16); }
__device__ __forceinline__ float bfhi(unsigned w) { return __uint_as_float(w & 0xffff0000u); }
__device__ __forceinline__ float sigmoidf_(float x) { return __builtin_amdgcn_rcpf(1.0f + __builtin_amdgcn_exp2f(-1.4426950408889634f * x)); }
__device__ __forceinline__ float gelu_tanh(float x) {
    const float y = 2.0f * 0.7978845608028654f * x * (1.0f + 0.044715f * x * x);
    return x * sigmoidf_(y);
}
__device__ __forceinline__ int lane_id() { unsigned z = 0u; asm volatile("" : "+s"(z)); return (int)__builtin_amdgcn_mbcnt_hi(~0u, __builtin_amdgcn_mbcnt_lo(~0u, z)); }
#define LDS_WAIT() asm volatile("s_waitcnt lgkmcnt(0)" ::: "memory")
#define VM_WAIT() asm volatile("s_waitcnt vmcnt(0)" ::: "memory")

namespace pg8 {
constexpr int BM = 256, BK = 64, HALF = 128, HTB = HALF * BK * 2, STAGE_BYTES = 8 * HTB, NXCD = 8, WGM = 8;
__host__ __device__ __forceinline__ int lds_byte(int r, int c) { const int st = (r >> 4) * 2 + (c >> 5), rr = r & 15, cc = c & 31, ob = rr * 64 + cc * 2; return st * 1024 + (ob ^ (((ob >> 9) & 1) << 5)); }
__host__ __device__ __forceinline__ void stage_rc(int b, int& R, int& C) { const int st = b / 1024, sb = b % 1024, swz = sb ^ (((sb >> 9) & 1) << 5); R = (st >> 1) * 16 + swz / 64; C = (st & 1) * 32 + (swz % 64) / 2; }
__host__ __device__ __forceinline__ int perm32(int rho) { const int n = rho >> 4, i = rho & 15; return 8 * (i >> 2) + 4 * n + (i & 3); }

struct Unit { int pm, pn; };
struct Gemm { const bf16_t* A; const bf16_t* Bt; int M, N, K, lda, ldb; };

struct StaticOrder {
    int nM, nN, nwg, G, c;
    __host__ __device__ __forceinline__ void init(int M_, int N_, int G_, int c_) { nM = M_ / BM; nN = N_ / BM; nwg = nM * nN; G = G_; c = c_; }
    __host__ __device__ __forceinline__ bool next(int i, Unit& u) const {
        const long L = (long)i * G + c; if (L >= nwg) return false;
        int wgid = (int)L; { const int q = nwg / NXCD, r = nwg % NXCD, xcd = wgid % NXCD, off = wgid / NXCD; wgid = (xcd < r ? xcd * (q + 1) : r * (q + 1) + (xcd - r) * q) + off; }
        const int nig = WGM * nN, gid = wgid / nig, fm = gid * WGM, gsz = (nM - fm) < WGM ? (nM - fm) : WGM;
        u.pm = fm + ((wgid % nig) % gsz); u.pn = (wgid % nig) / gsz; return true;
    }
    __device__ __forceinline__ void a_ready(const Unit&) const {}
    __device__ __forceinline__ void done(const Unit&) const {}
};


struct EpiInEven {
    static constexpr bool PERM = true, AFTER_DRAIN = false;
    bf16_t* QH; bf16_t* KV; bf16_t* PIN; float* GATES; const float* ROPE;
    __device__ __forceinline__ void operator()(const f32x4 (&acc)[2][2][4][2], const Unit& u, int wr, int wc, int fr, int fq) const {
        const int pn = u.pn;
#pragma unroll
        for (int ai = 0; ai < 2; ++ai)
#pragma unroll
            for (int m = 0; m < 4; ++m) {
                const int row = u.pm * BM + ai * HALF + wr * 64 + m * 16 + fr, b = row >> 12, t = row & 4095;
#pragma unroll
                for (int bj = 0; bj < 2; ++bj) {
                    f32x4 v0 = acc[ai][bj][m][0], v1 = acc[ai][bj][m][1];
                    if (pn < 20) {
                        const bool is_q = pn < 8; const int which = (pn - 8) >> 1;
                        if (wc == 0 && (is_q || !(which & 1))) {
                            f32x4 p0, p1;
#pragma unroll
                            for (int e = 0; e < 4; ++e) { p0[e] = __shfl_xor(v0[e], 32); p1[e] = __shfl_xor(v1[e], 32); }
                            const float* cp = ROPE + t * 16 + 8 * (fq & 1);
                            const f32x4 c0 = *(const f32x4*)cp, c1 = *(const f32x4*)(cp + 4), s0 = *(const f32x4*)(cp + 65536), s1 = *(const f32x4*)(cp + 65536 + 4);
                            if (fq < 2) { v0 = v0 * c0 - p0 * s0; v1 = v1 * c1 - p1 * s1; } else { v0 = v0 * c0 + p0 * s0; v1 = v1 * c1 + p1 * s1; }
                        }
                        const int d0 = wc * 32 + 8 * fq;
                        bf16_t* dst = is_q ? QH + ((size_t)((b * 16 + 2 * pn + bj) * 4096 + t)) * 128 + d0
                                           : KV + (size_t)which * KVSZ + ((size_t)((b * 4 + ((pn - 8) & 1) * 2 + bj) * 4096 + t)) * 128 + d0;
                        u32x4 w; w.x = cvt_pk_bf16(v0[0], v0[1]); w.y = cvt_pk_bf16(v0[2], v0[3]); w.z = cvt_pk_bf16(v1[0], v1[1]); w.w = cvt_pk_bf16(v1[2], v1[3]);
                        *(u32x4*)dst = w;
                    } else if (pn < 28) {
                        u32x4 w; w.x = cvt_pk_bf16(v0[0], v0[1]); w.y = cvt_pk_bf16(v0[2], v0[3]); w.z = cvt_pk_bf16(v1[0], v1[1]); w.w = cvt_pk_bf16(v1[2], v1[3]);
                        *(u32x4*)(PIN + (size_t)row * 2048 + (pn - 20) * 256 + bj * HALF + wc * 32 + 8 * fq) = w;
                    } else {
                        const int col0 = wc * 32 + 8 * fq;
                        if (bj == 0 && col0 <= 40) {
                            f32x4 g0, g1;
#pragma unroll
                            for (int e = 0; e < 4; ++e) { g0[e] = sigmoidf_(v0[e]); g1[e] = sigmoidf_(v1[e]); }
                            float* gp = GATES + (size_t)row * 48 + col0; *(f32x4*)gp = g0; *(f32x4*)(gp + 4) = g1;
                        }
                    }
                }
            }
    }
};
struct EpiScaleBf16 {
    static constexpr bool PERM = true, AFTER_DRAIN = false;
    bf16_t* O; int ldc; const float* scale;
    __device__ __forceinline__ void operator()(const f32x4 (&acc)[2][2][4][2], const Unit& u, int wr, int wc, int fr, int fq) const {
        const int row0 = u.pm * BM + wr * 64 + fr, col0 = u.pn * BM + wc * 32 + 8 * fq;
#pragma unroll
        for (int bj = 0; bj < 2; ++bj) {
            const f32x4 sc0 = *(const f32x4*)(scale + col0 + bj * HALF), sc1 = *(const f32x4*)(scale + col0 + bj * HALF + 4);
#pragma unroll
            for (int ai = 0; ai < 2; ++ai)
#pragma unroll
                for (int m = 0; m < 4; ++m) { const f32x4 v0 = acc[ai][bj][m][0] * sc0, v1 = acc[ai][bj][m][1] * sc1;
                    u32x4 w; w.x = cvt_pk_bf16(v0[0], v0[1]); w.y = cvt_pk_bf16(v0[2], v0[3]); w.z = cvt_pk_bf16(v1[0], v1[1]); w.w = cvt_pk_bf16(v1[2], v1[3]);
                    *(u32x4*)(O + (size_t)(row0 + ai * HALF + m * 16) * ldc + col0 + bj * HALF) = w; }
        }
    }
};
template <bool BASE_F32> struct EpiResid {
    static constexpr bool PERM = true, AFTER_DRAIN = false;
    const void* base; bf16_t* out; int ldc; float* ssqp;
    __device__ __forceinline__ void operator()(const f32x4 (&acc)[2][2][4][2], const Unit& u, int wr, int wc, int fr, int fq) const {
        const int row0 = u.pm * BM + wr * 64 + fr, col0 = u.pn * BM + wc * 32 + 8 * fq;
#pragma unroll
        for (int ai = 0; ai < 2; ++ai) { f32x4 b0[4][2], b1[4][2];
#pragma unroll
            for (int m = 0; m < 4; ++m) { const size_t off = (size_t)(row0 + ai * HALF + m * 16) * ldc + col0;
#pragma unroll
                for (int bj = 0; bj < 2; ++bj) {
                    if constexpr (BASE_F32) { const float* bp = (const float*)base + off + bj * HALF; b0[m][bj] = *(const f32x4*)bp; b1[m][bj] = *(const f32x4*)(bp + 4); }
                    else { const u32x4 w = *(const u32x4*)((const bf16_t*)base + off + bj * HALF); b0[m][bj] = (f32x4){bflo(w.x), bfhi(w.x), bflo(w.y), bfhi(w.y)}; b1[m][bj] = (f32x4){bflo(w.z), bfhi(w.z), bflo(w.w), bfhi(w.w)}; } } }
#pragma unroll
            for (int m = 0; m < 4; ++m) { const int row = row0 + ai * HALF + m * 16; const size_t off = (size_t)row * ldc + col0; float sq = 0.f;
#pragma unroll
                for (int bj = 0; bj < 2; ++bj) { const f32x4 o0 = b0[m][bj] + acc[ai][bj][m][0], o1 = b1[m][bj] + acc[ai][bj][m][1];
                    sq += ((o0[0] * o0[0] + o0[1] * o0[1]) + (o0[2] * o0[2] + o0[3] * o0[3])) + ((o1[0] * o1[0] + o1[1] * o1[1]) + (o1[2] * o1[2] + o1[3] * o1[3]));
                    u32x4 w; w.x = cvt_pk_bf16(o0[0], o0[1]); w.y = cvt_pk_bf16(o0[2], o0[3]); w.z = cvt_pk_bf16(o1[0], o1[1]); w.w = cvt_pk_bf16(o1[2], o1[3]);
                    *(u32x4*)(out + off + bj * HALF) = w; }
                sq += __shfl_xor(sq, 16); sq += __shfl_xor(sq, 32);
                if (fq == 0) ssqp[(size_t)row * 64 + u.pn * 4 + wc] = sq; }
            asm volatile("" ::: "memory"); }
    }
};
__device__ __forceinline__ float row_rstd_from_partials(const float* ssqp, int row) { const f32x4* p = (const f32x4*)(ssqp + (size_t)row * 64); float t = 0.f;
#pragma unroll
    for (int i = 0; i < 16; ++i) { const f32x4 v = p[i]; t += (v[0] + v[1]) + (v[2] + v[3]); }
    return 1.0f / sqrtf(t * (1.0f / DM) + EPS); }
struct RowScale { const LAS float* tab; int pm0;
    __device__ __forceinline__ float get(int pm, int r_in_panel) const { return pm == pm0 ? tab[r_in_panel] : __builtin_nanf(""); } };
__device__ __forceinline__ void build_row_scale(LAS float* tab, const float* ssqp, int pm, int tid) {
    const int r = tid >> 1, h = tid & 1; const f32x4* p = (const f32x4*)(ssqp + (size_t)(pm * 256 + r) * 64 + 32 * h); float t = 0.f;
#pragma unroll
    for (int i = 0; i < 8; ++i) { const f32x4 v = p[i]; t += (v[0] + v[1]) + (v[2] + v[3]); }
    const float o = __shfl_xor(t, 1); const float tot = h ? (o + t) : (t + o);
    if (h == 0) tab[r] = 1.0f / sqrtf(tot * (1.0f / DM) + EPS); }
struct EpiSwiGLU {
    static constexpr bool PERM = true, AFTER_DRAIN = false;
    bf16_t* H; int ldc; RowScale rsc;
    __device__ __forceinline__ void operator()(const f32x4 (&acc)[2][2][4][2], const Unit& u, int wr, int wc, int fr, int fq) const {
        const int row0 = u.pm * BM + wr * 64 + fr, col0 = u.pn * HALF + wc * 32 + 8 * fq;
        float rs[2][4];
#pragma unroll
        for (int ai = 0; ai < 2; ++ai)
#pragma unroll
            for (int m = 0; m < 4; ++m) rs[ai][m] = rsc.get(u.pm, ai * HALF + wr * 64 + m * 16 + fr);
#pragma unroll
        for (int ai = 0; ai < 2; ++ai)
#pragma unroll
            for (int m = 0; m < 4; ++m) { f32x4 h0, h1; const float r = rs[ai][m];
#pragma unroll
                for (int e = 0; e < 4; ++e) { const float g0 = acc[ai][0][m][0][e] * r, g1 = acc[ai][0][m][1][e] * r;
                    h0[e] = g0 * sigmoidf_(g0) * (acc[ai][1][m][0][e] * r); h1[e] = g1 * sigmoidf_(g1) * (acc[ai][1][m][1][e] * r); }
                u32x4 w; w.x = cvt_pk_bf16(h0[0], h0[1]); w.y = cvt_pk_bf16(h0[2], h0[3]); w.z = cvt_pk_bf16(h1[0], h1[1]); w.w = cvt_pk_bf16(h1[2], h1[3]);
                *(u32x4*)(H + (size_t)(row0 + ai * HALF + m * 16) * ldc + col0) = w; }
    }
};
struct EpiGeluSplit {
    static constexpr bool PERM = true, AFTER_DRAIN = false;
    bf16_t* O0; bf16_t* O1; int ldc; int split; float* part; RowScale rsc;
    __device__ __forceinline__ void operator()(const f32x4 (&acc)[2][2][4][2], const Unit& u, int wr, int wc, int fr, int fq) const {
        const int row0 = u.pm * BM + wr * 64 + fr; int colt = u.pn * BM; bf16_t* base = O0;
        const bool is_v = colt >= split;
        if (is_v) { base = O1; colt -= split; }
        const int col0 = colt + wc * 32 + 8 * fq;
#pragma unroll
        for (int ai = 0; ai < 2; ++ai)
#pragma unroll
            for (int m = 0; m < 4; ++m) { float s1 = 0.f, s2 = 0.f; const float r = rsc.get(u.pm, ai * HALF + wr * 64 + m * 16 + fr);
#pragma unroll
                for (int bj = 0; bj < 2; ++bj) { f32x4 v0, v1;
#pragma unroll
                    for (int e = 0; e < 4; ++e) { v0[e] = gelu_tanh(acc[ai][bj][m][0][e] * r); v1[e] = gelu_tanh(acc[ai][bj][m][1][e] * r); }
                    u32x4 w; w.x = cvt_pk_bf16(v0[0], v0[1]); w.y = cvt_pk_bf16(v0[2], v0[3]); w.z = cvt_pk_bf16(v1[0], v1[1]); w.w = cvt_pk_bf16(v1[2], v1[3]);
                    *(u32x4*)(base + (size_t)(row0 + ai * HALF + m * 16) * ldc + col0 + bj * HALF) = w;
                    if (is_v) {
                        const float r0 = bflo(w.x), r1 = bfhi(w.x), r2 = bflo(w.y), r3 = bfhi(w.y), r4 = bflo(w.z), r5 = bfhi(w.z), r6 = bflo(w.w), r7 = bfhi(w.w);
                        s1 += ((r0 + r1) + (r2 + r3)) + ((r4 + r5) + (r6 + r7)); s2 += ((r0 * r0 + r1 * r1) + (r2 * r2 + r3 * r3)) + ((r4 * r4 + r5 * r5) + (r6 * r6 + r7 * r7)); } }
                if (is_v) {
                    s1 += __shfl_xor(s1, 16); s1 += __shfl_xor(s1, 32); s2 += __shfl_xor(s2, 16); s2 += __shfl_xor(s2, 32);
                    if (fq == 0) { float* sp = part + ((size_t)(row0 + ai * HALF + m * 16) * 192 + (size_t)(u.pn - split / BM) * 4 + wc) * 2; *(f32x2*)sp = (f32x2){s1, s2}; } } }
    }
};

template <class Epi, class Sched, bool ALIGN_EPI = false, bool SP2 = false>
__device__ __forceinline__ void gemm_phase(LAS unsigned char* lds, const Gemm g, const Sched& S, const Epi& E, int wid, int lane) {
    const int tid = wid * 64 + lane, wr = wid >> 2, wc = wid & 3, fr = lane & 15, fq = lane >> 4;
    const int K = g.K, nt = K / BK;
    unsigned voffA[2], voffB[2];
#pragma unroll
    for (int i = 0; i < 2; ++i) { int R, C; stage_rc(tid * 16 + i * 8192, R, C); const int Rb = Epi::PERM ? ((R & ~31) + perm32(R & 31)) : R;
        voffA[i] = (unsigned)(R * g.lda + C) * 2u; voffB[i] = (unsigned)(Rb * g.ldb + C) * 2u; }
    const size_t kstep = (size_t)(BK * 2);
    const size_t hsA = (size_t)HALF * g.lda * 2, hsB = (size_t)HALF * g.ldb * 2;
    const size_t tsA = 2 * hsA, tsB = 2 * hsB;
    const unsigned ldsw = (unsigned)wid * 1024u;
    const int aoff = lds_byte(wr * 64 + fr, fq * 8), boff = lds_byte(wc * 32 + fr, fq * 8);
#define PG8_SA(b, h) (((b) * 2 + (h)) * HTB)
#define PG8_SB(b, h) ((4 + (b) * 2 + (h)) * HTB)
#define PG8_STAGE(bufoff, gbase, voff) do { _Pragma("unroll") for (int _i = 0; _i < 2; ++_i) \
        __builtin_amdgcn_global_load_lds((const unsigned*)((const char*)(gbase) + (voff)[_i]), (LAS unsigned*)(lds + (bufoff) + ldsw + _i * 8192), 16, 0, 0); } while (0)
#define PG8_LDA(dst, b, h) do { _Pragma("unroll") for (int m = 0; m < 4; ++m) _Pragma("unroll") for (int k = 0; k < 2; ++k) dst[m][k] = *(const LAS bf16x8*)(lds + PG8_SA(b, h) + aoff + m * 2048 + k * 1024); } while (0)
#define PG8_LDB(dst, b, h) do { _Pragma("unroll") for (int n = 0; n < 2; ++n) _Pragma("unroll") for (int k = 0; k < 2; ++k) dst[n][k] = *(const LAS bf16x8*)(lds + PG8_SB(b, h) + boff + n * 2048 + k * 1024); } while (0)
#define PG8_MMA(ai, bj, At, Bt) do { __builtin_amdgcn_s_setprio(1); _Pragma("unroll") for (int m = 0; m < 4; ++m) _Pragma("unroll") for (int n = 0; n < 2; ++n) _Pragma("unroll") for (int k = 0; k < 2; ++k) \
        acc[ai][bj][m][n] = __builtin_amdgcn_mfma_f32_16x16x32_bf16(Bt[n][k], At[m][k], acc[ai][bj][m][n], 0, 0, 0); __builtin_amdgcn_s_setprio(0); } while (0)
#define PG8_WAIT_V(n) asm volatile("s_waitcnt vmcnt(" #n ")" ::: "memory")
#define PG8_WAIT_L(n) asm volatile("s_waitcnt lgkmcnt(" #n ")" ::: "memory")
#define PG8_BAR __builtin_amdgcn_s_barrier()
#define PG8_SCHED __builtin_amdgcn_sched_barrier(0)
    Unit cur, nxt; int ui = 0;
    if (!S.next(0, cur)) return;
    f32x4 acc[2][2][4][2];
#pragma unroll
    for (int a = 0; a < 2; ++a)
#pragma unroll
        for (int b = 0; b < 2; ++b)
#pragma unroll
            for (int m = 0; m < 4; ++m)
#pragma unroll
                for (int n = 0; n < 2; ++n) acc[a][b][m][n] = (f32x4){0.f, 0.f, 0.f, 0.f};
    bf16x8 At[4][2], B0[2][2], B1[2][2];
    const char* cA = (const char*)g.A + (size_t)cur.pm * tsA; const char* cB = (const char*)g.Bt + (size_t)cur.pn * tsB;
    S.a_ready(cur);
    if constexpr (SP2) {
        PG8_STAGE(PG8_SB(0, 0), cB, voffB); PG8_STAGE(PG8_SB(0, 1), cB + hsB, voffB); PG8_STAGE(PG8_SA(0, 0), cA, voffA); PG8_STAGE(PG8_SA(0, 1), cA + hsA, voffA);
        if (wr == 1) PG8_BAR;
        PG8_WAIT_V(2); PG8_BAR;
        PG8_STAGE(PG8_SB(1, 0), cB + kstep, voffB); PG8_STAGE(PG8_SA(1, 0), cA + kstep, voffA); PG8_STAGE(PG8_SB(1, 1), cB + hsB + kstep, voffB);
        PG8_WAIT_V(6); PG8_BAR;
    } else {
        PG8_STAGE(PG8_SB(0, 0), cB, voffB); PG8_STAGE(PG8_SA(0, 0), cA, voffA); PG8_STAGE(PG8_SB(0, 1), cB + hsB, voffB); PG8_STAGE(PG8_SA(0, 1), cA + hsA, voffA);
        if (wr == 1) PG8_BAR;
        PG8_WAIT_V(4); PG8_BAR;
        PG8_STAGE(PG8_SB(1, 0), cB + kstep, voffB); PG8_STAGE(PG8_SA(1, 0), cA + kstep, voffA); PG8_STAGE(PG8_SB(1, 1), cB + hsB + kstep, voffB);
        PG8_WAIT_V(6); PG8_BAR;
    }
    for (;;) {
        const bool has_next = S.next(ui + 1, nxt);
        const char* nA = has_next ? (const char*)g.A + (size_t)nxt.pm * tsA : cA; const char* nB = has_next ? (const char*)g.Bt + (size_t)nxt.pn * tsB : cB;
        for (int t = 0; t < nt; t += 2) {
            const bool last = (t == nt - 2);
            const char* a1 = cA + (size_t)(t + 1) * kstep;
            const char* a2 = last ? nA : cA + (size_t)(t + 2) * kstep; const char* b2 = last ? nB : cB + (size_t)(t + 2) * kstep;
            const char* a3 = a2 + kstep; const char* b3 = b2 + kstep;
            if (last && has_next) S.a_ready(nxt);
            if constexpr (SP2) {
            PG8_LDB(B0, 0, 0); PG8_LDB(B1, 0, 1); PG8_SCHED; PG8_LDA(At, 0, 0); PG8_STAGE(PG8_SA(1, 1), a1 + hsA, voffA);
            PG8_WAIT_V(8); PG8_WAIT_L(0); PG8_BAR; PG8_MMA(0, 0, At, B0); PG8_MMA(0, 1, At, B1); PG8_BAR; PG8_SCHED;
            PG8_LDA(At, 0, 1); PG8_STAGE(PG8_SB(0, 0), b2, voffB); PG8_STAGE(PG8_SB(0, 1), b2 + hsB, voffB); PG8_STAGE(PG8_SA(0, 0), a2, voffA);
            PG8_WAIT_V(8); PG8_WAIT_L(0); PG8_BAR; PG8_MMA(1, 0, At, B0); PG8_MMA(1, 1, At, B1); PG8_BAR; PG8_SCHED;
            PG8_LDB(B0, 1, 0); PG8_LDB(B1, 1, 1); PG8_SCHED; PG8_LDA(At, 1, 0); PG8_STAGE(PG8_SA(0, 1), a2 + hsA, voffA);
            PG8_WAIT_V(8); PG8_WAIT_L(0); PG8_BAR; PG8_MMA(0, 0, At, B0); PG8_MMA(0, 1, At, B1); PG8_BAR; PG8_SCHED;
            PG8_LDA(At, 1, 1); PG8_STAGE(PG8_SB(1, 0), b3, voffB); PG8_STAGE(PG8_SB(1, 1), b3 + hsB, voffB); PG8_STAGE(PG8_SA(1, 0), a3, voffA);
            PG8_WAIT_V(8); PG8_WAIT_L(0); PG8_BAR; PG8_MMA(1, 0, At, B0); PG8_MMA(1, 1, At, B1); PG8_BAR; PG8_SCHED;
            } else {
            PG8_LDB(B0, 0, 0); PG8_SCHED; PG8_LDA(At, 0, 0); PG8_STAGE(PG8_SA(1, 1), a1 + hsA, voffA);
            PG8_WAIT_L(8); PG8_BAR; PG8_WAIT_L(0); PG8_MMA(0, 0, At, B0); PG8_BAR; PG8_SCHED;
            PG8_LDB(B1, 0, 1); PG8_STAGE(PG8_SB(0, 0), b2, voffB);
            PG8_BAR; PG8_WAIT_L(0); PG8_MMA(0, 1, At, B1); PG8_BAR;
            PG8_LDA(At, 0, 1); PG8_STAGE(PG8_SA(0, 0), a2, voffA);
            PG8_BAR; PG8_WAIT_L(0); PG8_MMA(1, 0, At, B0); PG8_BAR; PG8_SCHED;
            PG8_STAGE(PG8_SB(0, 1), b2 + hsB, voffB);
            PG8_WAIT_V(6); PG8_BAR; PG8_MMA(1, 1, At, B1); PG8_BAR;
            PG8_LDB(B0, 1, 0); PG8_SCHED; PG8_LDA(At, 1, 0); PG8_STAGE(PG8_SA(0, 1), a2 + hsA, voffA);
            PG8_WAIT_L(8); PG8_BAR; PG8_WAIT_L(0); PG8_MMA(0, 0, At, B0); PG8_BAR; PG8_SCHED;
            PG8_LDB(B1, 1, 1); PG8_STAGE(PG8_SB(1, 0), b3, voffB);
            PG8_BAR; PG8_WAIT_L(0); PG8_MMA(0, 1, At, B1); PG8_BAR;
            PG8_LDA(At, 1, 1); PG8_STAGE(PG8_SA(1, 0), a3, voffA);
            PG8_BAR; PG8_WAIT_L(0); PG8_MMA(1, 0, At, B0); PG8_BAR; PG8_SCHED;
            PG8_STAGE(PG8_SB(1, 1), b3 + hsB, voffB);
            PG8_WAIT_V(6); PG8_BAR; PG8_MMA(1, 1, At, B1); PG8_BAR;
            }
        }
        if constexpr (ALIGN_EPI) { if (wr == 0) PG8_BAR; }
        if constexpr (!Epi::AFTER_DRAIN) { E(acc, cur, wr, wc, fr, fq); S.done(cur); }
        if (!has_next) break;
#pragma unroll
        for (int a = 0; a < 2; ++a)
#pragma unroll
            for (int b = 0; b < 2; ++b)
#pragma unroll
                for (int m = 0; m < 4; ++m)
#pragma unroll
                    for (int n = 0; n < 2; ++n) acc[a][b][m][n] = (f32x4){0.f, 0.f, 0.f, 0.f};
        cur = nxt; cA = nA; cB = nB; ++ui;
        if constexpr (ALIGN_EPI) { if (wr == 1) PG8_BAR; }
    }
    PG8_WAIT_V(0);
    if constexpr (!ALIGN_EPI) { if (wr == 0) PG8_BAR; }
    PG8_BAR;
#undef PG8_SA
#undef PG8_SB
#undef PG8_STAGE
#undef PG8_LDA
#undef PG8_LDB
#undef PG8_MMA
#undef PG8_WAIT_V
#undef PG8_WAIT_L
#undef PG8_BAR
#undef PG8_SCHED
}
}

namespace swa {
constexpr int D = 128;
constexpr float SCALE = 0.08838834764831845f;
constexpr float THR = 8.f;
constexpr int NW = 8, QBLK = 32, KVBLK = 64, QB = NW * QBLK;
constexpr int SHM_V = KVBLK * D * 2, SHM_K = KVBLK * D * 2;
constexpr int LDS_BYTES_ATT = 2 * SHM_V + 2 * SHM_K + NW * 64 * 4;
#define KSWZ(row, colB) ((row) * 256 + ((colB) ^ (((row) & 7) << 4)))
#define SBAR() __builtin_amdgcn_sched_barrier(0)
__device__ __forceinline__ int v_st(int k, int c) { const int kk = (k & ~0xC) | ((k & 4) << 1) | ((k & 8) >> 1); return ((kk >> 3) * 4 + (c >> 5)) * 512 + ((kk & 7) * 32 + (c & 31)) * 2; }
__device__ __forceinline__ int v_rd_base(int lane) { return ((lane & 3) << 3) | (((lane >> 2) & 3) << 6) | (((lane >> 4) & 1) << 5) | (((lane >> 5) & 1) << 8); }
constexpr int v_rd_off(int d0, int ks, int half) { return d0 * 512 + ks * 4096 + half * 2048; }
__device__ __forceinline__ int crow(int r, int hi) { return (r & 3) + 8 * (r >> 2) + 4 * hi; }
__device__ __forceinline__ bf16x8 load8(const bf16_t* p) { return *reinterpret_cast<const bf16x8*>(p); }
__device__ __forceinline__ void mask_tile(f32x16& p0, f32x16& p1, int dq, unsigned W) {
    const float NEG = -__builtin_inff();
#pragma unroll
    for (int r = 0; r < 16; ++r) {
        const int c = (r & 3) + 8 * (r >> 2);
        if ((unsigned)(dq - c) >= W) p0[r] = NEG;
        if ((unsigned)(dq - c - 32) >= W) p1[r] = NEG;
    }
}
__device__ __forceinline__ void partialSM(f32x16& p0, f32x16& p1, float& m_reg, float& mn, float& alpha) {
    float pmax = p0[0];
#pragma unroll
    for (int r = 1; r < 16; ++r) pmax = fmaxf(pmax, p0[r]);
#pragma unroll
    for (int r = 0; r < 16; ++r) pmax = fmaxf(pmax, p1[r]);
    { auto rr = __builtin_amdgcn_permlane32_swap(__float_as_uint(pmax), __float_as_uint(pmax), false, false);
      pmax = fmaxf(__uint_as_float(rr[0]), __uint_as_float(rr[1])); }
    constexpr float C2 = 1.4426950408889634f * SCALE;
    if (__builtin_expect(__all((pmax - m_reg) * SCALE <= THR), 1)) { mn = m_reg; alpha = 1.f; }
    else { mn = fmaxf(m_reg, pmax); alpha = __builtin_amdgcn_exp2f((m_reg - mn) * C2); m_reg = mn; }
    const float mnL = -mn * C2;
#pragma unroll
    for (int r = 0; r < 16; ++r) p0[r] = fmaf(p0[r], C2, mnL);
#pragma unroll
    for (int r = 0; r < 16; ++r) p1[r] = fmaf(p1[r], C2, mnL);
#pragma unroll
    for (int r = 0; r < 16; ++r) p0[r] = __builtin_amdgcn_exp2f(p0[r]);
}
__device__ __forceinline__ void finishSM(f32x16& p0, f32x16& p1, float alpha, float& l_reg, bf16x8& pa0, bf16x8& pa1, bf16x8& pa2, bf16x8& pa3) {
#pragma unroll
    for (int r = 0; r < 16; ++r) p1[r] = __builtin_amdgcn_exp2f(p1[r]);
    float ps = 0;
#pragma unroll
    for (int r = 0; r < 16; ++r) ps += p0[r];
#pragma unroll
    for (int r = 0; r < 16; ++r) ps += p1[r];
    { auto rr = __builtin_amdgcn_permlane32_swap(__float_as_uint(ps), __float_as_uint(ps), false, false);
      ps = __uint_as_float(rr[0]) + __uint_as_float(rr[1]); }
    l_reg = l_reg * alpha + ps;
#define PK4(P, B_, OUT) do { unsigned a0 = cvt_pk_bf16(P[B_+0], P[B_+1]), a1 = cvt_pk_bf16(P[B_+2], P[B_+3]);                          \
        unsigned b0 = cvt_pk_bf16(P[B_+4], P[B_+5]), b1 = cvt_pk_bf16(P[B_+6], P[B_+7]);                                             \
        auto r0 = __builtin_amdgcn_permlane32_swap(a0, b0, false, false); auto r1 = __builtin_amdgcn_permlane32_swap(a1, b1, false, false); \
        u32x4 w = {r0[0], r1[0], r0[1], r1[1]}; OUT = *reinterpret_cast<bf16x8*>(&w); } while (0)
    PK4(p0, 0, pa0); PK4(p0, 8, pa1); PK4(p1, 0, pa2); PK4(p1, 8, pa3);
#undef PK4
}
template <int KB, bool SK>
__device__ __forceinline__ void qkt(f32x16& p0, f32x16& p1, const char* K_lds, int r32, int hi, const bf16x8* qr, bool act) {
    if (SK && !act) { const float NEG = -__builtin_inff();
#pragma unroll
        for (int r = 0; r < 16; ++r) { p0[r] = NEG; p1[r] = NEG; } return; }
    p0 = f32x16{}; p1 = f32x16{};
    const char* kb[4];
#pragma unroll
    for (int dd = 0; dd < 4; ++dd) kb[dd] = K_lds + KB * SHM_K + KSWZ(r32, (dd * 16 + hi * 8) * 2);
#pragma unroll
    for (int d0 = 0; d0 < 8; ++d0) { const char* a = kb[d0 & 3] + (d0 >> 2) * 128;
        bf16x8 b0 = *reinterpret_cast<const bf16x8*>(a);
        bf16x8 b1 = *reinterpret_cast<const bf16x8*>(a + 32 * 256);
        p0 = __builtin_amdgcn_mfma_f32_32x32x16_bf16(b0, qr[d0], p0, 0, 0, 0);
        p1 = __builtin_amdgcn_mfma_f32_32x32x16_bf16(b1, qr[d0], p1, 0, 0, 0); }
}
template <int VB, bool SK>
__device__ __forceinline__ void pv_tile(f32x16* o, int vb0, bf16x8 pa0, bf16x8 pa1, bf16x8 pa2, bf16x8 pa3, bool act) {
    if (SK && !act) return;
#define TRRD(dst, off) asm volatile("ds_read_b64_tr_b16 %0, %1 offset:%2" : "=&v"(dst) : "v"(vb0), "i"(off) : "memory")
#define PV_D0(d0) do { s16x4 l0, l1, l2, l3, h0, h1, h2, h3; constexpr int b_ = VB * SHM_V + v_rd_off(d0, 0, 0); \
        TRRD(l0, b_); TRRD(h0, b_ + 2048); TRRD(l1, b_ + 4096); TRRD(h1, b_ + 6144); TRRD(l2, b_ + 8192); TRRD(h2, b_ + 10240); TRRD(l3, b_ + 12288); TRRD(h3, b_ + 14336); \
        asm volatile("s_waitcnt lgkmcnt(0)" ::: "memory"); SBAR();   \
        o[d0] = __builtin_amdgcn_mfma_f32_32x32x16_bf16(pa0, (bf16x8){l0[0], l0[1], l0[2], l0[3], h0[0], h0[1], h0[2], h0[3]}, o[d0], 0, 0, 0);   \
        o[d0] = __builtin_amdgcn_mfma_f32_32x32x16_bf16(pa1, (bf16x8){l1[0], l1[1], l1[2], l1[3], h1[0], h1[1], h1[2], h1[3]}, o[d0], 0, 0, 0);   \
        o[d0] = __builtin_amdgcn_mfma_f32_32x32x16_bf16(pa2, (bf16x8){l2[0], l2[1], l2[2], l2[3], h2[0], h2[1], h2[2], h2[3]}, o[d0], 0, 0, 0);   \
        o[d0] = __builtin_amdgcn_mfma_f32_32x32x16_bf16(pa3, (bf16x8){l3[0], l3[1], l3[2], l3[3], h3[0], h3[1], h3[2], h3[3]}, o[d0], 0, 0, 0); } while (0)
    PV_D0(0); PV_D0(1); PV_D0(2); PV_D0(3);
#undef PV_D0
#undef TRRD
}
struct BlockRef { const bf16_t* Q; const bf16_t* K; const bf16_t* V; int P0; int b, h; };
struct Seam { bf16x8 qr[8]; bf16x8 st_v0, st_v1, st_k0, st_k1; };
struct Ctx { float* OACC; bf16_t* CAT; const float* GATES; const unsigned long long* SEL; };
__device__ __forceinline__ int swa_jlo(int P0, int W) { const int lowk = P0 - W + 1; return lowk > 0 ? lowk / KVBLK : 0; }
#define ROWU(p, k0, h) ((p) + (size_t)((k0) + 32 * (h)) * D + loff)
#define VMW() asm volatile("s_waitcnt vmcnt(0)" ::: "memory")
#define VMWN(n) asm volatile("s_waitcnt vmcnt(%0)" :: "i"(n) : "memory")
#define SLOAD_H(Kp, Vp, k0) do { S.st_v0 = load8(ROWU(Vp, k0, 0)); S.st_v1 = load8(ROWU(Vp, k0, 1));              \
                         S.st_k0 = load8(ROWU(Kp, k0, 0)); S.st_k1 = load8(ROWU(Kp, k0, 1)); } while (0)
#define SWRITE_HK(bf) do { *(bf16x8*)(K_lds + (bf) * SHM_K + kws) = S.st_k0; *(bf16x8*)(K_lds + (bf) * SHM_K + kws + 32 * 256) = S.st_k1; } while (0)
#define SWRITE_HV(bf) do { *(bf16x8*)(V_lds + (bf) * SHM_V + vst0) = S.st_v0; *(bf16x8*)(V_lds + (bf) * SHM_V + vst1) = S.st_v1; } while (0)
#define SWRITE_H(bf) do { SWRITE_HV(bf); SWRITE_HK(bf); } while (0)
__device__ __forceinline__ void swa_prime(const BlockRef& cur, int W, char* lds, Seam& S, int wid, int lane) {
    const int tid = wid * 64 + lane, r32 = lane & 31, hi = lane >> 5;
    const int sr = tid >> 4, sc = (tid & 15) * 8, kws = KSWZ(sr, sc * 2); char* K_lds = lds + 2 * SHM_V;
    const unsigned loff = (unsigned)(sr * D + sc), qoff = (unsigned)(r32 * D + hi * 8);
    const int kb0 = swa_jlo(cur.P0, W) * KVBLK;
#pragma unroll
    for (int d0 = 0; d0 < 8; ++d0) S.qr[d0] = load8(cur.Q + (size_t)(wid * QBLK) * D + d0 * 16 + qoff);
    SLOAD_H(cur.K, cur.V, kb0); VMW(); SWRITE_HK(0);
    __syncthreads();
}
template <int MODE, bool SK>
__device__ __forceinline__ void swa_block(const BlockRef& cur, const BlockRef& nxt, int W, int Wn, char* lds, Seam& S, const Ctx& X, int wid, int lane) {
    constexpr int skv = 4096;
    const int tid = wid * 64 + lane, r32 = lane & 31, hi = lane >> 5;
    const int j_lo = swa_jlo(cur.P0, W);
    int j_hi = (cur.P0 + QB - 1) / KVBLK + 1; if (j_hi > skv / KVBLK) j_hi = skv / KVBLK;
    const int NT = j_hi - j_lo;
    const int kbn = swa_jlo(nxt.P0, Wn) * KVBLK;
    const int qlo = cur.P0 + wid * QBLK, qm = qlo + r32 - 4 * hi;
    char* V_lds = lds; char* K_lds = lds + 2 * SHM_V;
    float* ws = (float*)(lds + 2 * SHM_V + 2 * SHM_K) + wid * 64; float* li_l = ws, * al_l = ws + 32;
    float m_reg = -1e30f, l_reg = 0; f32x16 o[4] = {};
    const int sr = tid >> 4, sc = (tid & 15) * 8, vst0 = v_st(sr, sc), vst1 = v_st(32 + sr, sc), kws = KSWZ(sr, sc * 2);
    const unsigned loff = (unsigned)(sr * D + sc), qoff = (unsigned)(r32 * D + hi * 8);
    const int vb0 = (int)(uintptr_t)V_lds + v_rd_base(lane);
    const bf16_t* Kh = cur.K; const bf16_t* Vh = cur.V;
    unsigned long long sel_ = ~0ull;
    if constexpr (MODE == 1) sel_ = X.SEL[(size_t)(cur.b * NG + (cur.h >> 2)) * T + qlo + r32];
#define RESC(a) do { if (__any((a) < 1.f)) { if (hi == 0) al_l[r32] = (a); asm volatile("s_waitcnt lgkmcnt(0)" ::: "memory");              \
                     for (int d_ = 0; d_ < 4; ++d_) for (int r = 0; r < 16; ++r) o[d_][r] *= al_l[crow(r, hi)]; } } while (0)
#define KBASE(t) ((j_lo + (t)) * KVBLK)
#define ACT(t) (KBASE(t) <= qlo + QBLK - 1 && KBASE(t) + KVBLK - 1 >= qlo - W + 1)
#define MASKT(P0_, P1_, t) do { const int kb_ = KBASE(t); if ((!SK || ACT(t)) && (kb_ + KVBLK - 1 > qlo || kb_ <= qlo + QBLK - 1 - W)) mask_tile(P0_, P1_, qm - kb_, (unsigned)W); \
        if constexpr (MODE == 1) { if (!((sel_ >> (j_lo + (t))) & 1ull)) { const float NEG_ = -__builtin_inff(); _Pragma("unroll") for (int r_ = 0; r_ < 16; ++r_) { P0_[r_] = NEG_; P1_[r_] = NEG_; } } } } while (0)
    constexpr int NQL = 8;
#define SEAM_K0() do { VMWN(NQL); SWRITE_HK(0); SBAR(); } while (0)
    f32x16 pA0, pA1, pB0, pB1; float mnA, mnB, alA, alB; bf16x8 pa0, pa1, pa2, pa3;
    SWRITE_HV(0); SBAR();
    if (NT > 1) { SLOAD_H(Kh, Vh, KBASE(1)); }
    SBAR(); qkt<0, SK>(pA0, pA1, K_lds, r32, hi, S.qr, ACT(0));
    MASKT(pA0, pA1, 0); partialSM(pA0, pA1, m_reg, mnA, alA);
    if (NT > 1) { VMW(); SWRITE_H(1); }
    __syncthreads();
#define HALF_STEP(PX0, PX1, mnX, alX, PY0, PY1, alY, t, KB, VB, SB) do {                                                      \
        SBAR(); qkt<KB, SK>(PX0, PX1, K_lds, r32, hi, S.qr, ACT(t));                                             \
        finishSM(PY0, PY1, alY, l_reg, pa0, pa1, pa2, pa3); SBAR();                                                           \
        if ((t) + 1 < NT) { SLOAD_H(Kh, Vh, KBASE((t) + 1)); SBAR(); }                                               \
        pv_tile<VB, SK>(o, vb0, pa0, pa1, pa2, pa3, ACT((t) - 1)); MASKT(PX0, PX1, (t)); partialSM(PX0, PX1, m_reg, mnX, alX);                                        \
        __syncthreads();                                                                                                      \
        if ((t) + 1 < NT) { VMW(); SWRITE_H(SB); }                                                                          \
        RESC(alX); __syncthreads(); } while (0)
    for (int t = 1; t + 1 < NT; t += 2) {
        HALF_STEP(pB0, pB1, mnB, alB, pA0, pA1, alA, t, 1, 0, 0);
        HALF_STEP(pA0, pA1, mnA, alA, pB0, pB1, alB, t + 1, 0, 1, 1);
    }
    const bool even = (NT & 1) == 0;
    if (even) { SBAR(); qkt<1, SK>(pB0, pB1, K_lds, r32, hi, S.qr, ACT(NT - 1)); SBAR(); }
    SLOAD_H(nxt.K, nxt.V, kbn); SBAR();
#pragma unroll
    for (int d0 = 0; d0 < 8; ++d0) S.qr[d0] = load8(nxt.Q + (size_t)(wid * QBLK) * D + d0 * 16 + qoff);
    SBAR();
    finishSM(pA0, pA1, alA, l_reg, pa0, pa1, pa2, pa3); SBAR();
    pv_tile<0, SK>(o, vb0, pa0, pa1, pa2, pa3, ACT(even ? NT - 2 : NT - 1));
    if (even) { MASKT(pB0, pB1, NT - 1); partialSM(pB0, pB1, m_reg, mnB, alB); __syncthreads(); RESC(alB);
        finishSM(pB0, pB1, alB, l_reg, pa0, pa1, pa2, pa3); SBAR(); pv_tile<1, SK>(o, vb0, pa0, pa1, pa2, pa3, ACT(NT - 1)); }
    SBAR(); SEAM_K0();
    if (hi == 0) li_l[r32] = __builtin_amdgcn_rcpf(l_reg) * X.GATES[(size_t)(cur.b * T + qlo + r32) * 48 + 3 * cur.h + (MODE == 1 ? 1 : 2)];
    asm volatile("s_waitcnt lgkmcnt(0)" ::: "memory");
    float rli[16];
#pragma unroll
    for (int r = 0; r < 16; ++r) rli[r] = li_l[crow(r, hi)];
    int hie = hi; asm volatile("" : "+v"(hie));
    const unsigned eo = (unsigned)(4 * hie * D + r32), ec = (unsigned)(4 * hie * DM + r32);
    float* Ob = X.OACC + ((size_t)(cur.b * NH + cur.h) * T + qlo) * D;
    bf16_t* Cb = X.CAT + (size_t)(cur.b * T + qlo) * DM + cur.h * HD;
#pragma unroll
    for (int r = 0; r < 16; ++r) { const int cr = (r & 3) + 8 * (r >> 2);
        float* op = Ob + (size_t)cr * D + eo;
        float ov[4];
#pragma unroll
        for (int d0 = 0; d0 < 4; ++d0) ov[d0] = op[d0 * 32];
#pragma unroll
        for (int d0 = 0; d0 < 4; ++d0) { const float v = ov[d0] + o[d0][r] * rli[r];
            if constexpr (MODE == 1) { op[d0 * 32] = v; }
            else { const float vn = __shfl_xor(v, 1);
                   if ((r32 & 1) == 0) *(unsigned*)(Cb + (size_t)cr * DM + d0 * 32 + ec) = cvt_pk_bf16(v, vn); } }
        asm volatile("" ::: "memory"); }
    __syncthreads();
#undef RESC
#undef KBASE
#undef ACT
#undef MASKT
#undef SEAM_K0
#undef HALF_STEP
}
#undef ROWU
#undef VMW
#undef VMWN
#undef SLOAD_H
#undef SWRITE_HK
#undef SWRITE_HV
#undef SWRITE_H

__host__ __device__ inline int swa_nramp(int nqb, int W) { const int t = W - 1; const int n = t < 0 ? 0 : t / QB + 1; return n > nqb ? nqb : n; }
struct SwaItem { int bh, qb0, qb1; };
__device__ __forceinline__ SwaItem swa_decode(int L, int nqb, int nx, int nramp) {
    SwaItem it; const int xcd = L & 7, k = L >> 3; it.bh = xcd * 4 + k / nx; const int x = k % nx;
    const int ns = nqb - nramp;
    if (x < ns) { it.qb0 = it.qb1 = nqb - 1 - x; } else { it.qb0 = x - ns; it.qb1 = nramp - 1 - it.qb0; }
    return it;
}
template <int MODE>
__device__ __forceinline__ BlockRef swa_ref(const SwaItem& it, int pass, const bf16_t* Q, const bf16_t* K, const bf16_t* V) {
    const int qb = pass ? it.qb1 : it.qb0, kvh = it.bh >> 2;
    BlockRef r; r.Q = Q + ((size_t)it.bh * T + (size_t)qb * QB) * D; r.K = K + (size_t)kvh * T * D; r.V = V + (size_t)kvh * T * D; r.P0 = qb * QB; r.b = it.bh >> 4; r.h = it.bh & 15;
    return r;
}
template <int MODE, bool SK>
__device__ __forceinline__ void swa_phase(char* lds, const bf16_t* Q, const bf16_t* K, const bf16_t* V, const Ctx& X, int W, int Wdeal, int c, int G, int wid, int lane) {
    constexpr int nqb = T / QB;
    const int nramp = swa_nramp(nqb, Wdeal),
               nx = (nramp + 1) / 2 + (nqb - nramp), total = nx * NB * NH;
    int L = c; if (L >= total) return;
    SwaItem it = swa_decode(L, nqb, nx, nramp); int pass = 0;
    BlockRef cur = swa_ref<MODE>(it, 0, Q, K, V);
    Seam S;
    swa_prime(cur, W, lds, S, wid, lane);
    for (;;) {
        const bool more_pass = pass == 0 && it.qb1 != it.qb0, more_item = L + G < total, last = !more_pass && !more_item;
        SwaItem itn = it; int passn = pass + 1, Ln = L;
        if (!more_pass) { passn = 0; Ln = more_item ? L + G : L; itn = swa_decode(Ln, nqb, nx, nramp); }
        const BlockRef nxt = last ? cur : swa_ref<MODE>(itn, passn, Q, K, V);
        swa_block<MODE, SK>(cur, nxt, W, W, lds, S, X, wid, lane);
        if (last) break;
        cur = nxt; it = itn; pass = passn; L = Ln;
    }
}
}

#define XB_TMO      128
#define XB_XCNT(j)  (256  + 64 * (j))
#define XB_XSUB(j)  (1280 + 64 * (j))
#define XB_XGEN(j)  (2304 + 64 * (j))
#define XB_TOP      3328
#define XB_TOPGEN   3392
#define XCD_BAR_WORDS 3456
#define XB_SPIN_CAP (1u << 18)
__device__ __forceinline__ unsigned xb_ld(unsigned* p)              { return __hip_atomic_load(p, __ATOMIC_RELAXED, __HIP_MEMORY_SCOPE_AGENT); }
__device__ __forceinline__ unsigned xb_add(unsigned* p, unsigned v) { return __hip_atomic_fetch_add(p, v, __ATOMIC_RELAXED, __HIP_MEMORY_SCOPE_AGENT); }
__device__ __forceinline__ unsigned xb_xcc_id() { return (unsigned)__builtin_amdgcn_s_getreg((3 << 11) | 20) & 0xFu; }
#define XB_SPIN(cond, bar) do { unsigned _sp = 0; while (cond) { __builtin_amdgcn_s_sleep(1); \
    if ((++_sp & 255u) == 0u) { if (xb_ld(&(bar)[XB_TMO])) break; if (_sp > XB_SPIN_CAP) { atomicAdd(&(bar)[XB_TMO], 1u); break; } } } } while (0)
struct XcdBarrier { unsigned* bar; unsigned x; volatile LAS unsigned* st; };
__device__ __forceinline__ XcdBarrier xcd_barrier_post(unsigned* bar, volatile LAS unsigned* st, bool t0) {
    XcdBarrier b; b.bar = bar; b.x = xb_xcc_id(); b.st = st;
    if (t0) (void)xb_add(&bar[XB_XCNT(b.x)], 1u);
    return b;
}
__device__ __forceinline__ void xcd_barrier_complete(unsigned* bar, unsigned x, unsigned& nloc, unsigned& nx) {
    const unsigned G = gridDim.x * gridDim.y * gridDim.z;
    unsigned sum, cnt, mine, sp = 0u;
    for (;;) {
        sum = 0u; cnt = 0u; mine = 0u;
#pragma unroll
        for (unsigned j = 0; j < 16; ++j) { const unsigned c = xb_ld(&bar[XB_XCNT(j)]); sum += c; cnt += (c > 0u) ? 1u : 0u; mine = (j == x) ? c : mine; }
        if (sum == G) break;
        __builtin_amdgcn_s_sleep(1);
        if ((++sp & 255u) == 0u) { if (xb_ld(&bar[XB_TMO])) break; if (sp > XB_SPIN_CAP) { atomicAdd(&bar[XB_TMO], 1u); break; } }
    }
    nloc = mine > 0u ? mine : 1u; nx = cnt > 0u ? cnt : 1u;
}
__device__ __forceinline__ void xcd_barrier(const XcdBarrier& b, bool t0) {
    asm volatile("s_waitcnt vmcnt(0)" ::: "memory");
    __syncthreads();
    if (t0) {
        unsigned* bar = b.bar;
        __builtin_amdgcn_s_waitcnt(0);
        unsigned nloc = b.st[0], nx = b.st[1];
        if (nloc == 0u) { xcd_barrier_complete(bar, b.x, nloc, nx); b.st[0] = nloc; b.st[1] = nx; }
        const unsigned old = xb_add(&bar[XB_XSUB(b.x)], 1u);
        const unsigned gen = old / nloc;
        if (old + 1u == (gen + 1u) * nloc) {
            __builtin_amdgcn_fence(__ATOMIC_RELEASE, "agent");
            asm volatile("s_waitcnt vmcnt(0)" ::: "memory");
            const unsigned og = xb_add(&bar[XB_TOP], 1u);
            const unsigned tg = og / nx;
            if (og + 1u == (tg + 1u) * nx) xb_add(&bar[XB_TOPGEN], 1u);
            else XB_SPIN(xb_ld(&bar[XB_TOPGEN]) == tg, bar);
            __builtin_amdgcn_fence(__ATOMIC_ACQUIRE, "agent");
            xb_add(&bar[XB_XGEN(b.x)], 1u);
            asm volatile("s_waitcnt vmcnt(0)" ::: "memory");
        } else {
            XB_SPIN(xb_ld(&bar[XB_XGEN(b.x)]) == gen, bar);
            __builtin_amdgcn_fence(__ATOMIC_ACQUIRE, "agent");
            asm volatile("s_waitcnt vmcnt(0)" ::: "memory");
        }
    }
    __syncthreads();
}

struct Args {
    const float* in[24]; float* out; unsigned char* ws; int ph_lo, ph_hi, G, pad;
};
__device__ __forceinline__ float wave_sum(float v) {
#pragma unroll
    for (int o = 1; o < 64; o <<= 1) v += __shfl_xor(v, o);
    return v;
}
__device__ __forceinline__ f32x4 mfma16(bf16x8 a, bf16x8 b, f32x4 c) { return __builtin_amdgcn_mfma_f32_16x16x32_bf16(a, b, c, 0, 0, 0); }

__device__ __forceinline__ void tr_load(const float* W, int ldw, int k0, int n0, int lane, f32x4 (&v)[16]) {
    const float* src = W + (size_t)(k0 + (lane >> 4)) * ldw + n0 + 4 * (lane & 15);
#pragma unroll
    for (int i = 0; i < 16; ++i) v[i] = __builtin_nontemporal_load((const f32x4*)(src + (size_t)(4 * i) * ldw));
}
__device__ __forceinline__ void tr_finish(const f32x4 (&v)[16], int k0, bf16_t* WT, size_t drow0, int ldt, LAS float* scr, int lane, const float* gn  ) {
#pragma unroll
    for (int i = 0; i < 16; ++i) { LAS float* s = scr + ((lane >> 4) + 4 * i) * 65 + 4 * (lane & 15); s[0] = v[i][0]; s[1] = v[i][1]; s[2] = v[i][2]; s[3] = v[i][3]; }
    LDS_WAIT();
    const int c = lane & 7;
    f32x4 g0 = {1.f, 1.f, 1.f, 1.f}, g1 = {1.f, 1.f, 1.f, 1.f};
    if (gn) { g0 = *(const f32x4*)(gn + 8 * c); g1 = *(const f32x4*)(gn + 8 * c + 4); }
#pragma unroll
    for (int j = 0; j < 8; ++j) { const int n = (lane >> 3) + 8 * j; const LAS float* s = scr + (8 * c) * 65 + n;
        u32x4 o; o.x = cvt_pk_bf16(s[0 * 65] * g0[0], s[1 * 65] * g0[1]); o.y = cvt_pk_bf16(s[2 * 65] * g0[2], s[3 * 65] * g0[3]); o.z = cvt_pk_bf16(s[4 * 65] * g1[0], s[5 * 65] * g1[1]); o.w = cvt_pk_bf16(s[6 * 65] * g1[2], s[7 * 65] * g1[3]);
        *(u32x4*)(WT + (drow0 + n) * (size_t)ldt + k0 + 8 * c) = o; }
    LDS_WAIT();
}
__device__ __forceinline__ void rms_row_bf16(const float* xrow, const float* gain, bf16_t* orow, int lane) {
    const f32x4* xr = (const f32x4*)xrow + lane; const f32x4* gr = (const f32x4*)gain + lane;
    f32x4 v[16]; float s = 0.f;
#pragma unroll
    for (int j = 0; j < 16; ++j) { v[j] = xr[64 * j]; s += (v[j][0] * v[j][0] + v[j][1] * v[j][1]) + (v[j][2] * v[j][2] + v[j][3] * v[j][3]); }
    const float r = 1.0f / sqrtf(wave_sum(s) * (1.0f / DM) + EPS);
    u32x2* o8 = (u32x2*)orow + lane;
#pragma unroll
    for (int j = 0; j < 16; ++j) { const f32x4 g = gr[64 * j]; u32x2 w; w.x = cvt_pk_bf16(v[j][0] * r * g[0], v[j][1] * r * g[1]); w.y = cvt_pk_bf16(v[j][2] * r * g[2], v[j][3] * r * g[3]); o8[64 * j] = w; }
}
__device__ __forceinline__ void rms_row_f32(const float* xrow, const float* gain, float* orow, int lane) {
    const f32x4* xr = (const f32x4*)xrow + lane; const f32x4* gr = (const f32x4*)gain + lane;
    f32x4 v[16]; float s = 0.f;
#pragma unroll
    for (int j = 0; j < 16; ++j) { v[j] = xr[64 * j]; s += (v[j][0] * v[j][0] + v[j][1] * v[j][1]) + (v[j][2] * v[j][2] + v[j][3] * v[j][3]); }
    const float r = 1.0f / sqrtf(wave_sum(s) * (1.0f / DM) + EPS);
    f32x4* o = (f32x4*)orow + lane;
#pragma unroll
    for (int j = 0; j < 16; ++j) { const f32x4 g = gr[64 * j]; o[64 * j] = v[j] * r * g; }
}

__device__ const float ROPE_INV_FREQ[16] = {1.0f, 0.44036659598350525f, 0.1939227432012558f, 0.08539710193872452f, 0.03760603070259094f, 0.01656043902039528f, 0.007292664609849453f,
    0.0032114458736032248f, 0.0014142135623842478f, 0.000622772378847003f, 0.00027424818836152554f, 0.00012076973507646471f, 5.318296098266728e-05f, 2.34199997066753e-05f,
    1.0313386155758053e-05f, 4.541670477919979e-06f};

__device__ __forceinline__ void compress_item(LAS unsigned char* lds, int which, int rt, const bf16_t* X0, const float* cb, const bf16_t* W1, const bf16_t* W2,
                                              bf16_t* KCMP, bf16_t* VCMPT, int wave, int lane) {
    const int fr = lane & 15, q4 = lane >> 4;
    const int bgi = (rt * 16) >> 8, n = ((rt * 16) & 255) + fr;
    const bf16_t* X = X0 + (size_t)bgi * T * HD + 8 * q4;
    f32x4 acc0 = {0.f, 0.f, 0.f, 0.f}, acc1 = {0.f, 0.f, 0.f, 0.f};
    const bf16_t* w1p = W1 + (size_t)(32 * wave + fr) * 4096 + 8 * q4;
#define CMP_LOADG(gq, A, B0, B1) do { _Pragma("unroll") for (int j = 0; j < 8; ++j) { const int ks = 8 * (gq) + j; int tok = 16 * n + 2 * (gq) + (j >> 2); tok = tok > (T - 1) ? (T - 1) : tok; \
        A[j] = *(const bf16x8*)(X + (size_t)tok * HD + 32 * (j & 3)); B0[j] = *(const bf16x8*)(w1p + 32 * ks); B1[j] = *(const bf16x8*)(w1p + (size_t)16 * 4096 + 32 * ks); } } while (0)
#define CMP_COMPG(A, B0, B1) do { _Pragma("unroll") for (int j = 0; j < 8; ++j) { acc0 = mfma16(A[j], B0[j], acc0); acc1 = mfma16(A[j], B1[j], acc1); } } while (0)
    bf16x8 a_0[8], b0_0[8], b1_0[8], a_1[8], b0_1[8], b1_1[8];
    CMP_LOADG(0, a_0, b0_0, b1_0);
    for (int gq = 0; gq < 16; gq += 2) {
        CMP_LOADG(gq + 1, a_1, b0_1, b1_1);
        CMP_COMPG(a_0, b0_0, b1_0);
        if (gq + 2 < 16) CMP_LOADG(gq + 2, a_0, b0_0, b1_0);
        CMP_COMPG(a_1, b0_1, b1_1);
    }
#undef CMP_LOADG
#undef CMP_COMPG
    const float cb0 = cb[32 * wave + fr], cb1 = cb[32 * wave + 16 + fr];
    LAS unsigned short* hid = (LAS unsigned short*)lds;
#pragma unroll
    for (int i = 0; i < 4; ++i) {
        hid[(4 * q4 + i) * 264 + 32 * wave + fr] = (unsigned short)(cvt_pk_bf16(gelu_tanh(acc0[i] + cb0), 0.f) & 0xffffu);
        hid[(4 * q4 + i) * 264 + 32 * wave + 16 + fr] = (unsigned short)(cvt_pk_bf16(gelu_tanh(acc1[i] + cb1), 0.f) & 0xffffu);
    }
    LDS_WAIT(); __syncthreads();
    f32x4 o = {0.f, 0.f, 0.f, 0.f};
    const bf16_t* w2p = W2 + (size_t)(16 * wave + fr) * 256 + 8 * q4;
#pragma unroll
    for (int ks = 0; ks < 8; ++ks) { const bf16x8 a2 = *(const LAS bf16x8*)(hid + fr * 264 + 32 * ks + 8 * q4); const bf16x8 b2 = *(const bf16x8*)(w2p + 32 * ks); o = mfma16(a2, b2, o); }
    const int nn = ((rt * 16) & 255) + 4 * q4, dcol = 16 * wave + fr;
    if (which == 0) {
#pragma unroll
        for (int i = 0; i < 4; ++i) KCMP[((size_t)bgi * 256 + nn + i) * HD + dcol] = (bf16_t)(cvt_pk_bf16(o[i], 0.f) & 0xffffu);
    } else {
        u32x2 w; w.x = cvt_pk_bf16(o[0], o[1]); w.y = cvt_pk_bf16(o[2], o[3]);
        *(u32x2*)(VCMPT + ((size_t)bgi * HD + dcol) * 256 + nn) = w;
    }
    __syncthreads();
}

__device__ __forceinline__ void cmp_attn_item(LAS unsigned char* lds, int bg, int tt, const bf16_t* QH, const bf16_t* KCMP, const bf16_t* VCMPT, const float* GATES,
                                              float* OACC, unsigned long long* SEL, int wave, int lane) {
    const int fr = lane & 15, q4 = lane >> 4, b = bg >> 2, g = bg & 3;
    const int t0w = tt * 32 + wave * 4;
    LAS unsigned short* pL = (LAS unsigned short*)(lds + wave * 16640);
    LAS float* impL = (LAS float*)(lds + wave * 16640 + 8448);
    LAS float* scL = (LAS float*)(lds + wave * 16640 + 8448 + 4160);
    const bf16_t* qrow = QH + ((size_t)((b * NH + g * 4 + (fr & 3)) * T + t0w + (fr >> 2))) * HD + 8 * q4;
    bf16x8 aq[4];
#pragma unroll
    for (int ks = 0; ks < 4; ++ks) aq[ks] = *(const bf16x8*)(qrow + 32 * ks);
    const bf16_t* kb = KCMP + (size_t)bg * 256 * HD + (size_t)fr * HD + 8 * q4;
    const int nlast = (t0w + 3 >= 31) ? ((t0w + 3 - 31) >> 4) : -1, Tmax = nlast >> 4, Kmax = nlast >> 5;
    f32x4 s[16];
#pragma unroll
    for (int Tt = 0; Tt < 16; ++Tt) { f32x4 a = {0.f, 0.f, 0.f, 0.f};
        if (Tt <= Tmax) {
#pragma unroll
            for (int ks = 0; ks < 4; ++ks) { const bf16x8 bk = *(const bf16x8*)(kb + (size_t)(16 * Tt) * HD + 32 * ks); a = mfma16(aq[ks], bk, a); } }
        s[Tt] = a; }
    const int t = t0w + q4;
    const int nmax = (t >= 31) ? ((t - 31) >> 4) : -1;
    const float NEGI = -__builtin_inff();
    float mx[4] = {NEGI, NEGI, NEGI, NEGI};
#pragma unroll
    for (int Tt = 0; Tt < 16; ++Tt) { const bool valid = (16 * Tt + fr) <= nmax;
#pragma unroll
        for (int i = 0; i < 4; ++i) mx[i] = valid ? fmaxf(mx[i], s[Tt][i]) : mx[i]; }
#pragma unroll
    for (int i = 0; i < 4; ++i) {
#pragma unroll
        for (int o = 1; o < 16; o <<= 1) mx[i] = fmaxf(mx[i], __shfl_xor(mx[i], o)); }
    constexpr float C2 = 1.4426950408889634f * 0.08838834764831845f;
    float sum[4] = {0.f, 0.f, 0.f, 0.f};
#pragma unroll
    for (int Tt = 0; Tt < 16; ++Tt) { const bool valid = (16 * Tt + fr) <= nmax;
#pragma unroll
        for (int i = 0; i < 4; ++i) { const float p = valid ? __builtin_amdgcn_exp2f((s[Tt][i] - mx[i]) * C2) : 0.f; s[Tt][i] = p; sum[i] += p; } }
#pragma unroll
    for (int i = 0; i < 4; ++i) {
#pragma unroll
        for (int o = 1; o < 16; o <<= 1) sum[i] += __shfl_xor(sum[i], o);
        sum[i] = sum[i] > 0.f ? 1.0f / sum[i] : 0.f; }
#pragma unroll
    for (int Tt = 0; Tt < 16; ++Tt) {
#pragma unroll
        for (int i = 0; i < 4; ++i) s[Tt][i] *= sum[i];
        impL[q4 * 260 + 16 * Tt + fr] = ((s[Tt][0] + s[Tt][1]) + s[Tt][2]) + s[Tt][3];
#pragma unroll
        for (int i = 0; i < 4; ++i) pL[(4 * q4 + i) * 264 + 16 * Tt + fr] = (unsigned short)(cvt_pk_bf16(s[Tt][i], 0.f) & 0xffffu);
    }
    LDS_WAIT();
    bf16x8 pf[8];
#pragma unroll
    for (int ks = 0; ks < 8; ++ks) pf[ks] = *(const LAS bf16x8*)(pL + fr * 264 + 32 * ks + 8 * q4);
    const bf16_t* vb = VCMPT + (size_t)bg * HD * 256 + (size_t)fr * 256 + 8 * q4;
    float gt[4];
#pragma unroll
    for (int i = 0; i < 4; ++i) gt[i] = GATES[(size_t)(b * T + t) * 48 + 3 * (g * 4 + i) + 0];
#pragma unroll
    for (int Dt = 0; Dt < 8; ++Dt) { f32x4 o = {0.f, 0.f, 0.f, 0.f};
#pragma unroll
        for (int ks = 0; ks < 8; ++ks) if (ks <= Kmax) { const bf16x8 bv = *(const bf16x8*)(vb + (size_t)(16 * Dt) * 256 + 32 * ks); o = mfma16(pf[ks], bv, o); }
#pragma unroll
        for (int i = 0; i < 4; ++i) OACC[((size_t)((b * NH + g * 4 + i) * T + t)) * HD + 16 * Dt + fr] = o[i] * gt[i]; }
    const LAS float* im = impL + q4 * 260;
    const int cur = t >> 6;
    float myv[4];
#pragma unroll
    for (int k = 0; k < 4; ++k) { const int jj = fr + 16 * k;
        const float m0 = jj > 0 ? im[4 * jj - 1] : 0.f, m1 = im[4 * jj], m2 = im[4 * jj + 1], m3 = im[4 * jj + 2], nx = im[4 * jj + 3];
        float sc = (((m0 + m1) + m2) + m3) - 0.5f * m0 + 0.5f * nx;
        sc = (jj == cur || jj == 0) ? 1e30f : (jj > cur ? -1e30f : sc);
        myv[k] = sc; scL[q4 * 64 + jj] = sc; }
    LDS_WAIT();
    int rank[4] = {0, 0, 0, 0};
#pragma unroll 8
    for (int i = 0; i < 64; ++i) { const float si = scL[q4 * 64 + i];
#pragma unroll
        for (int k = 0; k < 4; ++k) rank[k] += ((si > myv[k]) || (si == myv[k] && i < fr + 16 * k)) ? 1 : 0; }
    unsigned long long msk = 0ull;
#pragma unroll
    for (int k = 0; k < 4; ++k) { const unsigned long long bal = __ballot(rank[k] < 16); msk |= ((bal >> (16 * q4)) & 0xffffull) << (16 * k); }
    if (fr == 0) SEL[(size_t)bg * T + t] = msk;
    LDS_WAIT();
}

__device__ __forceinline__ void gate_task(LAS unsigned char* lds, int g, int dq, int bc0, int nbc, const bf16_t* V, bf16_t* U, const float* SUMS, const float* ln_g, const float* ln_b,
                                          const bf16_t* WM, const float* bs, int tid, int wave, int lane) {
    const int fr = lane & 15, q4 = lane >> 4;
    const int col0 = g * 768 + dq * 128;
    const int cc = tid & 15, s0 = tid >> 4;
    const f32x4 lg0 = *(const f32x4*)(ln_g + col0 + 8 * cc), lg1 = *(const f32x4*)(ln_g + col0 + 8 * cc + 4), lb0 = *(const f32x4*)(ln_b + col0 + 8 * cc), lb1 = *(const f32x4*)(ln_b + col0 + 8 * cc + 4);
    bf16x8 wf[4];
    const bf16_t* wp = WM + ((size_t)g * 128 + 16 * wave + fr) * 128 + 8 * q4;
#pragma unroll
    for (int ks = 0; ks < 4; ++ks) wf[ks] = *(const bf16x8*)(wp + 32 * ks);
    const int tt = 16 * wave + fr, kmax = wave >> 1;
    const float bias = bs[g * 128 + tt];
    const unsigned kf = (unsigned)((fr >> 3) ^ ((fr & 7) << 1)), rdl = ((unsigned)q4 ^ kf) << 4;
    u32x4 vraw[4]; f32x2 st[4];
    const bf16_t* vp = V + (size_t)(bc0 * 128 + s0) * GW + col0 + 8 * cc;
    const float* sp = SUMS + (size_t)(bc0 * 128 + s0) * 2;
#pragma unroll
    for (int j = 0; j < 4; ++j) { vraw[j] = *(const u32x4*)(vp + (size_t)(32 * j) * GW); st[j] = *(const f32x2*)(sp + 64 * j); }
    for (int i = 0; i < nbc; ++i) {
        const int row0 = (bc0 + i) * 128;
#pragma unroll
        for (int j = 0; j < 4; ++j) { const int sidx = s0 + 32 * j;
            const float mean = st[j][0] * (1.0f / GW); float var = st[j][1] * (1.0f / GW) - mean * mean; var = var > 0.f ? var : 0.f; const float rstd = 1.0f / sqrtf(var + EPS);
            const float x[8] = {bflo(vraw[j].x), bfhi(vraw[j].x), bflo(vraw[j].y), bfhi(vraw[j].y), bflo(vraw[j].z), bfhi(vraw[j].z), bflo(vraw[j].w), bfhi(vraw[j].w)};
#pragma unroll
            for (int e = 0; e < 8; ++e) { const float gg = e < 4 ? lg0[e & 3] : lg1[e & 3], bb = e < 4 ? lb0[e & 3] : lb1[e & 3];
                const float y = (x[e] - mean) * rstd * gg + bb;
                const unsigned off = (unsigned)(8 * cc + e) * 256u + ((((unsigned)(sidx >> 3)) ^ ((unsigned)cc ^ (unsigned)(2 * e))) & 15u) * 16u + (unsigned)(sidx & 7) * 2u;
                *(LAS unsigned short*)(lds + off) = (unsigned short)(cvt_pk_bf16(y, 0.f) & 0xffffu); } }
        if (i + 1 < nbc) {
            const bf16_t* vn = V + (size_t)(row0 + 128 + s0) * GW + col0 + 8 * cc; const float* sn = SUMS + (size_t)(row0 + 128 + s0) * 2;
#pragma unroll
            for (int j = 0; j < 4; ++j) { vraw[j] = *(const u32x4*)(vn + (size_t)(32 * j) * GW); st[j] = *(const f32x2*)(sn + 64 * j); } }
        bf16_t* up = U + (size_t)(row0 + tt) * GW + col0 + 4 * q4;
        u32x2 u4[8];
#pragma unroll
        for (int nt = 0; nt < 8; ++nt) u4[nt] = *(const u32x2*)(up + 16 * nt);
        LDS_WAIT(); __syncthreads();
#pragma unroll
        for (int nt = 0; nt < 8; ++nt) { f32x4 acc = {0.f, 0.f, 0.f, 0.f};
#pragma unroll
            for (int ks = 0; ks < 4; ++ks) if (ks <= kmax) { const bf16x8 af = *(const LAS bf16x8*)(lds + (unsigned)(16 * nt + fr) * 256u + ((unsigned)(((4 * ks) ^ (2 * nt)) << 4) ^ rdl)); acc = mfma16(af, wf[ks], acc); }
            u32x2 w; w.x = cvt_pk_bf16(bflo(u4[nt].x) * (acc[0] + bias), bfhi(u4[nt].x) * (acc[1] + bias)); w.y = cvt_pk_bf16(bflo(u4[nt].y) * (acc[2] + bias), bfhi(u4[nt].y) * (acc[3] + bias));
            *(u32x2*)(up + 16 * nt) = w; }
        __syncthreads();
    }
}

template <int W> __device__ __forceinline__ void pool_chunk(const bf16_t* PIN, bf16_t* POOLED, int row, int c8) {
    const int t = row & (T - 1), cnt = (t + 1) < W ? (t + 1) : W;
    u32x4 v[W];
#pragma unroll
    for (int i = 0; i < W; ++i) { const int ri = (i <= t) ? row - i : row; v[i] = *(const u32x4*)(PIN + (size_t)ri * 2048 + c8); }
    float sm[8] = {0.f, 0.f, 0.f, 0.f, 0.f, 0.f, 0.f, 0.f};
#pragma unroll
    for (int i = 0; i < W; ++i) { const float k = (i <= t) ? 1.f : 0.f;
        sm[0] += k * bflo(v[i].x); sm[1] += k * bfhi(v[i].x); sm[2] += k * bflo(v[i].y); sm[3] += k * bfhi(v[i].y); sm[4] += k * bflo(v[i].z); sm[5] += k * bfhi(v[i].z); sm[6] += k * bflo(v[i].w); sm[7] += k * bfhi(v[i].w); }
    const float fc = (float)cnt; const u32x4 cur = v[0];
    u32x4 w; w.x = cvt_pk_bf16(sm[0] / fc - bflo(cur.x), sm[1] / fc - bfhi(cur.x)); w.y = cvt_pk_bf16(sm[2] / fc - bflo(cur.y), sm[3] / fc - bfhi(cur.y));
    w.z = cvt_pk_bf16(sm[4] / fc - bflo(cur.z), sm[5] / fc - bfhi(cur.z)); w.w = cvt_pk_bf16(sm[6] / fc - bflo(cur.w), sm[7] / fc - bfhi(cur.w));
    *(u32x4*)(POOLED + (size_t)row * 2048 + c8) = w;
}

constexpr int N_PHASES = 19;
constexpr int I_INE1 = 64 * 80, I_INE2 = 64 * 32, I_OUTE = 64 * 64, I_G = 64 * 172, I_DN = 172 * 64, I_INO = 64 * 384, I_OUTO = 192 * 64, I_POOL = 8 * 8, I_C1 = 64 * 4, I_C2 = 4 * 2;
constexpr int NIT_A = I_INE1 + I_INE2 + 4 * I_POOL + 2 * I_C1 + 2 * I_C2;
constexpr int NIT_P0 = NIT_A + 4 * I_G + I_INO;
constexpr int NIT_C3 = NIT_A + 12288;
constexpr int NIT_T1 = NIT_P0 + I_DN + I_OUTE;
constexpr int NIT_T8 = NIT_T1 + I_OUTO;
constexpr int NITEMS = NIT_T8 + I_DN;
#ifndef PH_MASK
#define PH_MASK 0x7FFFF
#endif
typedef const __attribute__((address_space(4))) Args* KArgs;
__device__ __forceinline__ KArgs kargs() { unsigned long long v = (unsigned long long)__builtin_amdgcn_kernarg_segment_ptr(); asm volatile("" : "+s"(v)); return (KArgs)v; }
#define WSP(type, off) ((type*)(ws + (off)))

struct ConvJob { int cnt, in_idx; unsigned src_off; unsigned long long dst_off; int ldw, K, nblk, col0, drow0, mode, gain_idx, gain_off; };
__device__ const ConvJob CONV_JOBS[19] = {
    {I_INE1, 2, 0u, O_W_INE, IN_EVEN, 4096, 80, 0, 0, 0, -1, 0},
    {I_INE2, 2, 0u, O_W_INE, IN_EVEN, 4096, 32, 5168, 5120, 0, -1, 0},
    {I_POOL, 9, 0u, O_W_POOL, 512, 512, 8, 0, 0, 0, -1, 0},
    {I_POOL, 9, 1u * 512 * 512, O_W_POOL + 1ull * 512 * 512 * 2, 512, 512, 8, 0, 0, 0, -1, 0},
    {I_POOL, 9, 2u * 512 * 512, O_W_POOL + 2ull * 512 * 512 * 2, 512, 512, 8, 0, 0, 0, -1, 0},
    {I_POOL, 9, 3u * 512 * 512, O_W_POOL + 3ull * 512 * 512 * 2, 512, 512, 8, 0, 0, 0, -1, 0},
    {I_C1, 5, 0u, O_W_C1K, 256, 4096, 4, 0, 0, 0, -1, 0},
    {I_C1, 7, 0u, O_W_C1V, 256, 4096, 4, 0, 0, 0, -1, 0},
    {I_C2, 6, 0u, O_W_C2K, 128, 256, 2, 0, 0, 0, -1, 0},
    {I_C2, 8, 0u, O_W_C2V, 128, 256, 2, 0, 0, 0, -1, 0},
    {I_G, 20, 0u, O_W_GU0, FF, 4096, 172, 0, 0, 1, 19, 0},
    {I_G, 21, 0u, O_W_GU0, FF, 4096, 172, 0, 128, 1, 19, 0},
    {I_G, 20, (unsigned)(DM * FF), O_W_GU1, FF, 4096, 172, 0, 0, 1, 19, DM},
    {I_G, 21, (unsigned)(DM * FF), O_W_GU1, FF, 4096, 172, 0, 128, 1, 19, DM},
    {I_INO, 13, 0u, O_W_INO, 2 * GW, 4096, 384, 0, 0, 0, 12, 0},
    {I_DN, 22, 0u, O_W_DN0, 4096, FF, 64, 0, 0, 0, -1, 0},
    {I_OUTE, 11, 0u, O_W_OUTE, 4096, 4096, 64, 0, 0, 0, -1, 0},
    {I_OUTO, 18, 0u, O_W_OUTO, 4096, GW, 64, 0, 0, 0, -1, 0},
    {I_DN, 22, (unsigned)(DM * FF), O_W_DN1, 4096, FF, 64, 0, 0, 0, -1, 0}};
#define CONV_DECODE(it_, osrc, odst, oldw, oK, k0, n0, drow, ogn) const float* osrc; bf16_t* odst; const float* ogn; int oldw, oK, k0, n0, drow; { \
            int r = (it_), j = 0; while (j < 18 && r >= CONV_JOBS[j].cnt) { r -= CONV_JOBS[j].cnt; ++j; } \
            const ConvJob jb = CONV_JOBS[j]; \
            const int kb = r / jb.nblk, nb = r - kb * jb.nblk, n0l = nb * 64; k0 = kb * 64; n0 = jb.col0 + n0l; \
            drow = jb.mode ? (256 * (n0l >> 7) + (n0l & 127) + jb.drow0) : (jb.drow0 + n0l); \
            osrc = ap->in[jb.in_idx] + jb.src_off; odst = (bf16_t*)(ws + jb.dst_off); oldw = jb.ldw; oK = jb.K; ogn = jb.gain_idx >= 0 ? ap->in[jb.gain_idx] + jb.gain_off + k0 : nullptr; }
#define CONV_RANGE(lo_, hi_, first_, stride_) do { LAS float* scr = (LAS float*)(lds + RING_OFF + wave * 16640); \
        for (int it = (lo_) + (first_); it < (hi_); it += 2 * (stride_)) { f32x4 va[16], vb[16]; const bool hasb = it + (stride_) < (hi_); \
            CONV_DECODE(it, srcA, dstA, ldwA, KA, k0A, n0A, drowA, gnA) tr_load(srcA, ldwA, k0A, n0A, lane, va); \
            CONV_DECODE(hasb ? it + (stride_) : it, srcB, dstB, ldwB, KB, k0B, n0B, drowB, gnB) tr_load(srcB, ldwB, k0B, n0B, lane, vb);   \
            tr_finish(va, k0A, dstA, (size_t)drowA, KA, scr, lane, gnA); if (hasb) tr_finish(vb, k0B, dstB, (size_t)drowB, KB, scr, lane, gnB); } } while (0)
#define CONV_TAIL(nunits_, lo_, hi_) do { const int rounds_ = ((nunits_) + G - 1) / G, first_idle_ = (nunits_) - (rounds_ - 1) * G; \
        if (first_idle_ >= G) CONV_RANGE(lo_, hi_, bx * NWAVES + wave, G * NWAVES);   \
        else if (bx >= first_idle_) CONV_RANGE(lo_, hi_, (bx - first_idle_) * NWAVES + wave, (G - first_idle_) * NWAVES); } while (0)

__device__ __forceinline__ bool ph_in(int k) { KArgs ap = kargs(); return ap->ph_lo <= k && k < ap->ph_hi; }
__global__ void __launch_bounds__(NWAVES * 64, 2) fwd(Args args) {
    extern __shared__ __attribute__((aligned(16))) unsigned char lds_raw[];
    LAS unsigned char* lds = (LAS unsigned char*)lds_raw;
    const int wave = __builtin_amdgcn_readfirstlane((int)threadIdx.x >> 6);
    const int bx = blockIdx.x;
    { const int tid0 = threadIdx.x; for (int u = tid0; u < (LDS_BYTES - LDSCTL_OFF) / 4; u += NWAVES * 64) ((LAS unsigned*)(lds + LDSCTL_OFF))[u] = 0u; }
    __syncthreads();
#if MK_ONE_LAUNCH
    { KArgs ap = kargs(); (void)xcd_barrier_post((unsigned*)(ap->ws + O_CTL) + CW_BAR, (volatile LAS unsigned*)(lds + MISC_OFF) + 8, wave == 0 && lane_id() == 0); }
#define GRID_BAR() do { XcdBarrier bar_; bar_.bar = (unsigned*)(ws + O_CTL) + CW_BAR; bar_.x = xb_xcc_id(); bar_.st = (volatile LAS unsigned*)(lds + MISC_OFF) + 8; xcd_barrier(bar_, wave == 0 && lane_id() == 0); } while (0)
#else
#define GRID_BAR() do { } while (0)
#endif
#define IN(k) ((((PH_MASK) >> (k)) & 1) && ph_in(k))
#define BOTH(k) (IN(k) && IN((k) + 1))
#define PH_ARGS KArgs ap = kargs(); unsigned char* ws = ap->ws; (void)ws; const int G = ap->G; const int lane = lane_id(); const int tid = wave * 64 + lane; (void)tid; \
    const int vcu = (G % 8 == 0) ? (bx % 8) * (G / 8) + bx / 8 : bx; (void)vcu; const int gw = vcu * NWAVES + wave, NGW = G * NWAVES; (void)gw; (void)NGW; \
    const int gtid = vcu * (NWAVES * 64) + tid, NT_ALL = G * NWAVES * 64; (void)gtid; (void)NT_ALL

    if (IN(0)) {
        PH_ARGS;
        CONV_RANGE(0, NIT_A, gw, NGW);
        { const float* w_in = ap->in[2]; bf16_t* W_INE = WSP(bf16_t, O_W_INE);
          for (int idx = gtid; idx < 256 * 4096; idx += NT_ALL) { const int rr = idx >> 12, k = idx & 4095;
            const float v = rr < 48 ? w_in[(size_t)k * IN_EVEN + 5120 + rr] : 0.f;
            W_INE[(size_t)(7168 + rr) * 4096 + k] = (bf16_t)(cvt_pk_bf16(v, 0.f) & 0xffffu); } }
        { float* CB = WSP(float, O_CTL + O_CBIAS);
          for (int o = gw; o < 512; o += NGW) { const int which = o >> 8, h = o & 255; const float* pe = which ? ap->in[4] : ap->in[3]; const float* w1 = which ? ap->in[7] : ap->in[5]; float a = 0.f;
            for (int k = lane; k < 4096; k += 64) a += pe[k] * w1[(size_t)k * 256 + h];
            a = wave_sum(a); if (lane == 0) CB[o] = a; } }
        { const float* gws = ap->in[16]; bf16_t* WM = WSP(bf16_t, O_WM);
          for (int idx = gtid; idx < 16 * 128 * 128; idx += NT_ALL) { const int t = (idx >> 7) & 127, s = idx & 127;
            const float v = s <= t ? gws[idx] : 0.f; WM[idx] = (bf16_t)(cvt_pk_bf16(v, 0.f) & 0xffffu); } }
        { float* ROPE = WSP(float, O_ROPE);
          for (int idx = gtid; idx < 4096 * 16; idx += NT_ALL) { const int t = idx >> 4, i = idx & 15;
            const float ang = (float)t * ROPE_INV_FREQ[i];
            const double xr = (double)ang; const double nrev = __builtin_rint(xr * 0.15915494309189535); const double rr = __builtin_fma(-nrev, 6.283185307179586, xr) - nrev * 2.4492935982947064e-16;
            const double r2 = rr * rr; double ts = 1.0, tc = 1.0, sn = 1.0, cs = 1.0;
#pragma unroll
            for (int k = 1; k <= 15; ++k) { ts *= -r2 / (double)((2 * k) * (2 * k + 1)); sn += ts; tc *= -r2 / (double)((2 * k - 1) * (2 * k)); cs += tc; }
            ROPE[idx] = (float)cs; ROPE[65536 + idx] = (float)(sn * rr); } }
        { const float* x = ap->in[0]; const float* gn = ap->in[1]; bf16_t* HN = WSP(bf16_t, O_HN);
          for (int m = gw; m < M; m += NGW) rms_row_bf16(x + (size_t)m * DM, gn, HN + (size_t)m * DM, lane); }
        if (BOTH(0)) GRID_BAR();
    }

    if (IN(1)) {
        PH_ARGS;
        pg8::Gemm g{WSP(bf16_t, O_HN), WSP(bf16_t, O_W_INE), M, IN_EVEN_P, DM, DM, DM}; pg8::StaticOrder S; S.init(M, IN_EVEN_P, G, bx);
        pg8::EpiInEven E{WSP(bf16_t, O_QH), WSP(bf16_t, O_KV), WSP(bf16_t, O_PIN), WSP(float, O_GATES), WSP(float, O_ROPE)};
        pg8::gemm_phase<pg8::EpiInEven, pg8::StaticOrder, true, true>(lds + RING_OFF, g, S, E, wave, lane);
        CONV_TAIL((M / 256) * (IN_EVEN_P / 256), NIT_P0, NIT_T1);
        if (BOTH(1)) GRID_BAR();
    }
    if (IN(2)) {
        PH_ARGS;
        for (int id = vcu; id < 256; id += G) { const int which = id >> 7, rt = id & 127;
            compress_item(lds + RING_OFF, which, rt, WSP(bf16_t, O_KV) + (size_t)which * KVSZ, WSP(float, O_CTL + O_CBIAS) + 256 * which, which ? WSP(bf16_t, O_W_C1V) : WSP(bf16_t, O_W_C1K),
                          which ? WSP(bf16_t, O_W_C2V) : WSP(bf16_t, O_W_C2K), WSP(bf16_t, O_KCMP), WSP(bf16_t, O_VCMPT), wave, lane); }
        const bf16_t* PIN = WSP(bf16_t, O_PIN); bf16_t* POOLED = WSP(bf16_t, O_POOLED);
        for (int idx = gtid; idx < M * 256; idx += NT_ALL) { const int row = idx >> 8, c8 = (idx & 255) * 8, grp = __builtin_amdgcn_readfirstlane(c8 >> 9);
            if (grp == 0) pool_chunk<2>(PIN, POOLED, row, c8); else if (grp == 1) pool_chunk<4>(PIN, POOLED, row, c8); else if (grp == 2) pool_chunk<8>(PIN, POOLED, row, c8); else pool_chunk<16>(PIN, POOLED, row, c8); }
        if (BOTH(2)) GRID_BAR();
    }
    if (IN(3)) {
        PH_ARGS;
        { const int grp = bx >> 6, loc = bx & 63;
          pg8::Gemm g{WSP(bf16_t, O_POOLED) + 512 * grp, WSP(bf16_t, O_W_POOL) + (size_t)grp * 512 * 512, M, 512, 512, 2048, 512}; pg8::StaticOrder S; S.init(M, 512, 64, loc);
          pg8::EpiScaleBf16 E{WSP(bf16_t, O_CAT) + 2048 + 512 * grp, DM, ap->in[10] + 512 * grp};
          if (grp < 4) pg8::gemm_phase<pg8::EpiScaleBf16, pg8::StaticOrder, false, true>(lds + RING_OFF, g, S, E, wave, lane); }
        __syncthreads();
        if (wave < 4) CONV_RANGE(NIT_A, NIT_C3, bx * NWAVES + wave, G * NWAVES);
        for (int id = vcu; id < 1024; id += G) cmp_attn_item(lds + RING_OFF, 2 * (id >> 8) + ((id >> 7) & 1), (id + 32 * (id >> 8)) & 127, WSP(bf16_t, O_QH), WSP(bf16_t, O_KCMP), WSP(bf16_t, O_VCMPT), WSP(float, O_GATES),
                                                             WSP(float, O_OACC), WSP(unsigned long long, O_SEL), wave, lane);
        if (wave >= 4) CONV_RANGE(NIT_A, NIT_C3, bx * NWAVES + wave, G * NWAVES);
        if (BOTH(3)) GRID_BAR();
    }
    if (IN(4)) {
        PH_ARGS;
        const bool conv_first = ((bx >> 3) & 1) != 0;
        if (conv_first) { CONV_RANGE(NIT_C3, NIT_P0, bx * NWAVES + wave, G * NWAVES); VM_WAIT(); __syncthreads(); }
        const swa::Ctx X{WSP(float, O_OACC), WSP(bf16_t, O_CAT), WSP(float, O_GATES), WSP(unsigned long long, O_SEL)};
        swa::swa_phase<1, false>((char*)lds_raw + RING_OFF, WSP(bf16_t, O_QH), WSP(bf16_t, O_KV) + 2 * KVSZ, WSP(bf16_t, O_KV) + 3 * KVSZ, X, 1 << 28, 1 << 28, bx, G, wave, lane);
        if (!conv_first) { __syncthreads(); CONV_RANGE(NIT_C3, NIT_P0, bx * NWAVES + wave, G * NWAVES); }
        VM_WAIT(); __syncthreads();
        swa::swa_phase<0, true>((char*)lds_raw + RING_OFF, WSP(bf16_t, O_QH), WSP(bf16_t, O_KV) + 4 * KVSZ, WSP(bf16_t, O_KV) + 5 * KVSZ, X, 512, 1 << 28, bx, G, wave, lane);
        if (BOTH(4)) GRID_BAR();
    }
    if (IN(6)) {
        PH_ARGS;
        pg8::Gemm g{WSP(bf16_t, O_CAT), WSP(bf16_t, O_W_OUTE), M, DM, DM, DM, DM}; pg8::StaticOrder S; S.init(M, DM, G, bx);
        pg8::EpiResid<true> E{ap->in[0], WSP(bf16_t, O_XB), DM, WSP(float, O_SSQP)};
        pg8::gemm_phase<pg8::EpiResid<true>, pg8::StaticOrder, true, true>(lds + RING_OFF, g, S, E, wave, lane);
        if (BOTH(6)) GRID_BAR();
    }
    for (int l = 0; l < 2; ++l) {
        if (l == 1) {
            if (IN(11)) {
                PH_ARGS;
                pg8::Gemm g{WSP(bf16_t, O_XB1), WSP(bf16_t, O_W_INO), M, 2 * GW, DM, DM, DM}; pg8::StaticOrder S; S.init(M, 2 * GW, G, bx);
                pg8::Unit u0; LAS float* tab = (LAS float*)(lds + ROWSC_OFF); int pm0 = -1;
                if (S.next(0, u0)) { pm0 = u0.pm; pg8::build_row_scale(tab, WSP(float, O_SSQP), pm0, tid); }
                LDS_WAIT(); __syncthreads();
                pg8::EpiGeluSplit E{WSP(bf16_t, O_U), WSP(bf16_t, O_V), GW, GW, WSP(float, O_VPART), pg8::RowScale{tab, pm0}};
                pg8::gemm_phase<pg8::EpiGeluSplit, pg8::StaticOrder, true, true>(lds + RING_OFF, g, S, E, wave, lane);
                if (BOTH(11)) GRID_BAR();
            }
            if (IN(12)) { PH_ARGS; const float* part = WSP(float, O_VPART); float* SUMS = WSP(float, O_CTL + O_VSUMS);
                for (int m = gw; m < M; m += NGW) { const f32x2* pr = (const f32x2*)(part + (size_t)m * 384) + lane; const f32x2 a = pr[0], b = pr[64], c = pr[128];
                    const float s1 = wave_sum((a[0] + b[0]) + c[0]), s2 = wave_sum((a[1] + b[1]) + c[1]); if (lane == 0) *(f32x2*)(SUMS + (size_t)m * 2) = (f32x2){s1, s2}; }
                if (BOTH(12)) GRID_BAR(); }
            if (IN(13)) {
                PH_ARGS;
                for (int task = vcu; task < 96 * 8; task += G) { const int pnl = 3 * (task & 31) + ((task >> 5) % 3), bq = (task >> 5) / 3;
                    gate_task(lds + RING_OFF, pnl / 6, pnl % 6, 8 * bq, 8, WSP(bf16_t, O_V), WSP(bf16_t, O_U), WSP(float, O_CTL + O_VSUMS), ap->in[14], ap->in[15], WSP(bf16_t, O_WM), ap->in[17], tid, wave, lane); }
                if (BOTH(13)) GRID_BAR();
            }
            if (IN(14)) {
                PH_ARGS;
                pg8::Gemm g{WSP(bf16_t, O_U), WSP(bf16_t, O_W_OUTO), M, DM, GW, GW, GW}; pg8::StaticOrder S; S.init(M, DM, G, bx);
                pg8::EpiResid<false> E{WSP(bf16_t, O_XB1), WSP(bf16_t, O_XB), DM, WSP(float, O_SSQP)};
                pg8::gemm_phase<pg8::EpiResid<false>, pg8::StaticOrder, true, true>(lds + RING_OFF, g, S, E, wave, lane);
                if (BOTH(14)) GRID_BAR();
            }
        }
        const int pb = 7 + 8 * l;
        if (IN(pb + 1)) {
            PH_ARGS;
            pg8::Gemm g{WSP(bf16_t, O_XB), (const bf16_t*)(ws + (l ? O_W_GU1 : O_W_GU0)), M, 2 * FF, DM, DM, DM}; pg8::StaticOrder S; S.init(M, 2 * FF, G, bx);
            pg8::Unit u0; LAS float* tab = (LAS float*)(lds + ROWSC_OFF); int pm0 = -1;
            if (S.next(0, u0)) { pm0 = u0.pm; pg8::build_row_scale(tab, WSP(float, O_SSQP), pm0, tid); }
            LDS_WAIT(); __syncthreads();
            pg8::EpiSwiGLU E{WSP(bf16_t, O_H), FF, pg8::RowScale{tab, pm0}};
            pg8::gemm_phase<pg8::EpiSwiGLU, pg8::StaticOrder, true, true>(lds + RING_OFF, g, S, E, wave, lane);
            if (l == 0) CONV_TAIL((M / 256) * (2 * FF / 256), NIT_T1, NIT_T8); else CONV_TAIL((M / 256) * (2 * FF / 256), NIT_T8, NITEMS);
            if (BOTH(pb + 1)) GRID_BAR();
        }
        if (IN(pb + 2)) {
            PH_ARGS;
            pg8::Gemm g{WSP(bf16_t, O_H), (const bf16_t*)(ws + (l ? O_W_DN1 : O_W_DN0)), M, DM, FF, FF, FF}; pg8::StaticOrder S; S.init(M, DM, G, bx);
            pg8::EpiResid<false> E{WSP(bf16_t, O_XB), WSP(bf16_t, O_XB1), DM, WSP(float, O_SSQP)};
            pg8::gemm_phase<pg8::EpiResid<false>, pg8::StaticOrder, true, true>(lds + RING_OFF, g, S, E, wave, lane);
            if (BOTH(pb + 2)) GRID_BAR();
        }
    }
    if (IN(18)) { PH_ARGS; const bf16_t* XB = WSP(bf16_t, O_XB1); const float* gn = ap->in[23]; float* out = ap->out; const float* pp = WSP(float, O_SSQP);
        for (int m = gw; m < M; m += NGW) { const float r = 1.0f / sqrtf(wave_sum(pp[(size_t)m * 64 + lane]) * (1.0f / DM) + EPS); const u32x2* xr = (const u32x2*)(XB + (size_t)m * DM) + lane; const f32x4* gr = (const f32x4*)gn + lane; f32x4* o = (f32x4*)(out + (size_t)m * DM) + lane;
#pragma unroll 8
            for (int j = 0; j < 16; ++j) { const u32x2 w = xr[64 * j]; o[64 * j] = (f32x4){bflo(w.x), bfhi(w.x), bflo(w.y), bfhi(w.y)} * r * gr[64 * j]; } } }
#undef IN
#undef BOTH
}

extern "C" void kernel_launch(void* const* d_in, const int* in_sizes, int n_in, void* d_out, int out_size, void* d_ws, size_t ws_size, hipStream_t stream) {
    static int grid = 0;
    if (grid == 0) {
        if (n_in != 24 || in_sizes[0] != M * DM || out_size != M * DM || ws_size < WS_END) {
            fprintf(stderr, "kernel_launch: built for 24 inputs, x/out of %d floats, >= %zu bytes of workspace; got n_in %d, in0 %d, out %d, ws %zu; nothing launched\n", M * DM, (size_t)WS_END, n_in, n_in > 0 ? in_sizes[0] : -1, out_size, ws_size);
            grid = -1; return; }
        int dev = 0, cus = 0;
        if (hipGetDevice(&dev) != hipSuccess || hipDeviceGetAttribute(&cus, hipDeviceAttributeMultiprocessorCount, dev) != hipSuccess) { fprintf(stderr, "kernel_launch: device query failed\n"); grid = -1; return; }
        if (hipFuncSetAttribute((const void*)fwd, hipFuncAttributeMaxDynamicSharedMemorySize, LDS_BYTES) != hipSuccess) { fprintf(stderr, "kernel_launch: hipFuncSetAttribute failed\n"); grid = -1; return; }
        int per_cu = 0;
        if (hipOccupancyMaxActiveBlocksPerMultiprocessor(&per_cu, (const void*)fwd, NWAVES * 64, LDS_BYTES) != hipSuccess || per_cu < 1) fprintf(stderr, "kernel_launch: note: occupancy query reports %d\n", per_cu);
        (void)hipGetLastError();
        if (cus != 256) { fprintf(stderr, "kernel_launch: built for a 256-CU device, found %d CUs; nothing launched\n", cus); grid = -1; return; }
        grid = cus;
    }
    if (grid < 0) return;
    (void)hipMemsetAsync((char*)d_ws + O_CTL, 0, CTL_ZERO_BYTES, stream);
    Args a{};
    for (int i = 0; i < 24; ++i) a.in[i] = (const float*)d_in[i];
    a.out = (float*)d_out; a.ws = (unsigned char*)d_ws; a.G = grid; a.pad = 0;
#if MK_ONE_LAUNCH
    a.ph_lo = 0; a.ph_hi = N_PHASES;
    hipLaunchKernelGGL(fwd, dim3(grid), dim3(NWAVES * 64), LDS_BYTES, stream, a);
#else
    for (int p = 0; p < N_PHASES; ++p) { a.ph_lo = p; a.ph_hi = p + 1; hipLaunchKernelGGL(fwd, dim3(grid), dim3(NWAVES * 64), LDS_BYTES, stream, a); }
#endif
}
```

```cpp
#include <hip/hip_runtime.h>
#include <cstdio>
#include <cstdint>

#ifndef MK_ONE_LAUNCH
#define MK_ONE_LAUNCH 1
#endif

#define LAS __attribute__((address_space(3)))
#define GAS __attribute__((address_space(1)))
typedef unsigned short bf16_t;
typedef short bf16x8 __attribute__((ext_vector_type(8)));
typedef short s16x4 __attribute__((ext_vector_type(4)));
typedef float f32x2 __attribute__((ext_vector_type(2)));
typedef float f32x4 __attribute__((ext_vector_type(4)));
typedef float f32x16 __attribute__((ext_vector_type(16)));
typedef unsigned u32x2 __attribute__((ext_vector_type(2)));
typedef unsigned u32x4 __attribute__((ext_vector_type(4)));

constexpr int NB = 2, T = 4096, DM = 4096, M = NB * T;
constexpr int NH = 16, NG = 4, HD = 128;
constexpr int IN_EVEN = 7216, IN_EVEN_P = 7424;
constexpr int FF = 11008, GW = 12288;
constexpr float EPS = 1e-6f;
constexpr size_t KVSZ = (size_t)NB * NG * T * HD;

constexpr size_t O_CTL = 0, CTL_ZERO_BYTES = 64u << 10;
constexpr size_t O_ROPE = 1u << 20;
constexpr size_t O_WM = O_ROPE + (512u << 10);
constexpr size_t O_STATS = O_WM + (512u << 10);
constexpr size_t O_KCMP = O_STATS + (64u << 10);
constexpr size_t O_VCMPT = O_KCMP + (512u << 10);
constexpr size_t O_SEL = O_VCMPT + (512u << 10);
constexpr size_t O_GATES = O_SEL + (256u << 10);
constexpr size_t O_W = 8u << 20;
constexpr size_t O_W_INE = O_W;
constexpr size_t O_W_OUTE = O_W_INE + (size_t)IN_EVEN_P * DM * 2;
constexpr size_t O_W_GU0 = O_W_OUTE + (size_t)DM * DM * 2;
constexpr size_t O_W_DN0 = O_W_GU0 + (size_t)2 * FF * DM * 2;
constexpr size_t O_W_GU1 = O_W_DN0 + (size_t)DM * FF * 2;
constexpr size_t O_W_DN1 = O_W_GU1 + (size_t)2 * FF * DM * 2;
constexpr size_t O_W_INO = O_W_DN1 + (size_t)DM * FF * 2;
constexpr size_t O_W_OUTO = O_W_INO + (size_t)2 * GW * DM * 2;
constexpr size_t O_W_POOL = O_W_OUTO + (size_t)DM * GW * 2;
constexpr size_t O_W_C1K = O_W_POOL + (size_t)4 * 512 * 512 * 2;
constexpr size_t O_W_C1V = O_W_C1K + (size_t)256 * 4096 * 2;
constexpr size_t O_W_C2K = O_W_C1V + (size_t)256 * 4096 * 2;
constexpr size_t O_W_C2V = O_W_C2K + (size_t)128 * 256 * 2;
constexpr size_t O_XB = O_W_C2V + (size_t)128 * 256 * 2;
constexpr size_t O_XB1 = O_XB + (size_t)M * DM * 2;
constexpr size_t O_HN = O_XB + (size_t)M * DM * 4;
constexpr size_t O_A = O_HN + (size_t)M * DM * 2;
constexpr size_t O_QH = O_A;
constexpr size_t O_KV = O_QH + (size_t)M * 2048 * 2;
constexpr size_t O_PIN = O_KV + 6 * KVSZ * 2;
constexpr size_t O_POOLED = O_PIN + (size_t)M * 2048 * 2;
constexpr size_t O_OACC = O_POOLED + (size_t)M * 2048 * 2;
constexpr size_t O_CAT = O_OACC + (size_t)M * 2048 * 4;
constexpr size_t O_A_END_EVEN = O_CAT + (size_t)M * DM * 2;
constexpr size_t O_H = O_A;
constexpr size_t O_U = O_A;
constexpr size_t O_V = O_U + (size_t)M * GW * 2;
constexpr size_t O_A_END_ODD = O_V + (size_t)M * GW * 2;
constexpr size_t O_VPART = O_A_END_ODD > O_A_END_EVEN ? O_A_END_ODD : O_A_END_EVEN;
constexpr size_t O_SSQP = O_VPART + (size_t)M * 192 * 2 * 4;
constexpr size_t WS_END = O_SSQP + (size_t)M * 64 * 4;
static_assert(O_GATES + (size_t)M * 48 * 4 <= O_W, "small buffers fit below the weights");
static_assert((O_W_OUTE % 256) == 0 && (O_W_GU0 % 256) == 0 && (O_W_DN0 % 256) == 0 && (O_W_INO % 256) == 0 && (O_XB % 256) == 0 && (O_A % 256) == 0 && (O_V % 256) == 0, "alignment");

constexpr int CW_TMO = 0, CW_BAR = 4096;
constexpr size_t O_CBIAS = 384u << 10;
constexpr size_t O_SSQ = 448u << 10;
constexpr size_t O_VSUMS = 256u << 10;

constexpr int RING_OFF = 0, RING_BYTES = 131072;
constexpr int LDS_BYTES = 147456;
constexpr int LDSCTL_OFF = LDS_BYTES - 1024, MISC_OFF = LDSCTL_OFF + 320;
constexpr int ROWSC_OFF = LDSCTL_OFF - 2048;
constexpr int NWAVES = 8;

typedef __bf16 bf16x2_t __attribute__((ext_vector_type(2)));
__device__ __forceinline__ unsigned cvt_pk_bf16(float lo, float hi) { f32x2 v = {lo, hi}; bf16x2_t b = __builtin_convertvector(v, bf16x2_t); return __builtin_bit_cast(unsigned, b); }
__device__ __forceinline__ float bf2f(unsigned short b) { return __uint_as_float(((unsigned)b) << 16); }
__device__ __forceinline__ float bflo(unsigned w) { return __uint_as_float(w << 16); }
__device__ __forceinline__ float bfhi(unsigned w) { return __uint_as_float(w & 0xffff0000u); }
__device__ __forceinline__ float sigmoidf_(float x) { return __builtin_amdgcn_rcpf(1.0f + __builtin_amdgcn_exp2f(-1.4426950408889634f * x)); }
__device__ __forceinline__ float gelu_tanh(float x) {
    const float y = 2.0f * 0.7978845608028654f * x * (1.0f + 0.044715f * x * x);
    return x * sigmoidf_(y);
}
__device__ __forceinline__ int lane_id() { unsigned z = 0u; asm volatile("" : "+s"(z)); return (int)__builtin_amdgcn_mbcnt_hi(~0u, __builtin_amdgcn_mbcnt_lo(~0u, z)); }
#define LDS_WAIT() asm volatile("s_waitcnt lgkmcnt(0)" ::: "memory")
#define VM_WAIT() asm volatile("s_waitcnt vmcnt(0)" ::: "memory")

namespace pg8 {
constexpr int BM = 256, BK = 64, HALF = 128, HTB = HALF * BK * 2, STAGE_BYTES = 8 * HTB, NXCD = 8, WGM = 8;
__host__ __device__ __forceinline__ int lds_byte(int r, int c) { const int st = (r >> 4) * 2 + (c >> 5), rr = r & 15, cc = c & 31, ob = rr * 64 + cc * 2; return st * 1024 + (ob ^ (((ob >> 9) & 1) << 5)); }
__host__ __device__ __forceinline__ void stage_rc(int b, int& R, int& C) { const int st = b / 1024, sb = b % 1024, swz = sb ^ (((sb >> 9) & 1) << 5); R = (st >> 1) * 16 + swz / 64; C = (st & 1) * 32 + (swz % 64) / 2; }
__host__ __device__ __forceinline__ int perm32(int rho) { const int n = rho >> 4, i = rho & 15; return 8 * (i >> 2) + 4 * n + (i & 3); }

struct Unit { int pm, pn; };
struct Gemm { const bf16_t* A; const bf16_t* Bt; int M, N, K, lda, ldb; };

struct StaticOrder {
    int nM, nN, nwg, G, c;
    __host__ __device__ __forceinline__ void init(int M_, int N_, int G_, int c_) { nM = M_ / BM; nN = N_ / BM; nwg = nM * nN; G = G_; c = c_; }
    __host__ __device__ __forceinline__ bool next(int i, Unit& u) const {
        const long L = (long)i * G + c; if (L >= nwg) return false;
        int wgid = (int)L; { const int q = nwg / NXCD, r = nwg % NXCD, xcd = wgid % NXCD, off = wgid / NXCD; wgid = (xcd < r ? xcd * (q + 1) : r * (q + 1) + (xcd - r) * q) + off; }
        const int nig = WGM * nN, gid = wgid / nig, fm = gid * WGM, gsz = (nM - fm) < WGM ? (nM - fm) : WGM;
        u.pm = fm + ((wgid % nig) % gsz); u.pn = (wgid % nig) / gsz; return true;
    }
    __device__ __forceinline__ void a_ready(const Unit&) const {}
    __device__ __forceinline__ void done(const Unit&) const {}
};


struct EpiInEven {
    static constexpr bool PERM = true, AFTER_DRAIN = false;
    bf16_t* QH; bf16_t* KV; bf16_t* PIN; float* GATES; const float* ROPE;
    __device__ __forceinline__ void operator()(const f32x4 (&acc)[2][2][4][2], const Unit& u, int wr, int wc, int fr, int fq) const {
        const int pn = u.pn;
#pragma unroll
        for (int ai = 0; ai < 2; ++ai)
#pragma unroll
            for (int m = 0; m < 4; ++m) {
                const int row = u.pm * BM + ai * HALF + wr * 64 + m * 16 + fr, b = row >> 12, t = row & 4095;
#pragma unroll
                for (int bj = 0; bj < 2; ++bj) {
                    f32x4 v0 = acc[ai][bj][m][0], v1 = acc[ai][bj][m][1];
                    if (pn < 20) {
                        const bool is_q = pn < 8; const int which = (pn - 8) >> 1;
                        if (wc == 0 && (is_q || !(which & 1))) {
                            f32x4 p0, p1;
#pragma unroll
                            for (int e = 0; e < 4; ++e) { p0[e] = __shfl_xor(v0[e], 32); p1[e] = __shfl_xor(v1[e], 32); }
                            const float* cp = ROPE + t * 16 + 8 * (fq & 1);
                            const f32x4 c0 = *(const f32x4*)cp, c1 = *(const f32x4*)(cp + 4), s0 = *(const f32x4*)(cp + 65536), s1 = *(const f32x4*)(cp + 65536 + 4);
                            if (fq < 2) { v0 = v0 * c0 - p0 * s0; v1 = v1 * c1 - p1 * s1; } else { v0 = v0 * c0 + p0 * s0; v1 = v1 * c1 + p1 * s1; }
                        }
                        const int d0 = wc * 32 + 8 * fq;
                        bf16_t* dst = is_q ? QH + ((size_t)((b * 16 + 2 * pn + bj) * 4096 + t)) * 128 + d0
                                           : KV + (size_t)which * KVSZ + ((size_t)((b * 4 + ((pn - 8) & 1) * 2 + bj) * 4096 + t)) * 128 + d0;
                        u32x4 w; w.x = cvt_pk_bf16(v0[0], v0[1]); w.y = cvt_pk_bf16(v0[2], v0[3]); w.z = cvt_pk_bf16(v1[0], v1[1]); w.w = cvt_pk_bf16(v1[2], v1[3]);
                        *(u32x4*)dst = w;
                    } else if (pn < 28) {
                        u32x4 w; w.x = cvt_pk_bf16(v0[0], v0[1]); w.y = cvt_pk_bf16(v0[2], v0[3]); w.z = cvt_pk_bf16(v1[0], v1[1]); w.w = cvt_pk_bf16(v1[2], v1[3]);
                        *(u32x4*)(PIN + (size_t)row * 2048 + (pn - 20) * 256 + bj * HALF + wc * 32 + 8 * fq) = w;
                    } else {
                        const int col0 = wc * 32 + 8 * fq;
                        if (bj == 0 && col0 <= 40) {
                            f32x4 g0, g1;
#pragma unroll
                            for (int e = 0; e < 4; ++e) { g0[e] = sigmoidf_(v0[e]); g1[e] = sigmoidf_(v1[e]); }
                            float* gp = GATES + (size_t)row * 48 + col0; *(f32x4*)gp = g0; *(f32x4*)(gp + 4) = g1;
                        }
                    }
                }
            }
    }
};
struct EpiScaleBf16 {
    static constexpr bool PERM = true, AFTER_DRAIN = false;
    bf16_t* O; int ldc; const float* scale;
    __device__ __forceinline__ void operator()(const f32x4 (&acc)[2][2][4][2], const Unit& u, int wr, int wc, int fr, int fq) const {
        const int row0 = u.pm * BM + wr * 64 + fr, col0 = u.pn * BM + wc * 32 + 8 * fq;
#pragma unroll
        for (int bj = 0; bj < 2; ++bj) {
            const f32x4 sc0 = *(const f32x4*)(scale + col0 + bj * HALF), sc1 = *(const f32x4*)(scale + col0 + bj * HALF + 4);
#pragma unroll
            for (int ai = 0; ai < 2; ++ai)
#pragma unroll
                for (int m = 0; m < 4; ++m) { const f32x4 v0 = acc[ai][bj][m][0] * sc0, v1 = acc[ai][bj][m][1] * sc1;
                    u32x4 w; w.x = cvt_pk_bf16(v0[0], v0[1]); w.y = cvt_pk_bf16(v0[2], v0[3]); w.z = cvt_pk_bf16(v1[0], v1[1]); w.w = cvt_pk_bf16(v1[2], v1[3]);
                    *(u32x4*)(O + (size_t)(row0 + ai * HALF + m * 16) * ldc + col0 + bj * HALF) = w; }
        }
    }
};
template <bool BASE_F32> struct EpiResid {
    static constexpr bool PERM = true, AFTER_DRAIN = false;
    const void* base; bf16_t* out; int ldc; float* ssqp;
    __device__ __forceinline__ void operator()(const f32x4 (&acc)[2][2][4][2], const Unit& u, int wr, int wc, int fr, int fq) const {
        const int row0 = u.pm * BM + wr * 64 + fr, col0 = u.pn * BM + wc * 32 + 8 * fq;
#pragma unroll
        for (int ai = 0; ai < 2; ++ai) { f32x4 b0[4][2], b1[4][2];
#pragma unroll
            for (int m = 0; m < 4; ++m) { const size_t off = (size_t)(row0 + ai * HALF + m * 16) * ldc + col0;
#pragma unroll
                for (int bj = 0; bj < 2; ++bj) {
                    if constexpr (BASE_F32) { const float* bp = (const float*)base + off + bj * HALF; b0[m][bj] = *(const f32x4*)bp; b1[m][bj] = *(const f32x4*)(bp + 4); }
                    else { const u32x4 w = *(const u32x4*)((const bf16_t*)base + off + bj * HALF); b0[m][bj] = (f32x4){bflo(w.x), bfhi(w.x), bflo(w.y), bfhi(w.y)}; b1[m][bj] = (f32x4){bflo(w.z), bfhi(w.z), bflo(w.w), bfhi(w.w)}; } } }
#pragma unroll
            for (int m = 0; m < 4; ++m) { const int row = row0 + ai * HALF + m * 16; const size_t off = (size_t)row * ldc + col0; float sq = 0.f;
#pragma unroll
                for (int bj = 0; bj < 2; ++bj) { const f32x4 o0 = b0[m][bj] + acc[ai][bj][m][0], o1 = b1[m][bj] + acc[ai][bj][m][1];
                    sq += ((o0[0] * o0[0] + o0[1] * o0[1]) + (o0[2] * o0[2] + o0[3] * o0[3])) + ((o1[0] * o1[0] + o1[1] * o1[1]) + (o1[2] * o1[2] + o1[3] * o1[3]));
                    u32x4 w; w.x = cvt_pk_bf16(o0[0], o0[1]); w.y = cvt_pk_bf16(o0[2], o0[3]); w.z = cvt_pk_bf16(o1[0], o1[1]); w.w = cvt_pk_bf16(o1[2], o1[3]);
                    *(u32x4*)(out + off + bj * HALF) = w; }
                sq += __shfl_xor(sq, 16); sq += __shfl_xor(sq, 32);
                if (fq == 0) ssqp[(size_t)row * 64 + u.pn * 4 + wc] = sq; }
            asm volatile("" ::: "memory"); }
    }
};
__device__ __forceinline__ float row_rstd_from_partials(const float* ssqp, int row) { const f32x4* p = (const f32x4*)(ssqp + (size_t)row * 64); float t = 0.f;
#pragma unroll
    for (int i = 0; i < 16; ++i) { const f32x4 v = p[i]; t += (v[0] + v[1]) + (v[2] + v[3]); }
    return 1.0f / sqrtf(t * (1.0f / DM) + EPS); }
struct RowScale { const LAS float* tab; int pm0;
    __device__ __forceinline__ float get(int pm, int r_in_panel) const { return pm == pm0 ? tab[r_in_panel] : __builtin_nanf(""); } };
__device__ __forceinline__ void build_row_scale(LAS float* tab, const float* ssqp, int pm, int tid) {
    const int r = tid >> 1, h = tid & 1; const f32x4* p = (const f32x4*)(ssqp + (size_t)(pm * 256 + r) * 64 + 32 * h); float t = 0.f;
#pragma unroll
    for (int i = 0; i < 8; ++i) { const f32x4 v = p[i]; t += (v[0] + v[1]) + (v[2] + v[3]); }
    const float o = __shfl_xor(t, 1); const float tot = h ? (o + t) : (t + o);
    if (h == 0) tab[r] = 1.0f / sqrtf(tot * (1.0f / DM) + EPS); }
struct EpiSwiGLU {
    static constexpr bool PERM = true, AFTER_DRAIN = false;
    bf16_t* H; int ldc; RowScale rsc;
    __device__ __forceinline__ void operator()(const f32x4 (&acc)[2][2][4][2], const Unit& u, int wr, int wc, int fr, int fq) const {
        const int row0 = u.pm * BM + wr * 64 + fr, col0 = u.pn * HALF + wc * 32 + 8 * fq;
        float rs[2][4];
#pragma unroll
        for (int ai = 0; ai < 2; ++ai)
#pragma unroll
            for (int m = 0; m < 4; ++m) rs[ai][m] = rsc.get(u.pm, ai * HALF + wr * 64 + m * 16 + fr);
#pragma unroll
        for (int ai = 0; ai < 2; ++ai)
#pragma unroll
            for (int m = 0; m < 4; ++m) { f32x4 h0, h1; const float r = rs[ai][m];
#pragma unroll
                for (int e = 0; e < 4; ++e) { const float g0 = acc[ai][0][m][0][e] * r, g1 = acc[ai][0][m][1][e] * r;
                    h0[e] = g0 * sigmoidf_(g0) * (acc[ai][1][m][0][e] * r); h1[e] = g1 * sigmoidf_(g1) * (acc[ai][1][m][1][e] * r); }
                u32x4 w; w.x = cvt_pk_bf16(h0[0], h0[1]); w.y = cvt_pk_bf16(h0[2], h0[3]); w.z = cvt_pk_bf16(h1[0], h1[1]); w.w = cvt_pk_bf16(h1[2], h1[3]);
                *(u32x4*)(H + (size_t)(row0 + ai * HALF + m * 16) * ldc + col0) = w; }
    }
};
struct EpiGeluSplit {
    static constexpr bool PERM = true, AFTER_DRAIN = false;
    bf16_t* O0; bf16_t* O1; int ldc; int split; float* part; RowScale rsc;
    __device__ __forceinline__ void operator()(const f32x4 (&acc)[2][2][4][2], const Unit& u, int wr, int wc, int fr, int fq) const {
        const int row0 = u.pm * BM + wr * 64 + fr; int colt = u.pn * BM; bf16_t* base = O0;
        const bool is_v = colt >= split;
        if (is_v) { base = O1; colt -= split; }
        const int col0 = colt + wc * 32 + 8 * fq;
#pragma unroll
        for (int ai = 0; ai < 2; ++ai)
#pragma unroll
            for (int m = 0; m < 4; ++m) { float s1 = 0.f, s2 = 0.f; const float r = rsc.get(u.pm, ai * HALF + wr * 64 + m * 16 + fr);
#pragma unroll
                for (int bj = 0; bj < 2; ++bj) { f32x4 v0, v1;
#pragma unroll
                    for (int e = 0; e < 4; ++e) { v0[e] = gelu_tanh(acc[ai][bj][m][0][e] * r); v1[e] = gelu_tanh(acc[ai][bj][m][1][e] * r); }
                    u32x4 w; w.x = cvt_pk_bf16(v0[0], v0[1]); w.y = cvt_pk_bf16(v0[2], v0[3]); w.z = cvt_pk_bf16(v1[0], v1[1]); w.w = cvt_pk_bf16(v1[2], v1[3]);
                    *(u32x4*)(base + (size_t)(row0 + ai * HALF + m * 16) * ldc + col0 + bj * HALF) = w;
                    if (is_v) {
                        const float r0 = bflo(w.x), r1 = bfhi(w.x), r2 = bflo(w.y), r3 = bfhi(w.y), r4 = bflo(w.z), r5 = bfhi(w.z), r6 = bflo(w.w), r7 = bfhi(w.w);
                        s1 += ((r0 + r1) + (r2 + r3)) + ((r4 + r5) + (r6 + r7)); s2 += ((r0 * r0 + r1 * r1) + (r2 * r2 + r3 * r3)) + ((r4 * r4 + r5 * r5) + (r6 * r6 + r7 * r7)); } }
                if (is_v) {
                    s1 += __shfl_xor(s1, 16); s1 += __shfl_xor(s1, 32); s2 += __shfl_xor(s2, 16); s2 += __shfl_xor(s2, 32);
                    if (fq == 0) { float* sp = part + ((size_t)(row0 + ai * HALF + m * 16) * 192 + (size_t)(u.pn - split / BM) * 4 + wc) * 2; *(f32x2*)sp = (f32x2){s1, s2}; } } }
    }
};

template <class Epi, class Sched, bool ALIGN_EPI = false, bool SP2 = false>
__device__ __forceinline__ void gemm_phase(LAS unsigned char* lds, const Gemm g, const Sched& S, const Epi& E, int wid, int lane) {
    const int tid = wid * 64 + lane, wr = wid >> 2, wc = wid & 3, fr = lane & 15, fq = lane >> 4;
    const int K = g.K, nt = K / BK;
    unsigned voffA[2], voffB[2];
#pragma unroll
    for (int i = 0; i < 2; ++i) { int R, C; stage_rc(tid * 16 + i * 8192, R, C); const int Rb = Epi::PERM ? ((R & ~31) + perm32(R & 31)) : R;
        voffA[i] = (unsigned)(R * g.lda + C) * 2u; voffB[i] = (unsigned)(Rb * g.ldb + C) * 2u; }
    const size_t kstep = (size_t)(BK * 2);
    const size_t hsA = (size_t)HALF * g.lda * 2, hsB = (size_t)HALF * g.ldb * 2;
    const size_t tsA = 2 * hsA, tsB = 2 * hsB;
    const unsigned ldsw = (unsigned)wid * 1024u;
    const int aoff = lds_byte(wr * 64 + fr, fq * 8), boff = lds_byte(wc * 32 + fr, fq * 8);
#define PG8_SA(b, h) (((b) * 2 + (h)) * HTB)
#define PG8_SB(b, h) ((4 + (b) * 2 + (h)) * HTB)
#define PG8_STAGE(bufoff, gbase, voff) do { _Pragma("unroll") for (int _i = 0; _i < 2; ++_i) \
        __builtin_amdgcn_global_load_lds((const unsigned*)((const char*)(gbase) + (voff)[_i]), (LAS unsigned*)(lds + (bufoff) + ldsw + _i * 8192), 16, 0, 0); } while (0)
#define PG8_LDA(dst, b, h) do { _Pragma("unroll") for (int m = 0; m < 4; ++m) _Pragma("unroll") for (int k = 0; k < 2; ++k) dst[m][k] = *(const LAS bf16x8*)(lds + PG8_SA(b, h) + aoff + m * 2048 + k * 1024); } while (0)
#define PG8_LDB(dst, b, h) do { _Pragma("unroll") for (int n = 0; n < 2; ++n) _Pragma("unroll") for (int k = 0; k < 2; ++k) dst[n][k] = *(const LAS bf16x8*)(lds + PG8_SB(b, h) + boff + n * 2048 + k * 1024); } while (0)
#define PG8_MMA(ai, bj, At, Bt) do { __builtin_amdgcn_s_setprio(1); _Pragma("unroll") for (int m = 0; m < 4; ++m) _Pragma("unroll") for (int n = 0; n < 2; ++n) _Pragma("unroll") for (int k = 0; k < 2; ++k) \
        acc[ai][bj][m][n] = __builtin_amdgcn_mfma_f32_16x16x32_bf16(Bt[n][k], At[m][k], acc[ai][bj][m][n], 0, 0, 0); __builtin_amdgcn_s_setprio(0); } while (0)
#define PG8_WAIT_V(n) asm volatile("s_waitcnt vmcnt(" #n ")" ::: "memory")
#define PG8_WAIT_L(n) asm volatile("s_waitcnt lgkmcnt(" #n ")" ::: "memory")
#define PG8_BAR __builtin_amdgcn_s_barrier()
#define PG8_SCHED __builtin_amdgcn_sched_barrier(0)
    Unit cur, nxt; int ui = 0;
    if (!S.next(0, cur)) return;
    f32x4 acc[2][2][4][2];
#pragma unroll
    for (int a = 0; a < 2; ++a)
#pragma unroll
        for (int b = 0; b < 2; ++b)
#pragma unroll
            for (int m = 0; m < 4; ++m)
#pragma unroll
                for (int n = 0; n < 2; ++n) acc[a][b][m][n] = (f32x4){0.f, 0.f, 0.f, 0.f};
    bf16x8 At[4][2], B0[2][2], B1[2][2];
    const char* cA = (const char*)g.A + (size_t)cur.pm * tsA; const char* cB = (const char*)g.Bt + (size_t)cur.pn * tsB;
    S.a_ready(cur);
    if constexpr (SP2) {
        PG8_STAGE(PG8_SB(0, 0), cB, voffB); PG8_STAGE(PG8_SB(0, 1), cB + hsB, voffB); PG8_STAGE(PG8_SA(0, 0), cA, voffA); PG8_STAGE(PG8_SA(0, 1), cA + hsA, voffA);
        if (wr == 1) PG8_BAR;
        PG8_WAIT_V(2); PG8_BAR;
        PG8_STAGE(PG8_SB(1, 0), cB + kstep, voffB); PG8_STAGE(PG8_SA(1, 0), cA + kstep, voffA); PG8_STAGE(PG8_SB(1, 1), cB + hsB + kstep, voffB);
        PG8_WAIT_V(6); PG8_BAR;
    } else {
        PG8_STAGE(PG8_SB(0, 0), cB, voffB); PG8_STAGE(PG8_SA(0, 0), cA, voffA); PG8_STAGE(PG8_SB(0, 1), cB + hsB, voffB); PG8_STAGE(PG8_SA(0, 1), cA + hsA, voffA);
        if (wr == 1) PG8_BAR;
        PG8_WAIT_V(4); PG8_BAR;
        PG8_STAGE(PG8_SB(1, 0), cB + kstep, voffB); PG8_STAGE(PG8_SA(1, 0), cA + kstep, voffA); PG8_STAGE(PG8_SB(1, 1), cB + hsB + kstep, voffB);
        PG8_WAIT_V(6); PG8_BAR;
    }
    for (;;) {
        const bool has_next = S.next(ui + 1, nxt);
        const char* nA = has_next ? (const char*)g.A + (size_t)nxt.pm * tsA : cA; const char* nB = has_next ? (const char*)g.Bt + (size_t)nxt.pn * tsB : cB;
        for (int t = 0; t < nt; t += 2) {
            const bool last = (t == nt - 2);
            const char* a1 = cA + (size_t)(t + 1) * kstep;
            const char* a2 = last ? nA : cA + (size_t)(t + 2) * kstep; const char* b2 = last ? nB : cB + (size_t)(t + 2) * kstep;
            const char* a3 = a2 + kstep; const char* b3 = b2 + kstep;
            if (last && has_next) S.a_ready(nxt);
            if constexpr (SP2) {
            PG8_LDB(B0, 0, 0); PG8_LDB(B1, 0, 1); PG8_SCHED; PG8_LDA(At, 0, 0); PG8_STAGE(PG8_SA(1, 1), a1 + hsA, voffA);
            PG8_WAIT_V(8); PG8_WAIT_L(0); PG8_BAR; PG8_MMA(0, 0, At, B0); PG8_MMA(0, 1, At, B1); PG8_BAR; PG8_SCHED;
            PG8_LDA(At, 0, 1); PG8_STAGE(PG8_SB(0, 0), b2, voffB); PG8_STAGE(PG8_SB(0, 1), b2 + hsB, voffB); PG8_STAGE(PG8_SA(0, 0), a2, voffA);
            PG8_WAIT_V(8); PG8_WAIT_L(0); PG8_BAR; PG8_MMA(1, 0, At, B0); PG8_MMA(1, 1, At, B1); PG8_BAR; PG8_SCHED;
            PG8_LDB(B0, 1, 0); PG8_LDB(B1, 1, 1); PG8_SCHED; PG8_LDA(At, 1, 0); PG8_STAGE(PG8_SA(0, 1), a2 + hsA, voffA);
            PG8_WAIT_V(8); PG8_WAIT_L(0); PG8_BAR; PG8_MMA(0, 0, At, B0); PG8_MMA(0, 1, At, B1); PG8_BAR; PG8_SCHED;
            PG8_LDA(At, 1, 1); PG8_STAGE(PG8_SB(1, 0), b3, voffB); PG8_STAGE(PG8_SB(1, 1), b3 + hsB, voffB); PG8_STAGE(PG8_SA(1, 0), a3, voffA);
            PG8_WAIT_V(8); PG8_WAIT_L(0); PG8_BAR; PG8_MMA(1, 0, At, B0); PG8_MMA(1, 1, At, B1); PG8_BAR; PG8_SCHED;
            } else {
            PG8_LDB(B0, 0, 0); PG8_SCHED; PG8_LDA(At, 0, 0); PG8_STAGE(PG8_SA(1, 1), a1 + hsA, voffA);
            PG8_WAIT_L(8); PG8_BAR; PG8_WAIT_L(0); PG8_MMA(0, 0, At, B0); PG8_BAR; PG8_SCHED;
            PG8_LDB(B1, 0, 1); PG8_STAGE(PG8_SB(0, 0), b2, voffB);
            PG8_BAR; PG8_WAIT_L(0); PG8_MMA(0, 1, At, B1); PG8_BAR;
            PG8_LDA(At, 0, 1); PG8_STAGE(PG8_SA(0, 0), a2, voffA);
            PG8_BAR; PG8_WAIT_L(0); PG8_MMA(1, 0, At, B0); PG8_BAR; PG8_SCHED;
            PG8_STAGE(PG8_SB(0, 1), b2 + hsB, voffB);
            PG8_WAIT_V(6); PG8_BAR; PG8_MMA(1, 1, At, B1); PG8_BAR;
            PG8_LDB(B0, 1, 0); PG8_SCHED; PG8_LDA(At, 1, 0); PG8_STAGE(PG8_SA(0, 1), a2 + hsA, voffA);
            PG8_WAIT_L(8); PG8_BAR; PG8_WAIT_L(0); PG8_MMA(0, 0, At, B0); PG8_BAR; PG8_SCHED;
            PG8_LDB(B1, 1, 1); PG8_STAGE(PG8_SB(1, 0), b3, voffB);
            PG8_BAR; PG8_WAIT_L(0); PG8_MMA(0, 1, At, B1); PG8_BAR;
            PG8_LDA(At, 1, 1); PG8_STAGE(PG8_SA(1, 0), a3, voffA);
            PG8_BAR; PG8_WAIT_L(0); PG8_MMA(1, 0, At, B0); PG8_BAR; PG8_SCHED;
            PG8_STAGE(PG8_SB(1, 1), b3 + hsB, voffB);
            PG8_WAIT_V(6); PG8_BAR; PG8_MMA(1, 1, At, B1); PG8_BAR;
            }
        }
        if constexpr (ALIGN_EPI) { if (wr == 0) PG8_BAR; }
        if constexpr (!Epi::AFTER_DRAIN) { E(acc, cur, wr, wc, fr, fq); S.done(cur); }
        if (!has_next) break;
#pragma unroll
        for (int a = 0; a < 2; ++a)
#pragma unroll
            for (int b = 0; b < 2; ++b)
#pragma unroll
                for (int m = 0; m < 4; ++m)
#pragma unroll
                    for (int n = 0; n < 2; ++n) acc[a][b][m][n] = (f32x4){0.f, 0.f, 0.f, 0.f};
        cur = nxt; cA = nA; cB = nB; ++ui;
        if constexpr (ALIGN_EPI) { if (wr == 1) PG8_BAR; }
    }
    PG8_WAIT_V(0);
    if constexpr (!ALIGN_EPI) { if (wr == 0) PG8_BAR; }
    PG8_BAR;
#undef PG8_SA
#undef PG8_SB
#undef PG8_STAGE
#undef PG8_LDA
#undef PG8_LDB
#undef PG8_MMA
#undef PG8_WAIT_V
#undef PG8_WAIT_L
#undef PG8_BAR
#undef PG8_SCHED
}
}

namespace swa {
constexpr int D = 128;
constexpr float SCALE = 0.08838834764831845f;
constexpr float THR = 8.f;
constexpr int NW = 8, QBLK = 32, KVBLK = 64, QB = NW * QBLK;
constexpr int SHM_V = KVBLK * D * 2, SHM_K = KVBLK * D * 2;
constexpr int LDS_BYTES_ATT = 2 * SHM_V + 2 * SHM_K + NW * 64 * 4;
#define KSWZ(row, colB) ((row) * 256 + ((colB) ^ (((row) & 7) << 4)))
#define SBAR() __builtin_amdgcn_sched_barrier(0)
__device__ __forceinline__ int v_st(int k, int c) { const int kk = (k & ~0xC) | ((k & 4) << 1) | ((k & 8) >> 1); return ((kk >> 3) * 4 + (c >> 5)) * 512 + ((kk & 7) * 32 + (c & 31)) * 2; }
__device__ __forceinline__ int v_rd_base(int lane) { return ((lane & 3) << 3) | (((lane >> 2) & 3) << 6) | (((lane >> 4) & 1) << 5) | (((lane >> 5) & 1) << 8); }
constexpr int v_rd_off(int d0, int ks, int half) { return d0 * 512 + ks * 4096 + half * 2048; }
__device__ __forceinline__ int crow(int r, int hi) { return (r & 3) + 8 * (r >> 2) + 4 * hi; }
__device__ __forceinline__ bf16x8 load8(const bf16_t* p) { return *reinterpret_cast<const bf16x8*>(p); }
__device__ __forceinline__ void mask_tile(f32x16& p0, f32x16& p1, int dq, unsigned W) {
    const float NEG = -__builtin_inff();
#pragma unroll
    for (int r = 0; r < 16; ++r) {
        const int c = (r & 3) + 8 * (r >> 2);
        if ((unsigned)(dq - c) >= W) p0[r] = NEG;
        if ((unsigned)(dq - c - 32) >= W) p1[r] = NEG;
    }
}
__device__ __forceinline__ void partialSM(f32x16& p0, f32x16& p1, float& m_reg, float& mn, float& alpha) {
    float pmax = p0[0];
#pragma unroll
    for (int r = 1; r < 16; ++r) pmax = fmaxf(pmax, p0[r]);
#pragma unroll
    for (int r = 0; r < 16; ++r) pmax = fmaxf(pmax, p1[r]);
    { auto rr = __builtin_amdgcn_permlane32_swap(__float_as_uint(pmax), __float_as_uint(pmax), false, false);
      pmax = fmaxf(__uint_as_float(rr[0]), __uint_as_float(rr[1])); }
    constexpr float C2 = 1.4426950408889634f * SCALE;
    if (__builtin_expect(__all((pmax - m_reg) * SCALE <= THR), 1)) { mn = m_reg; alpha = 1.f; }
    else { mn = fmaxf(m_reg, pmax); alpha = __builtin_amdgcn_exp2f((m_reg - mn) * C2); m_reg = mn; }
    const float mnL = -mn * C2;
#pragma unroll
    for (int r = 0; r < 16; ++r) p0[r] = fmaf(p0[r], C2, mnL);
#pragma unroll
    for (int r = 0; r < 16; ++r) p1[r] = fmaf(p1[r], C2, mnL);
#pragma unroll
    for (int r = 0; r < 16; ++r) p0[r] = __builtin_amdgcn_exp2f(p0[r]);
}
__device__ __forceinline__ void finishSM(f32x16& p0, f32x16& p1, float alpha, float& l_reg, bf16x8& pa0, bf16x8& pa1, bf16x8& pa2, bf16x8& pa3) {
#pragma unroll
    for (int r = 0; r < 16; ++r) p1[r] = __builtin_amdgcn_exp2f(p1[r]);
    float ps = 0;
#pragma unroll
    for (int r = 0; r < 16; ++r) ps += p0[r];
#pragma unroll
    for (int r = 0; r < 16; ++r) ps += p1[r];
    { auto rr = __builtin_amdgcn_permlane32_swap(__float_as_uint(ps), __float_as_uint(ps), false, false);
      ps = __uint_as_float(rr[0]) + __uint_as_float(rr[1]); }
    l_reg = l_reg * alpha + ps;
#define PK4(P, B_, OUT) do { unsigned a0 = cvt_pk_bf16(P[B_+0], P[B_+1]), a1 = cvt_pk_bf16(P[B_+2], P[B_+3]);                          \
        unsigned b0 = cvt_pk_bf16(P[B_+4], P[B_+5]), b1 = cvt_pk_bf16(P[B_+6], P[B_+7]);                                             \
        auto r0 = __builtin_amdgcn_permlane32_swap(a0, b0, false, false); auto r1 = __builtin_amdgcn_permlane32_swap(a1, b1, false, false); \
        u32x4 w = {r0[0], r1[0], r0[1], r1[1]}; OUT = *reinterpret_cast<bf16x8*>(&w); } while (0)
    PK4(p0, 0, pa0); PK4(p0, 8, pa1); PK4(p1, 0, pa2); PK4(p1, 8, pa3);
#undef PK4
}
template <int KB, bool SK>
__device__ __forceinline__ void qkt(f32x16& p0, f32x16& p1, const char* K_lds, int r32, int hi, const bf16x8* qr, bool act) {
    if (SK && !act) { const float NEG = -__builtin_inff();
#pragma unroll
        for (int r = 0; r < 16; ++r) { p0[r] = NEG; p1[r] = NEG; } return; }
    p0 = f32x16{}; p1 = f32x16{};
    const char* kb[4];
#pragma unroll
    for (int dd = 0; dd < 4; ++dd) kb[dd] = K_lds + KB * SHM_K + KSWZ(r32, (dd * 16 + hi * 8) * 2);
#pragma unroll
    for (int d0 = 0; d0 < 8; ++d0) { const char* a = kb[d0 & 3] + (d0 >> 2) * 128;
        bf16x8 b0 = *reinterpret_cast<const bf16x8*>(a);
        bf16x8 b1 = *reinterpret_cast<const bf16x8*>(a + 32 * 256);
        p0 = __builtin_amdgcn_mfma_f32_32x32x16_bf16(b0, qr[d0], p0, 0, 0, 0);
        p1 = __builtin_amdgcn_mfma_f32_32x32x16_bf16(b1, qr[d0], p1, 0, 0, 0); }
}
template <int VB, bool SK>
__device__ __forceinline__ void pv_tile(f32x16* o, int vb0, bf16x8 pa0, bf16x8 pa1, bf16x8 pa2, bf16x8 pa3, bool act) {
    if (SK && !act) return;
#define TRRD(dst, off) asm volatile("ds_read_b64_tr_b16 %0, %1 offset:%2" : "=&v"(dst) : "v"(vb0), "i"(off) : "memory")
#define PV_D0(d0) do { s16x4 l0, l1, l2, l3, h0, h1, h2, h3; constexpr int b_ = VB * SHM_V + v_rd_off(d0, 0, 0); \
        TRRD(l0, b_); TRRD(h0, b_ + 2048); TRRD(l1, b_ + 4096); TRRD(h1, b_ + 6144); TRRD(l2, b_ + 8192); TRRD(h2, b_ + 10240); TRRD(l3, b_ + 12288); TRRD(h3, b_ + 14336); \
        asm volatile("s_waitcnt lgkmcnt(0)" ::: "memory"); SBAR();   \
        o[d0] = __builtin_amdgcn_mfma_f32_32x32x16_bf16(pa0, (bf16x8){l0[0], l0[1], l0[2], l0[3], h0[0], h0[1], h0[2], h0[3]}, o[d0], 0, 0, 0);   \
        o[d0] = __builtin_amdgcn_mfma_f32_32x32x16_bf16(pa1, (bf16x8){l1[0], l1[1], l1[2], l1[3], h1[0], h1[1], h1[2], h1[3]}, o[d0], 0, 0, 0);   \
        o[d0] = __builtin_amdgcn_mfma_f32_32x32x16_bf16(pa2, (bf16x8){l2[0], l2[1], l2[2], l2[3], h2[0], h2[1], h2[2], h2[3]}, o[d0], 0, 0, 0);   \
        o[d0] = __builtin_amdgcn_mfma_f32_32x32x16_bf16(pa3, (bf16x8){l3[0], l3[1], l3[2], l3[3], h3[0], h3[1], h3[2], h3[3]}, o[d0], 0, 0, 0); } while (0)
    PV_D0(0); PV_D0(1); PV_D0(2); PV_D0(3);
#undef PV_D0
#undef TRRD
}
struct BlockRef { const bf16_t* Q; const bf16_t* K; const bf16_t* V; int P0; int b, h; };
struct Seam { bf16x8 qr[8]; bf16x8 st_v0, st_v1, st_k0, st_k1; };
struct Ctx { float* OACC; bf16_t* CAT; const float* GATES; const unsigned long long* SEL; };
__device__ __forceinline__ int swa_jlo(int P0, int W) { const int lowk = P0 - W + 1; return lowk > 0 ? lowk / KVBLK : 0; }
#define ROWU(p, k0, h) ((p) + (size_t)((k0) + 32 * (h)) * D + loff)
#define VMW() asm volatile("s_waitcnt vmcnt(0)" ::: "memory")
#define VMWN(n) asm volatile("s_waitcnt vmcnt(%0)" :: "i"(n) : "memory")
#define SLOAD_H(Kp, Vp, k0) do { S.st_v0 = load8(ROWU(Vp, k0, 0)); S.st_v1 = load8(ROWU(Vp, k0, 1));              \
                         S.st_k0 = load8(ROWU(Kp, k0, 0)); S.st_k1 = load8(ROWU(Kp, k0, 1)); } while (0)
#define SWRITE_HK(bf) do { *(bf16x8*)(K_lds + (bf) * SHM_K + kws) = S.st_k0; *(bf16x8*)(K_lds + (bf) * SHM_K + kws + 32 * 256) = S.st_k1; } while (0)
#define SWRITE_HV(bf) do { *(bf16x8*)(V_lds + (bf) * SHM_V + vst0) = S.st_v0; *(bf16x8*)(V_lds + (bf) * SHM_V + vst1) = S.st_v1; } while (0)
#define SWRITE_H(bf) do { SWRITE_HV(bf); SWRITE_HK(bf); } while (0)
__device__ __forceinline__ void swa_prime(const BlockRef& cur, int W, char* lds, Seam& S, int wid, int lane) {
    const int tid = wid * 64 + lane, r32 = lane & 31, hi = lane >> 5;
    const int sr = tid >> 4, sc = (tid & 15) * 8, kws = KSWZ(sr, sc * 2); char* K_lds = lds + 2 * SHM_V;
    const unsigned loff = (unsigned)(sr * D + sc), qoff = (unsigned)(r32 * D + hi * 8);
    const int kb0 = swa_jlo(cur.P0, W) * KVBLK;
#pragma unroll
    for (int d0 = 0; d0 < 8; ++d0) S.qr[d0] = load8(cur.Q + (size_t)(wid * QBLK) * D + d0 * 16 + qoff);
    SLOAD_H(cur.K, cur.V, kb0); VMW(); SWRITE_HK(0);
    __syncthreads();
}
template <int MODE, bool SK>
__device__ __forceinline__ void swa_block(const BlockRef& cur, const BlockRef& nxt, int W, int Wn, char* lds, Seam& S, const Ctx& X, int wid, int lane) {
    constexpr int skv = 4096;
    const int tid = wid * 64 + lane, r32 = lane & 31, hi = lane >> 5;
    const int j_lo = swa_jlo(cur.P0, W);
    int j_hi = (cur.P0 + QB - 1) / KVBLK + 1; if (j_hi > skv / KVBLK) j_hi = skv / KVBLK;
    const int NT = j_hi - j_lo;
    const int kbn = swa_jlo(nxt.P0, Wn) * KVBLK;
    const int qlo = cur.P0 + wid * QBLK, qm = qlo + r32 - 4 * hi;
    char* V_lds = lds; char* K_lds = lds + 2 * SHM_V;
    float* ws = (float*)(lds + 2 * SHM_V + 2 * SHM_K) + wid * 64; float* li_l = ws, * al_l = ws + 32;
    float m_reg = -1e30f, l_reg = 0; f32x16 o[4] = {};
    const int sr = tid >> 4, sc = (tid & 15) * 8, vst0 = v_st(sr, sc), vst1 = v_st(32 + sr, sc), kws = KSWZ(sr, sc * 2);
    const unsigned loff = (unsigned)(sr * D + sc), qoff = (unsigned)(r32 * D + hi * 8);
    const int vb0 = (int)(uintptr_t)V_lds + v_rd_base(lane);
    const bf16_t* Kh = cur.K; const bf16_t* Vh = cur.V;
    unsigned long long sel_ = ~0ull;
    if constexpr (MODE == 1) sel_ = X.SEL[(size_t)(cur.b * NG + (cur.h >> 2)) * T + qlo + r32];
#define RESC(a) do { if (__any((a) < 1.f)) { if (hi == 0) al_l[r32] = (a); asm volatile("s_waitcnt lgkmcnt(0)" ::: "memory");              \
                     for (int d_ = 0; d_ < 4; ++d_) for (int r = 0; r < 16; ++r) o[d_][r] *= al_l[crow(r, hi)]; } } while (0)
#define KBASE(t) ((j_lo + (t)) * KVBLK)
#define ACT(t) (KBASE(t) <= qlo + QBLK - 1 && KBASE(t) + KVBLK - 1 >= qlo - W + 1)
#define MASKT(P0_, P1_, t) do { const int kb_ = KBASE(t); if ((!SK || ACT(t)) && (kb_ + KVBLK - 1 > qlo || kb_ <= qlo + QBLK - 1 - W)) mask_tile(P0_, P1_, qm - kb_, (unsigned)W); \
        if constexpr (MODE == 1) { if (!((sel_ >> (j_lo + (t))) & 1ull)) { const float NEG_ = -__builtin_inff(); _Pragma("unroll") for (int r_ = 0; r_ < 16; ++r_) { P0_[r_] = NEG_; P1_[r_] = NEG_; } } } } while (0)
    constexpr int NQL = 8;
#define SEAM_K0() do { VMWN(NQL); SWRITE_HK(0); SBAR(); } while (0)
    f32x16 pA0, pA1, pB0, pB1; float mnA, mnB, alA, alB; bf16x8 pa0, pa1, pa2, pa3;
    SWRITE_HV(0); SBAR();
    if (NT > 1) { SLOAD_H(Kh, Vh, KBASE(1)); }
    SBAR(); qkt<0, SK>(pA0, pA1, K_lds, r32, hi, S.qr, ACT(0));
    MASKT(pA0, pA1, 0); partialSM(pA0, pA1, m_reg, mnA, alA);
    if (NT > 1) { VMW(); SWRITE_H(1); }
    __syncthreads();
#define HALF_STEP(PX0, PX1, mnX, alX, PY0, PY1, alY, t, KB, VB, SB) do {                                                      \
        SBAR(); qkt<KB, SK>(PX0, PX1, K_lds, r32, hi, S.qr, ACT(t));                                             \
        finishSM(PY0, PY1, alY, l_reg, pa0, pa1, pa2, pa3); SBAR();                                                           \
        if ((t) + 1 < NT) { SLOAD_H(Kh, Vh, KBASE((t) + 1)); SBAR(); }                                               \
        pv_tile<VB, SK>(o, vb0, pa0, pa1, pa2, pa3, ACT((t) - 1)); MASKT(PX0, PX1, (t)); partialSM(PX0, PX1, m_reg, mnX, alX);                                        \
        __syncthreads();                                                                                                      \
        if ((t) + 1 < NT) { VMW(); SWRITE_H(SB); }                                                                          \
        RESC(alX); __syncthreads(); } while (0)
    for (int t = 1; t + 1 < NT; t += 2) {
        HALF_STEP(pB0, pB1, mnB, alB, pA0, pA1, alA, t, 1, 0, 0);
        HALF_STEP(pA0, pA1, mnA, alA, pB0, pB1, alB, t + 1, 0, 1, 1);
    }
    const bool even = (NT & 1) == 0;
    if (even) { SBAR(); qkt<1, SK>(pB0, pB1, K_lds, r32, hi, S.qr, ACT(NT - 1)); SBAR(); }
    SLOAD_H(nxt.K, nxt.V, kbn); SBAR();
#pragma unroll
    for (int d0 = 0; d0 < 8; ++d0) S.qr[d0] = load8(nxt.Q + (size_t)(wid * QBLK) * D + d0 * 16 + qoff);
    SBAR();
    finishSM(pA0, pA1, alA, l_reg, pa0, pa1, pa2, pa3); SBAR();
    pv_tile<0, SK>(o, vb0, pa0, pa1, pa2, pa3, ACT(even ? NT - 2 : NT - 1));
    if (even) { MASKT(pB0, pB1, NT - 1); partialSM(pB0, pB1, m_reg, mnB, alB); __syncthreads(); RESC(alB);
        finishSM(pB0, pB1, alB, l_reg, pa0, pa1, pa2, pa3); SBAR(); pv_tile<1, SK>(o, vb0, pa0, pa1, pa2, pa3, ACT(NT - 1)); }
    SBAR(); SEAM_K0();
    if (hi == 0) li_l[r32] = __builtin_amdgcn_rcpf(l_reg) * X.GATES[(size_t)(cur.b * T + qlo + r32) * 48 + 3 * cur.h + (MODE == 1 ? 1 : 2)];
    asm volatile("s_waitcnt lgkmcnt(0)" ::: "memory");
    float rli[16];
#pragma unroll
    for (int r = 0; r < 16; ++r) rli[r] = li_l[crow(r, hi)];
    int hie = hi; asm volatile("" : "+v"(hie));
    const unsigned eo = (unsigned)(4 * hie * D + r32), ec = (unsigned)(4 * hie * DM + r32);
    float* Ob = X.OACC + ((size_t)(cur.b * NH + cur.h) * T + qlo) * D;
    bf16_t* Cb = X.CAT + (size_t)(cur.b * T + qlo) * DM + cur.h * HD;
#pragma unroll
    for (int r = 0; r < 16; ++r) { const int cr = (r & 3) + 8 * (r >> 2);
        float* op = Ob + (size_t)cr * D + eo;
        float ov[4];
#pragma unroll
        for (int d0 = 0; d0 < 4; ++d0) ov[d0] = op[d0 * 32];
#pragma unroll
        for (int d0 = 0; d0 < 4; ++d0) { const float v = ov[d0] + o[d0][r] * rli[r];
            if constexpr (MODE == 1) { op[d0 * 32] = v; }
            else { const float vn = __shfl_xor(v, 1);
                   if ((r32 & 1) == 0) *(unsigned*)(Cb + (size_t)cr * DM + d0 * 32 + ec) = cvt_pk_bf16(v, vn); } }
        asm volatile("" ::: "memory"); }
    __syncthreads();
#undef RESC
#undef KBASE
#undef ACT
#undef MASKT
#undef SEAM_K0
#undef HALF_STEP
}
#undef ROWU
#undef VMW
#undef VMWN
#undef SLOAD_H
#undef SWRITE_HK
#undef SWRITE_HV
#undef SWRITE_H

__host__ __device__ inline int swa_nramp(int nqb, int W) { const int t = W - 1; const int n = t < 0 ? 0 : t / QB + 1; return n > nqb ? nqb : n; }
struct SwaItem { int bh, qb0, qb1; };
__device__ __forceinline__ SwaItem swa_decode(int L, int nqb, int nx, int nramp) {
    SwaItem it; const int xcd = L & 7, k = L >> 3; it.bh = xcd * 4 + k / nx; const int x = k % nx;
    const int ns = nqb - nramp;
    if (x < ns) { it.qb0 = it.qb1 = nqb - 1 - x; } else { it.qb0 = x - ns; it.qb1 = nramp - 1 - it.qb0; }
    return it;
}
template <int MODE>
__device__ __forceinline__ BlockRef swa_ref(const SwaItem& it, int pass, const bf16_t* Q, const bf16_t* K, const bf16_t* V) {
    const int qb = pass ? it.qb1 : it.qb0, kvh = it.bh >> 2;
    BlockRef r; r.Q = Q + ((size_t)it.bh * T + (size_t)qb * QB) * D; r.K = K + (size_t)kvh * T * D; r.V = V + (size_t)kvh * T * D; r.P0 = qb * QB; r.b = it.bh >> 4; r.h = it.bh & 15;
    return r;
}
template <int MODE, bool SK>
__device__ __forceinline__ void swa_phase(char* lds, const bf16_t* Q, const bf16_t* K, const bf16_t* V, const Ctx& X, int W, int Wdeal, int c, int G, int wid, int lane) {
    constexpr int nqb = T / QB;
    const int nramp = swa_nramp(nqb, Wdeal),
               nx = (nramp + 1) / 2 + (nqb - nramp), total = nx * NB * NH;
    int L = c; if (L >= total) return;
    SwaItem it = swa_decode(L, nqb, nx, nramp); int pass = 0;
    BlockRef cur = swa_ref<MODE>(it, 0, Q, K, V);
    Seam S;
    swa_prime(cur, W, lds, S, wid, lane);
    for (;;) {
        const bool more_pass = pass == 0 && it.qb1 != it.qb0, more_item = L + G < total, last = !more_pass && !more_item;
        SwaItem itn = it; int passn = pass + 1, Ln = L;
        if (!more_pass) { passn = 0; Ln = more_item ? L + G : L; itn = swa_decode(Ln, nqb, nx, nramp); }
        const BlockRef nxt = last ? cur : swa_ref<MODE>(itn, passn, Q, K, V);
        swa_block<MODE, SK>(cur, nxt, W, W, lds, S, X, wid, lane);
        if (last) break;
        cur = nxt; it = itn; pass = passn; L = Ln;
    }
}
}

#define XB_TMO      128
#define XB_XCNT(j)  (256  + 64 * (j))
#define XB_XSUB(j)  (1280 + 64 * (j))
#define XB_XGEN(j)  (2304 + 64 * (j))
#define XB_TOP      3328
#define XB_TOPGEN   3392
#define XCD_BAR_WORDS 3456
#define XB_SPIN_CAP (1u << 18)
__device__ __forceinline__ unsigned xb_ld(unsigned* p)              { return __hip_atomic_load(p, __ATOMIC_RELAXED, __HIP_MEMORY_SCOPE_AGENT); }
__device__ __forceinline__ unsigned xb_add(unsigned* p, unsigned v) { return __hip_atomic_fetch_add(p, v, __ATOMIC_RELAXED, __HIP_MEMORY_SCOPE_AGENT); }
__device__ __forceinline__ unsigned xb_xcc_id() { return (unsigned)__builtin_amdgcn_s_getreg((3 << 11) | 20) & 0xFu; }
#define XB_SPIN(cond, bar) do { unsigned _sp = 0; while (cond) { __builtin_amdgcn_s_sleep(1); \
    if ((++_sp & 255u) == 0u) { if (xb_ld(&(bar)[XB_TMO])) break; if (_sp > XB_SPIN_CAP) { atomicAdd(&(bar)[XB_TMO], 1u); break; } } } } while (0)
struct XcdBarrier { unsigned* bar; unsigned x; volatile LAS unsigned* st; };
__device__ __forceinline__ XcdBarrier xcd_barrier_post(unsigned* bar, volatile LAS unsigned* st, bool t0) {
    XcdBarrier b; b.bar = bar; b.x = xb_xcc_id(); b.st = st;
    if (t0) (void)xb_add(&bar[XB_XCNT(b.x)], 1u);
    return b;
}
__device__ __forceinline__ void xcd_barrier_complete(unsigned* bar, unsigned x, unsigned& nloc, unsigned& nx) {
    const unsigned G = gridDim.x * gridDim.y * gridDim.z;
    unsigned sum, cnt, mine, sp = 0u;
    for (;;) {
        sum = 0u; cnt = 0u; mine = 0u;
#pragma unroll
        for (unsigned j = 0; j < 16; ++j) { const unsigned c = xb_ld(&bar[XB_XCNT(j)]); sum += c; cnt += (c > 0u) ? 1u : 0u; mine = (j == x) ? c : mine; }
        if (sum == G) break;
        __builtin_amdgcn_s_sleep(1);
        if ((++sp & 255u) == 0u) { if (xb_ld(&bar[XB_TMO])) break; if (sp > XB_SPIN_CAP) { atomicAdd(&bar[XB_TMO], 1u); break; } }
    }
    nloc = mine > 0u ? mine : 1u; nx = cnt > 0u ? cnt : 1u;
}
__device__ __forceinline__ void xcd_barrier(const XcdBarrier& b, bool t0) {
    asm volatile("s_waitcnt vmcnt(0)" ::: "memory");
    __syncthreads();
    if (t0) {
        unsigned* bar = b.bar;
        __builtin_amdgcn_s_waitcnt(0);
        unsigned nloc = b.st[0], nx = b.st[1];
        if (nloc == 0u) { xcd_barrier_complete(bar, b.x, nloc, nx); b.st[0] = nloc; b.st[1] = nx; }
        const unsigned old = xb_add(&bar[XB_XSUB(b.x)], 1u);
        const unsigned gen = old / nloc;
        if (old + 1u == (gen + 1u) * nloc) {
            __builtin_amdgcn_fence(__ATOMIC_RELEASE, "agent");
            asm volatile("s_waitcnt vmcnt(0)" ::: "memory");
            const unsigned og = xb_add(&bar[XB_TOP], 1u);
            const unsigned tg = og / nx;
            if (og + 1u == (tg + 1u) * nx) xb_add(&bar[XB_TOPGEN], 1u);
            else XB_SPIN(xb_ld(&bar[XB_TOPGEN]) == tg, bar);
            __builtin_amdgcn_fence(__ATOMIC_ACQUIRE, "agent");
            xb_add(&bar[XB_XGEN(b.x)], 1u);
            asm volatile("s_waitcnt vmcnt(0)" ::: "memory");
        } else {
            XB_SPIN(xb_ld(&bar[XB_XGEN(b.x)]) == gen, bar);
            __builtin_amdgcn_fence(__ATOMIC_ACQUIRE, "agent");
            asm volatile("s_waitcnt vmcnt(0)" ::: "memory");
        }
    }
    __syncthreads();
}

struct Args {
    const float* in[24]; float* out; unsigned char* ws; int ph_lo, ph_hi, G, pad;
};
__device__ __forceinline__ float wave_sum(float v) {
#pragma unroll
    for (int o = 1; o < 64; o <<= 1) v += __shfl_xor(v, o);
    return v;
}
__device__ __forceinline__ f32x4 mfma16(bf16x8 a, bf16x8 b, f32x4 c) { return __builtin_amdgcn_mfma_f32_16x16x32_bf16(a, b, c, 0, 0, 0); }

__device__ __forceinline__ void tr_load(const float* W, int ldw, int k0, int n0, int lane, f32x4 (&v)[16]) {
    const float* src = W + (size_t)(k0 + (lane >> 4)) * ldw + n0 + 4 * (lane & 15);
#pragma unroll
    for (int i = 0; i < 16; ++i) v[i] = __builtin_nontemporal_load((const f32x4*)(src + (size_t)(4 * i) * ldw));
}
__device__ __forceinline__ void tr_finish(const f32x4 (&v)[16], int k0, bf16_t* WT, size_t drow0, int ldt, LAS float* scr, int lane, const float* gn  ) {
#pragma unroll
    for (int i = 0; i < 16; ++i) { LAS float* s = scr + ((lane >> 4) + 4 * i) * 65 + 4 * (lane & 15); s[0] = v[i][0]; s[1] = v[i][1]; s[2] = v[i][2]; s[3] = v[i][3]; }
    LDS_WAIT();
    const int c = lane & 7;
    f32x4 g0 = {1.f, 1.f, 1.f, 1.f}, g1 = {1.f, 1.f, 1.f, 1.f};
    if (gn) { g0 = *(const f32x4*)(gn + 8 * c); g1 = *(const f32x4*)(gn + 8 * c + 4); }
#pragma unroll
    for (int j = 0; j < 8; ++j) { const int n = (lane >> 3) + 8 * j; const LAS float* s = scr + (8 * c) * 65 + n;
        u32x4 o; o.x = cvt_pk_bf16(s[0 * 65] * g0[0], s[1 * 65] * g0[1]); o.y = cvt_pk_bf16(s[2 * 65] * g0[2], s[3 * 65] * g0[3]); o.z = cvt_pk_bf16(s[4 * 65] * g1[0], s[5 * 65] * g1[1]); o.w = cvt_pk_bf16(s[6 * 65] * g1[2], s[7 * 65] * g1[3]);
        if (ldt > 0) *(u32x4*)(WT + (drow0 + n) * (size_t)ldt + k0 + 8 * c) = o;
        else { const int row = (int)drow0 + n, k = k0 + 8 * c;
               *(u32x4*)(WT + ((size_t)((row >> 4) * ((-ldt) >> 5) + (k >> 5)) * 64 + ((k >> 3) & 3) * 16 + (row & 15)) * 8) = o; } }
    LDS_WAIT();
}
__device__ __forceinline__ void rms_row_bf16(const float* xrow, const float* gain, bf16_t* orow, int lane) {
    const f32x4* xr = (const f32x4*)xrow + lane; const f32x4* gr = (const f32x4*)gain + lane;
    f32x4 v[16]; float s = 0.f;
#pragma unroll
    for (int j = 0; j < 16; ++j) { v[j] = xr[64 * j]; s += (v[j][0] * v[j][0] + v[j][1] * v[j][1]) + (v[j][2] * v[j][2] + v[j][3] * v[j][3]); }
    const float r = 1.0f / sqrtf(wave_sum(s) * (1.0f / DM) + EPS);
    u32x2* o8 = (u32x2*)orow + lane;
#pragma unroll
    for (int j = 0; j < 16; ++j) { const f32x4 g = gr[64 * j]; u32x2 w; w.x = cvt_pk_bf16(v[j][0] * r * g[0], v[j][1] * r * g[1]); w.y = cvt_pk_bf16(v[j][2] * r * g[2], v[j][3] * r * g[3]); o8[64 * j] = w; }
}
__device__ __forceinline__ void rms_row_f32(const float* xrow, const float* gain, float* orow, int lane) {
    const f32x4* xr = (const f32x4*)xrow + lane; const f32x4* gr = (const f32x4*)gain + lane;
    f32x4 v[16]; float s = 0.f;
#pragma unroll
    for (int j = 0; j < 16; ++j) { v[j] = xr[64 * j]; s += (v[j][0] * v[j][0] + v[j][1] * v[j][1]) + (v[j][2] * v[j][2] + v[j][3] * v[j][3]); }
    const float r = 1.0f / sqrtf(wave_sum(s) * (1.0f / DM) + EPS);
    f32x4* o = (f32x4*)orow + lane;
#pragma unroll
    for (int j = 0; j < 16; ++j) { const f32x4 g = gr[64 * j]; o[64 * j] = v[j] * r * g; }
}

__device__ const float ROPE_INV_FREQ[16] = {1.0f, 0.44036659598350525f, 0.1939227432012558f, 0.08539710193872452f, 0.03760603070259094f, 0.01656043902039528f, 0.007292664609849453f,
    0.0032114458736032248f, 0.0014142135623842478f, 0.000622772378847003f, 0.00027424818836152554f, 0.00012076973507646471f, 5.318296098266728e-05f, 2.34199997066753e-05f,
    1.0313386155758053e-05f, 4.541670477919979e-06f};

__device__ __forceinline__ void compress_item(LAS unsigned char* lds, int which, int rt, const bf16_t* X0, const float* cb, const bf16_t* W1, const bf16_t* W2,
                                              bf16_t* KCMP, bf16_t* VCMPT, int wave, int lane) {
    const int fr = lane & 15, q4 = lane >> 4;
    const int bgi = (rt * 16) >> 8, n = ((rt * 16) & 255) + fr;
    const bf16_t* X = X0 + (size_t)bgi * T * HD + 8 * q4;
    f32x4 acc0 = {0.f, 0.f, 0.f, 0.f}, acc1 = {0.f, 0.f, 0.f, 0.f};
    const bf16_t* w1p = W1 + ((size_t)(2 * wave) * 128 * 64 + lane) * 8;
#define CMP_LOADG(gq, A, B0, B1) do { _Pragma("unroll") for (int j = 0; j < 8; ++j) { const int ks = 8 * (gq) + j; int tok = 16 * n + 2 * (gq) + (j >> 2); tok = tok > (T - 1) ? (T - 1) : tok; \
        A[j] = *(const bf16x8*)(X + (size_t)tok * HD + 32 * (j & 3)); B0[j] = *(const bf16x8*)(w1p + (size_t)ks * 512); B1[j] = *(const bf16x8*)(w1p + (size_t)(128 + ks) * 512); } } while (0)
#define CMP_COMPG(A, B0, B1) do { _Pragma("unroll") for (int j = 0; j < 8; ++j) { acc0 = mfma16(A[j], B0[j], acc0); acc1 = mfma16(A[j], B1[j], acc1); } } while (0)
    bf16x8 a_0[8], b0_0[8], b1_0[8], a_1[8], b0_1[8], b1_1[8];
    CMP_LOADG(0, a_0, b0_0, b1_0);
    for (int gq = 0; gq < 16; gq += 2) {
        CMP_LOADG(gq + 1, a_1, b0_1, b1_1);
        CMP_COMPG(a_0, b0_0, b1_0);
        if (gq + 2 < 16) CMP_LOADG(gq + 2, a_0, b0_0, b1_0);
        CMP_COMPG(a_1, b0_1, b1_1);
    }
#undef CMP_LOADG
#undef CMP_COMPG
    const float cb0 = cb[32 * wave + fr], cb1 = cb[32 * wave + 16 + fr];
    LAS unsigned short* hid = (LAS unsigned short*)lds;
#pragma unroll
    for (int i = 0; i < 4; ++i) {
        hid[(4 * q4 + i) * 264 + 32 * wave + fr] = (unsigned short)(cvt_pk_bf16(gelu_tanh(acc0[i] + cb0), 0.f) & 0xffffu);
        hid[(4 * q4 + i) * 264 + 32 * wave + 16 + fr] = (unsigned short)(cvt_pk_bf16(gelu_tanh(acc1[i] + cb1), 0.f) & 0xffffu);
    }
    LDS_WAIT(); __syncthreads();
    f32x4 o = {0.f, 0.f, 0.f, 0.f};
    const bf16_t* w2p = W2 + (size_t)(16 * wave + fr) * 256 + 8 * q4;
#pragma unroll
    for (int ks = 0; ks < 8; ++ks) { const bf16x8 a2 = *(const LAS bf16x8*)(hid + fr * 264 + 32 * ks + 8 * q4); const bf16x8 b2 = *(const bf16x8*)(w2p + 32 * ks); o = mfma16(a2, b2, o); }
    const int nn = ((rt * 16) & 255) + 4 * q4, dcol = 16 * wave + fr;
    if (which == 0) {
#pragma unroll
        for (int i = 0; i < 4; ++i) KCMP[((size_t)bgi * 256 + nn + i) * HD + dcol] = (bf16_t)(cvt_pk_bf16(o[i], 0.f) & 0xffffu);
    } else {
        u32x2 w; w.x = cvt_pk_bf16(o[0], o[1]); w.y = cvt_pk_bf16(o[2], o[3]);
        *(u32x2*)(VCMPT + ((size_t)bgi * HD + dcol) * 256 + nn) = w;
    }
    __syncthreads();
}

__device__ __forceinline__ void cmp_attn_item(LAS unsigned char* lds, int bg, int tt, const bf16_t* QH, const bf16_t* KCMP, const bf16_t* VCMPT, const float* GATES,
                                              float* OACC, unsigned long long* SEL, int wave, int lane) {
    const int fr = lane & 15, q4 = lane >> 4, b = bg >> 2, g = bg & 3;
    const int t0w = tt * 32 + wave * 4;
    LAS unsigned short* pL = (LAS unsigned short*)(lds + wave * 8448);
    LAS float* impL = (LAS float*)(lds + 8 * 8448 + wave * 4160);
    LAS float* scL = (LAS float*)(lds + 8 * 8448 + 8 * 4160 + wave * 1024);
    const bf16_t* qrow = QH + ((size_t)((b * NH + g * 4 + (fr & 3)) * T + t0w + (fr >> 2))) * HD + 8 * q4;
    bf16x8 aq[4];
#pragma unroll
    for (int ks = 0; ks < 4; ++ks) aq[ks] = *(const bf16x8*)(qrow + 32 * ks);
    const bf16_t* kb = KCMP + (size_t)bg * 256 * HD + (size_t)fr * HD + 8 * q4;
    const int nlast = (t0w + 3 >= 31) ? ((t0w + 3 - 31) >> 4) : -1, Tmax = nlast >> 4, Kmax = nlast >> 5;
    f32x4 s[16];
#pragma unroll
    for (int Tt = 0; Tt < 16; ++Tt) { f32x4 a = {0.f, 0.f, 0.f, 0.f};
        if (Tt <= Tmax) {
#pragma unroll
            for (int ks = 0; ks < 4; ++ks) { const bf16x8 bk = *(const bf16x8*)(kb + (size_t)(16 * Tt) * HD + 32 * ks); a = mfma16(aq[ks], bk, a); } }
        s[Tt] = a; }
    const int t = t0w + q4;
    const int nmax = (t >= 31) ? ((t - 31) >> 4) : -1;
    const float NEGI = -__builtin_inff();
    float mx[4] = {NEGI, NEGI, NEGI, NEGI};
#pragma unroll
    for (int Tt = 0; Tt < 16; ++Tt) { const bool valid = (16 * Tt + fr) <= nmax;
#pragma unroll
        for (int i = 0; i < 4; ++i) mx[i] = valid ? fmaxf(mx[i], s[Tt][i]) : mx[i]; }
#pragma unroll
    for (int i = 0; i < 4; ++i) {
#pragma unroll
        for (int o = 1; o < 16; o <<= 1) mx[i] = fmaxf(mx[i], __shfl_xor(mx[i], o)); }
    constexpr float C2 = 1.4426950408889634f * 0.08838834764831845f;
    float sum[4] = {0.f, 0.f, 0.f, 0.f};
#pragma unroll
    for (int Tt = 0; Tt < 16; ++Tt) { const bool valid = (16 * Tt + fr) <= nmax;
#pragma unroll
        for (int i = 0; i < 4; ++i) { const float p = valid ? __builtin_amdgcn_exp2f((s[Tt][i] - mx[i]) * C2) : 0.f; s[Tt][i] = p; sum[i] += p; } }
#pragma unroll
    for (int i = 0; i < 4; ++i) {
#pragma unroll
        for (int o = 1; o < 16; o <<= 1) sum[i] += __shfl_xor(sum[i], o);
        sum[i] = sum[i] > 0.f ? 1.0f / sum[i] : 0.f; }
#pragma unroll
    for (int Tt = 0; Tt < 16; ++Tt) {
#pragma unroll
        for (int i = 0; i < 4; ++i) s[Tt][i] *= sum[i];
        impL[q4 * 260 + 16 * Tt + fr] = ((s[Tt][0] + s[Tt][1]) + s[Tt][2]) + s[Tt][3];
#pragma unroll
        for (int i = 0; i < 4; ++i) pL[(4 * q4 + i) * 264 + 16 * Tt + fr] = (unsigned short)(cvt_pk_bf16(s[Tt][i], 0.f) & 0xffffu);
    }
    LDS_WAIT();
    bf16x8 pf[8];
#pragma unroll
    for (int ks = 0; ks < 8; ++ks) pf[ks] = *(const LAS bf16x8*)(pL + fr * 264 + 32 * ks + 8 * q4);
    const bf16_t* vb = VCMPT + (size_t)bg * HD * 256 + (size_t)fr * 256 + 8 * q4;
    float gt[4];
#pragma unroll
    for (int i = 0; i < 4; ++i) gt[i] = GATES[(size_t)(b * T + t) * 48 + 3 * (g * 4 + i) + 0];
#pragma unroll
    for (int Dt = 0; Dt < 8; ++Dt) { f32x4 o = {0.f, 0.f, 0.f, 0.f};
#pragma unroll
        for (int ks = 0; ks < 8; ++ks) if (ks <= Kmax) { const bf16x8 bv = *(const bf16x8*)(vb + (size_t)(16 * Dt) * 256 + 32 * ks); o = mfma16(pf[ks], bv, o); }
#pragma unroll
        for (int i = 0; i < 4; ++i) OACC[((size_t)((b * NH + g * 4 + i) * T + t)) * HD + 16 * Dt + fr] = o[i] * gt[i]; }
    const LAS float* im = impL + q4 * 260;
    const int cur = t >> 6;
    float myv[4];
#pragma unroll
    for (int k = 0; k < 4; ++k) { const int jj = fr + 16 * k;
        const float m0 = jj > 0 ? im[4 * jj - 1] : 0.f, m1 = im[4 * jj], m2 = im[4 * jj + 1], m3 = im[4 * jj + 2], nx = im[4 * jj + 3];
        float sc = (((m0 + m1) + m2) + m3) - 0.5f * m0 + 0.5f * nx;
        sc = (jj == cur || jj == 0) ? 1e30f : (jj > cur ? -1e30f : sc);
        myv[k] = sc; scL[q4 * 64 + jj] = sc; }
    LDS_WAIT();
    int rank[4] = {0, 0, 0, 0};
#pragma unroll 8
    for (int i = 0; i < 64; ++i) { const float si = scL[q4 * 64 + i];
#pragma unroll
        for (int k = 0; k < 4; ++k) rank[k] += ((si > myv[k]) || (si == myv[k] && i < fr + 16 * k)) ? 1 : 0; }
    unsigned long long msk = 0ull;
#pragma unroll
    for (int k = 0; k < 4; ++k) { const unsigned long long bal = __ballot(rank[k] < 16); msk |= ((bal >> (16 * q4)) & 0xffffull) << (16 * k); }
    if (fr == 0) SEL[(size_t)bg * T + t] = msk;
    LDS_WAIT();
}

__device__ __forceinline__ void gate_task(LAS unsigned char* lds, int g, int dq, int bc0, int nbc, const bf16_t* V, bf16_t* U, const float* SUMS, const float* ln_g, const float* ln_b,
                                          const bf16_t* WM, const float* bs, int tid, int wave, int lane) {
    const int fr = lane & 15, q4 = lane >> 4;
    const int col0 = g * 768 + dq * 128;
    const int cc = tid & 15, s0 = tid >> 4;
    const f32x4 lg0 = *(const f32x4*)(ln_g + col0 + 8 * cc), lg1 = *(const f32x4*)(ln_g + col0 + 8 * cc + 4), lb0 = *(const f32x4*)(ln_b + col0 + 8 * cc), lb1 = *(const f32x4*)(ln_b + col0 + 8 * cc + 4);
    bf16x8 wf[4];
    const bf16_t* wp = WM + ((size_t)g * 128 + 16 * wave + fr) * 128 + 8 * q4;
#pragma unroll
    for (int ks = 0; ks < 4; ++ks) wf[ks] = *(const bf16x8*)(wp + 32 * ks);
    const int tt = 16 * wave + fr, kmax = wave >> 1;
    const float bias = bs[g * 128 + tt];
    const unsigned kf = (unsigned)((fr >> 3) ^ ((fr & 7) << 1)), rdl = ((unsigned)q4 ^ kf) << 4;
    u32x4 vraw[4]; f32x2 st[4];
    const bf16_t* vp = V + (size_t)(bc0 * 128 + s0) * GW + col0 + 8 * cc;
    const float* sp = SUMS + (size_t)(bc0 * 128 + s0) * 2;
#pragma unroll
    for (int j = 0; j < 4; ++j) { vraw[j] = *(const u32x4*)(vp + (size_t)(32 * j) * GW); st[j] = *(const f32x2*)(sp + 64 * j); }
    for (int i = 0; i < nbc; ++i) {
        const int row0 = (bc0 + i) * 128;
#pragma unroll
        for (int j = 0; j < 4; ++j) { const int sidx = s0 + 32 * j;
            const float mean = st[j][0] * (1.0f / GW); float var = st[j][1] * (1.0f / GW) - mean * mean; var = var > 0.f ? var : 0.f; const float rstd = 1.0f / sqrtf(var + EPS);
            const float x[8] = {bflo(vraw[j].x), bfhi(vraw[j].x), bflo(vraw[j].y), bfhi(vraw[j].y), bflo(vraw[j].z), bfhi(vraw[j].z), bflo(vraw[j].w), bfhi(vraw[j].w)};
#pragma unroll
            for (int e = 0; e < 8; ++e) { const float gg = e < 4 ? lg0[e & 3] : lg1[e & 3], bb = e < 4 ? lb0[e & 3] : lb1[e & 3];
                const float y = (x[e] - mean) * rstd * gg + bb;
                const unsigned off = (unsigned)(8 * cc + e) * 256u + ((((unsigned)(sidx >> 3)) ^ ((unsigned)cc ^ (unsigned)(2 * e))) & 15u) * 16u + (unsigned)(sidx & 7) * 2u;
                *(LAS unsigned short*)(lds + off) = (unsigned short)(cvt_pk_bf16(y, 0.f) & 0xffffu); } }
        if (i + 1 < nbc) {
            const bf16_t* vn = V + (size_t)(row0 + 128 + s0) * GW + col0 + 8 * cc; const float* sn = SUMS + (size_t)(row0 + 128 + s0) * 2;
#pragma unroll
            for (int j = 0; j < 4; ++j) { vraw[j] = *(const u32x4*)(vn + (size_t)(32 * j) * GW); st[j] = *(const f32x2*)(sn + 64 * j); } }
        bf16_t* up = U + (size_t)(row0 + tt) * GW + col0 + 4 * q4;
        u32x2 u4[8];
#pragma unroll
        for (int nt = 0; nt < 8; ++nt) u4[nt] = *(const u32x2*)(up + 16 * nt);
        LDS_WAIT(); __syncthreads();
#pragma unroll
        for (int nt = 0; nt < 8; ++nt) { f32x4 acc = {0.f, 0.f, 0.f, 0.f};
#pragma unroll
            for (int ks = 0; ks < 4; ++ks) if (ks <= kmax) { const bf16x8 af = *(const LAS bf16x8*)(lds + (unsigned)(16 * nt + fr) * 256u + ((unsigned)(((4 * ks) ^ (2 * nt)) << 4) ^ rdl)); acc = mfma16(af, wf[ks], acc); }
            u32x2 w; w.x = cvt_pk_bf16(bflo(u4[nt].x) * (acc[0] + bias), bfhi(u4[nt].x) * (acc[1] + bias)); w.y = cvt_pk_bf16(bflo(u4[nt].y) * (acc[2] + bias), bfhi(u4[nt].y) * (acc[3] + bias));
            *(u32x2*)(up + 16 * nt) = w; }
        __syncthreads();
    }
}

template <int W> __device__ __forceinline__ void pool_chunk(const bf16_t* PIN, bf16_t* POOLED, int row, int c8) {
    const int t = row & (T - 1), cnt = (t + 1) < W ? (t + 1) : W;
    u32x4 v[W];
#pragma unroll
    for (int i = 0; i < W; ++i) { const int ri = (i <= t) ? row - i : row; v[i] = *(const u32x4*)(PIN + (size_t)ri * 2048 + c8); }
    float sm[8] = {0.f, 0.f, 0.f, 0.f, 0.f, 0.f, 0.f, 0.f};
#pragma unroll
    for (int i = 0; i < W; ++i) { const float k = (i <= t) ? 1.f : 0.f;
        sm[0] += k * bflo(v[i].x); sm[1] += k * bfhi(v[i].x); sm[2] += k * bflo(v[i].y); sm[3] += k * bfhi(v[i].y); sm[4] += k * bflo(v[i].z); sm[5] += k * bfhi(v[i].z); sm[6] += k * bflo(v[i].w); sm[7] += k * bfhi(v[i].w); }
    const float fc = (float)cnt; const u32x4 cur = v[0];
    u32x4 w; w.x = cvt_pk_bf16(sm[0] / fc - bflo(cur.x), sm[1] / fc - bfhi(cur.x)); w.y = cvt_pk_bf16(sm[2] / fc - bflo(cur.y), sm[3] / fc - bfhi(cur.y));
    w.z = cvt_pk_bf16(sm[4] / fc - bflo(cur.z), sm[5] / fc - bfhi(cur.z)); w.w = cvt_pk_bf16(sm[6] / fc - bflo(cur.w), sm[7] / fc - bfhi(cur.w));
    *(u32x4*)(POOLED + (size_t)row * 2048 + c8) = w;
}

constexpr int N_PHASES = 19;
constexpr int I_INE1 = 64 * 80, I_INE2 = 64 * 32, I_OUTE = 64 * 64, I_G = 64 * 172, I_DN = 172 * 64, I_INO = 64 * 384, I_OUTO = 192 * 64, I_POOL = 8 * 8, I_C1 = 64 * 4, I_C2 = 4 * 2;
constexpr int NIT_A = I_INE1 + I_INE2 + 4 * I_POOL + 2 * I_C1 + 2 * I_C2;
constexpr int NIT_P0 = NIT_A + 4 * I_G + I_INO;
constexpr int NIT_T1 = NIT_P0 + I_DN + I_OUTE;
constexpr int NIT_T8 = NIT_T1 + I_OUTO;
constexpr int NITEMS = NIT_T8 + I_DN;
#ifndef PH_MASK
#define PH_MASK 0x7FFFF
#endif
typedef const __attribute__((address_space(4))) Args* KArgs;
__device__ __forceinline__ KArgs kargs() { unsigned long long v = (unsigned long long)__builtin_amdgcn_kernarg_segment_ptr(); asm volatile("" : "+s"(v)); return (KArgs)v; }
#define WSP(type, off) ((type*)(ws + (off)))

struct ConvJob { int cnt, in_idx; unsigned src_off; unsigned long long dst_off; int ldw, K, nblk, col0, drow0, mode, gain_idx, gain_off; };
__device__ const ConvJob CONV_JOBS[19] = {
    {I_INE1, 2, 0u, O_W_INE, IN_EVEN, 4096, 80, 0, 0, 0, -1, 0},
    {I_INE2, 2, 0u, O_W_INE, IN_EVEN, 4096, 32, 5168, 5120, 0, -1, 0},
    {I_POOL, 9, 0u, O_W_POOL, 512, 512, 8, 0, 0, 0, -1, 0},
    {I_POOL, 9, 1u * 512 * 512, O_W_POOL + 1ull * 512 * 512 * 2, 512, 512, 8, 0, 0, 0, -1, 0},
    {I_POOL, 9, 2u * 512 * 512, O_W_POOL + 2ull * 512 * 512 * 2, 512, 512, 8, 0, 0, 0, -1, 0},
    {I_POOL, 9, 3u * 512 * 512, O_W_POOL + 3ull * 512 * 512 * 2, 512, 512, 8, 0, 0, 0, -1, 0},
    {I_C1, 5, 0u, O_W_C1K, 256, 4096, 4, 0, 0, 2, -1, 0},
    {I_C1, 7, 0u, O_W_C1V, 256, 4096, 4, 0, 0, 2, -1, 0},
    {I_C2, 6, 0u, O_W_C2K, 128, 256, 2, 0, 0, 0, -1, 0},
    {I_C2, 8, 0u, O_W_C2V, 128, 256, 2, 0, 0, 0, -1, 0},
    {I_G, 20, 0u, O_W_GU0, FF, 4096, 172, 0, 0, 1, 19, 0},
    {I_G, 21, 0u, O_W_GU0, FF, 4096, 172, 0, 128, 1, 19, 0},
    {I_G, 20, (unsigned)(DM * FF), O_W_GU1, FF, 4096, 172, 0, 0, 1, 19, DM},
    {I_G, 21, (unsigned)(DM * FF), O_W_GU1, FF, 4096, 172, 0, 128, 1, 19, DM},
    {I_INO, 13, 0u, O_W_INO, 2 * GW, 4096, 384, 0, 0, 0, 12, 0},
    {I_DN, 22, 0u, O_W_DN0, 4096, FF, 64, 0, 0, 0, -1, 0},
    {I_OUTE, 11, 0u, O_W_OUTE, 4096, 4096, 64, 0, 0, 0, -1, 0},
    {I_OUTO, 18, 0u, O_W_OUTO, 4096, GW, 64, 0, 0, 0, -1, 0},
    {I_DN, 22, (unsigned)(DM * FF), O_W_DN1, 4096, FF, 64, 0, 0, 0, -1, 0}};
#define CONV_DECODE(it_, osrc, odst, oldw, oK, k0, n0, drow, ogn) const float* osrc; bf16_t* odst; const float* ogn; int oldw, oK, k0, n0, drow; { \
            int r = (it_), j = 0; while (j < 18 && r >= CONV_JOBS[j].cnt) { r -= CONV_JOBS[j].cnt; ++j; } \
            const ConvJob jb = CONV_JOBS[j]; \
            const int kb = r / jb.nblk, nb = r - kb * jb.nblk, n0l = nb * 64; k0 = kb * 64; n0 = jb.col0 + n0l; \
            drow = jb.mode == 1 ? (256 * (n0l >> 7) + (n0l & 127) + jb.drow0) : (jb.drow0 + n0l); \
            osrc = ap->in[jb.in_idx] + jb.src_off; odst = (bf16_t*)(ws + jb.dst_off); oldw = jb.ldw; oK = jb.mode == 2 ? -jb.K : jb.K; ogn = jb.gain_idx >= 0 ? ap->in[jb.gain_idx] + jb.gain_off + k0 : nullptr; }
#define CONV_RANGE(lo_, hi_, first_, stride_) do { LAS float* scr = (LAS float*)(lds + RING_OFF + wave * 16640); \
        for (int it = (lo_) + (first_); it < (hi_); it += 2 * (stride_)) { f32x4 va[16], vb[16]; const bool hasb = it + (stride_) < (hi_); \
            CONV_DECODE(it, srcA, dstA, ldwA, KA, k0A, n0A, drowA, gnA) tr_load(srcA, ldwA, k0A, n0A, lane, va); \
            CONV_DECODE(hasb ? it + (stride_) : it, srcB, dstB, ldwB, KB, k0B, n0B, drowB, gnB) tr_load(srcB, ldwB, k0B, n0B, lane, vb);   \
            tr_finish(va, k0A, dstA, (size_t)drowA, KA, scr, lane, gnA); if (hasb) tr_finish(vb, k0B, dstB, (size_t)drowB, KB, scr, lane, gnB); } } while (0)
#define CONV_TAIL(nunits_, lo_, hi_) do { const int rounds_ = ((nunits_) + G - 1) / G, first_idle_ = (nunits_) - (rounds_ - 1) * G; \
        if (first_idle_ >= G) CONV_RANGE(lo_, hi_, bx * NWAVES + wave, G * NWAVES);   \
        else if (bx >= first_idle_) CONV_RANGE(lo_, hi_, (bx - first_idle_) * NWAVES + wave, (G - first_idle_) * NWAVES); } while (0)

__device__ __forceinline__ bool ph_in(int k) { KArgs ap = kargs(); return ap->ph_lo <= k && k < ap->ph_hi; }
__global__ void __launch_bounds__(NWAVES * 64, 2) fwd(Args args) {
    extern __shared__ __attribute__((aligned(16))) unsigned char lds_raw[];
    LAS unsigned char* lds = (LAS unsigned char*)lds_raw;
    const int wave = __builtin_amdgcn_readfirstlane((int)threadIdx.x >> 6);
    const int bx = blockIdx.x;
    { const int tid0 = threadIdx.x; for (int u = tid0; u < (LDS_BYTES - LDSCTL_OFF) / 4; u += NWAVES * 64) ((LAS unsigned*)(lds + LDSCTL_OFF))[u] = 0u; }
    __syncthreads();
#if MK_ONE_LAUNCH
    { KArgs ap = kargs(); (void)xcd_barrier_post((unsigned*)(ap->ws + O_CTL) + CW_BAR, (volatile LAS unsigned*)(lds + MISC_OFF) + 8, wave == 0 && lane_id() == 0); }
#define GRID_BAR() do { XcdBarrier bar_; bar_.bar = (unsigned*)(ws + O_CTL) + CW_BAR; bar_.x = xb_xcc_id(); bar_.st = (volatile LAS unsigned*)(lds + MISC_OFF) + 8; xcd_barrier(bar_, wave == 0 && lane_id() == 0); } while (0)
#else
#define GRID_BAR() do { } while (0)
#endif
#define IN(k) ((((PH_MASK) >> (k)) & 1) && ph_in(k))
#define BOTH(k) (IN(k) && IN((k) + 1))
#define PH_ARGS KArgs ap = kargs(); unsigned char* ws = ap->ws; (void)ws; const int G = ap->G; const int lane = lane_id(); const int tid = wave * 64 + lane; (void)tid; \
    const int vcu = (G % 8 == 0) ? (bx % 8) * (G / 8) + bx / 8 : bx; (void)vcu; const int gw = vcu * NWAVES + wave, NGW = G * NWAVES; (void)gw; (void)NGW; \
    const int gtid = vcu * (NWAVES * 64) + tid, NT_ALL = G * NWAVES * 64; (void)gtid; (void)NT_ALL

    if (IN(0)) {
        PH_ARGS;
        CONV_RANGE(0, NIT_A, gw, NGW);
        { const float* w_in = ap->in[2]; bf16_t* W_INE = WSP(bf16_t, O_W_INE);
          for (int idx = gtid; idx < 256 * 4096; idx += NT_ALL) { const int rr = idx >> 12, k = idx & 4095;
            const float v = rr < 48 ? w_in[(size_t)k * IN_EVEN + 5120 + rr] : 0.f;
            W_INE[(size_t)(7168 + rr) * 4096 + k] = (bf16_t)(cvt_pk_bf16(v, 0.f) & 0xffffu); } }
        { float* CB = WSP(float, O_CTL + O_CBIAS);
          for (int o = gw; o < 512; o += NGW) { const int which = o >> 8, h = o & 255; const float* pe = which ? ap->in[4] : ap->in[3]; const float* w1 = which ? ap->in[7] : ap->in[5]; float a = 0.f;
            for (int k = lane; k < 4096; k += 64) a += pe[k] * w1[(size_t)k * 256 + h];
            a = wave_sum(a); if (lane == 0) CB[o] = a; } }
        { const float* gws = ap->in[16]; bf16_t* WM = WSP(bf16_t, O_WM);
          for (int idx = gtid; idx < 16 * 128 * 128; idx += NT_ALL) { const int t = (idx >> 7) & 127, s = idx & 127;
            const float v = s <= t ? gws[idx] : 0.f; WM[idx] = (bf16_t)(cvt_pk_bf16(v, 0.f) & 0xffffu); } }
        { float* ROPE = WSP(float, O_ROPE);
          for (int idx = gtid; idx < 4096 * 16; idx += NT_ALL) { const int t = idx >> 4, i = idx & 15;
            const float ang = (float)t * ROPE_INV_FREQ[i];
            const double xr = (double)ang; const double nrev = __builtin_rint(xr * 0.15915494309189535); const double rr = __builtin_fma(-nrev, 6.283185307179586, xr) - nrev * 2.4492935982947064e-16;
            const double r2 = rr * rr; double ts = 1.0, tc = 1.0, sn = 1.0, cs = 1.0;
#pragma unroll
            for (int k = 1; k <= 15; ++k) { ts *= -r2 / (double)((2 * k) * (2 * k + 1)); sn += ts; tc *= -r2 / (double)((2 * k - 1) * (2 * k)); cs += tc; }
            ROPE[idx] = (float)cs; ROPE[65536 + idx] = (float)(sn * rr); } }
        { const float* x = ap->in[0]; const float* gn = ap->in[1]; bf16_t* HN = WSP(bf16_t, O_HN);
          for (int m = gw; m < M; m += NGW) rms_row_bf16(x + (size_t)m * DM, gn, HN + (size_t)m * DM, lane); }
        if (BOTH(0)) GRID_BAR();
    }

    if (IN(1)) {
        PH_ARGS;
        pg8::Gemm g{WSP(bf16_t, O_HN), WSP(bf16_t, O_W_INE), M, IN_EVEN_P, DM, DM, DM}; pg8::StaticOrder S; S.init(M, IN_EVEN_P, G, bx);
        pg8::EpiInEven E{WSP(bf16_t, O_QH), WSP(bf16_t, O_KV), WSP(bf16_t, O_PIN), WSP(float, O_GATES), WSP(float, O_ROPE)};
        pg8::gemm_phase<pg8::EpiInEven, pg8::StaticOrder, true, true>(lds + RING_OFF, g, S, E, wave, lane);
        CONV_TAIL((M / 256) * (IN_EVEN_P / 256), NIT_P0, NIT_T1);
        if (BOTH(1)) GRID_BAR();
    }
    if (IN(2)) {
        PH_ARGS;
        for (int id = vcu; id < 256; id += G) { const int which = id >> 7, rt = id & 127;
            compress_item(lds + RING_OFF, which, rt, WSP(bf16_t, O_KV) + (size_t)which * KVSZ, WSP(float, O_CTL + O_CBIAS) + 256 * which, which ? WSP(bf16_t, O_W_C1V) : WSP(bf16_t, O_W_C1K),
                          which ? WSP(bf16_t, O_W_C2V) : WSP(bf16_t, O_W_C2K), WSP(bf16_t, O_KCMP), WSP(bf16_t, O_VCMPT), wave, lane); }
        const bf16_t* PIN = WSP(bf16_t, O_PIN); bf16_t* POOLED = WSP(bf16_t, O_POOLED);
        for (int idx = gtid; idx < M * 256; idx += NT_ALL) { const int row = idx >> 8, c8 = (idx & 255) * 8, grp = __builtin_amdgcn_readfirstlane(c8 >> 9);
            if (grp == 0) pool_chunk<2>(PIN, POOLED, row, c8); else if (grp == 1) pool_chunk<4>(PIN, POOLED, row, c8); else if (grp == 2) pool_chunk<8>(PIN, POOLED, row, c8); else pool_chunk<16>(PIN, POOLED, row, c8); }
        if (BOTH(2)) GRID_BAR();
    }
    if (IN(3)) {
        PH_ARGS;
        { const int grp = bx >> 6, loc = bx & 63;
          pg8::Gemm g{WSP(bf16_t, O_POOLED) + 512 * grp, WSP(bf16_t, O_W_POOL) + (size_t)grp * 512 * 512, M, 512, 512, 2048, 512}; pg8::StaticOrder S; S.init(M, 512, 64, loc);
          pg8::EpiScaleBf16 E{WSP(bf16_t, O_CAT) + 2048 + 512 * grp, DM, ap->in[10] + 512 * grp};
          if (grp < 4) pg8::gemm_phase<pg8::EpiScaleBf16, pg8::StaticOrder, false, true>(lds + RING_OFF, g, S, E, wave, lane); }
        __syncthreads();
        for (int id = vcu; id < 1024; id += G) cmp_attn_item(lds + RING_OFF, 2 * (id >> 8) + ((id >> 7) & 1), (id + 32 * (id >> 8)) & 127, WSP(bf16_t, O_QH), WSP(bf16_t, O_KCMP), WSP(bf16_t, O_VCMPT), WSP(float, O_GATES),
                                                             WSP(float, O_OACC), WSP(unsigned long long, O_SEL), wave, lane);
        if (BOTH(3)) GRID_BAR();
    }
    if (IN(4)) {
        PH_ARGS;
        const bool conv_first = ((bx >> 3) & 1) != 0;
        if (conv_first) { CONV_RANGE(NIT_A, NIT_P0, bx * NWAVES + wave, G * NWAVES); VM_WAIT(); __syncthreads(); }
        const swa::Ctx X{WSP(float, O_OACC), WSP(bf16_t, O_CAT), WSP(float, O_GATES), WSP(unsigned long long, O_SEL)};
        swa::swa_phase<1, false>((char*)lds_raw + RING_OFF, WSP(bf16_t, O_QH), WSP(bf16_t, O_KV) + 2 * KVSZ, WSP(bf16_t, O_KV) + 3 * KVSZ, X, 1 << 28, 1 << 28, bx, G, wave, lane);
        if (!conv_first) { __syncthreads(); CONV_RANGE(NIT_A, NIT_P0, bx * NWAVES + wave, G * NWAVES); }
        VM_WAIT(); __syncthreads();
        swa::swa_phase<0, true>((char*)lds_raw + RING_OFF, WSP(bf16_t, O_QH), WSP(bf16_t, O_KV) + 4 * KVSZ, WSP(bf16_t, O_KV) + 5 * KVSZ, X, 512, 1 << 28, bx, G, wave, lane);
        if (BOTH(4)) GRID_BAR();
    }
    if (IN(6)) {
        PH_ARGS;
        pg8::Gemm g{WSP(bf16_t, O_CAT), WSP(bf16_t, O_W_OUTE), M, DM, DM, DM, DM}; pg8::StaticOrder S; S.init(M, DM, G, bx);
        pg8::EpiResid<true> E{ap->in[0], WSP(bf16_t, O_XB), DM, WSP(float, O_SSQP)};
        pg8::gemm_phase<pg8::EpiResid<true>, pg8::StaticOrder, true, true>(lds + RING_OFF, g, S, E, wave, lane);
        if (BOTH(6)) GRID_BAR();
    }
    for (int l = 0; l < 2; ++l) {
        if (l == 1) {
            if (IN(11)) {
                PH_ARGS;
                pg8::Gemm g{WSP(bf16_t, O_XB1), WSP(bf16_t, O_W_INO), M, 2 * GW, DM, DM, DM}; pg8::StaticOrder S; S.init(M, 2 * GW, G, bx);
                pg8::Unit u0; LAS float* tab = (LAS float*)(lds + ROWSC_OFF); int pm0 = -1;
                if (S.next(0, u0)) { pm0 = u0.pm; pg8::build_row_scale(tab, WSP(float, O_SSQP), pm0, tid); }
                LDS_WAIT(); __syncthreads();
                pg8::EpiGeluSplit E{WSP(bf16_t, O_U), WSP(bf16_t, O_V), GW, GW, WSP(float, O_VPART), pg8::RowScale{tab, pm0}};
                pg8::gemm_phase<pg8::EpiGeluSplit, pg8::StaticOrder, true, true>(lds + RING_OFF, g, S, E, wave, lane);
                if (BOTH(11)) GRID_BAR();
            }
            if (IN(12)) { PH_ARGS; const float* part = WSP(float, O_VPART); float* SUMS = WSP(float, O_CTL + O_VSUMS);
                for (int m = gw; m < M; m += NGW) { const f32x2* pr = (const f32x2*)(part + (size_t)m * 384) + lane; const f32x2 a = pr[0], b = pr[64], c = pr[128];
                    const float s1 = wave_sum((a[0] + b[0]) + c[0]), s2 = wave_sum((a[1] + b[1]) + c[1]); if (lane == 0) *(f32x2*)(SUMS + (size_t)m * 2) = (f32x2){s1, s2}; }
                if (BOTH(12)) GRID_BAR(); }
            if (IN(13)) {
                PH_ARGS;
                for (int task = vcu; task < 96 * 8; task += G) { const int pnl = 3 * (task & 31) + ((task >> 5) % 3), bq = (task >> 5) / 3;
                    gate_task(lds + RING_OFF, pnl / 6, pnl % 6, 8 * bq, 8, WSP(bf16_t, O_V), WSP(bf16_t, O_U), WSP(float, O_CTL + O_VSUMS), ap->in[14], ap->in[15], WSP(bf16_t, O_WM), ap->in[17], tid, wave, lane); }
                if (BOTH(13)) GRID_BAR();
            }
            if (IN(14)) {
                PH_ARGS;
                pg8::Gemm g{WSP(bf16_t, O_U), WSP(bf16_t, O_W_OUTO), M, DM, GW, GW, GW}; pg8::StaticOrder S; S.init(M, DM, G, bx);
                pg8::EpiResid<false> E{WSP(bf16_t, O_XB1), WSP(bf16_t, O_XB), DM, WSP(float, O_SSQP)};
                pg8::gemm_phase<pg8::EpiResid<false>, pg8::StaticOrder, true, true>(lds + RING_OFF, g, S, E, wave, lane);
                if (BOTH(14)) GRID_BAR();
            }
        }
        const int pb = 7 + 8 * l;
        if (IN(pb + 1)) {
            PH_ARGS;
            pg8::Gemm g{WSP(bf16_t, O_XB), (const bf16_t*)(ws + (l ? O_W_GU1 : O_W_GU0)), M, 2 * FF, DM, DM, DM}; pg8::StaticOrder S; S.init(M, 2 * FF, G, bx);
            pg8::Unit u0; LAS float* tab = (LAS float*)(lds + ROWSC_OFF); int pm0 = -1;
            if (S.next(0, u0)) { pm0 = u0.pm; pg8::build_row_scale(tab, WSP(float, O_SSQP), pm0, tid); }
            LDS_WAIT(); __syncthreads();
            pg8::EpiSwiGLU E{WSP(bf16_t, O_H), FF, pg8::RowScale{tab, pm0}};
            pg8::gemm_phase<pg8::EpiSwiGLU, pg8::StaticOrder, true, true>(lds + RING_OFF, g, S, E, wave, lane);
            if (l == 0) CONV_TAIL((M / 256) * (2 * FF / 256), NIT_T1, NIT_T8); else CONV_TAIL((M / 256) * (2 * FF / 256), NIT_T8, NITEMS);
            if (BOTH(pb + 1)) GRID_BAR();
        }
        if (IN(pb + 2)) {
            PH_ARGS;
            pg8::Gemm g{WSP(bf16_t, O_H), (const bf16_t*)(ws + (l ? O_W_DN1 : O_W_DN0)), M, DM, FF, FF, FF}; pg8::StaticOrder S; S.init(M, DM, G, bx);
            pg8::EpiResid<false> E{WSP(bf16_t, O_XB), WSP(bf16_t, O_XB1), DM, WSP(float, O_SSQP)};
            pg8::gemm_phase<pg8::EpiResid<false>, pg8::StaticOrder, true, true>(lds + RING_OFF, g, S, E, wave, lane);
            if (BOTH(pb + 2)) GRID_BAR();
        }
    }
    if (IN(18)) { PH_ARGS; const bf16_t* XB = WSP(bf16_t, O_XB1); const float* gn = ap->in[23]; float* out = ap->out; const float* pp = WSP(float, O_SSQP);
        for (int m = gw; m < M; m += NGW) { const float r = 1.0f / sqrtf(wave_sum(pp[(size_t)m * 64 + lane]) * (1.0f / DM) + EPS); const u32x2* xr = (const u32x2*)(XB + (size_t)m * DM) + lane; const f32x4* gr = (const f32x4*)gn + lane; f32x4* o = (f32x4*)(out + (size_t)m * DM) + lane;
#pragma unroll 8
            for (int j = 0; j < 16; ++j) { const u32x2 w = xr[64 * j]; o[64 * j] = (f32x4){bflo(w.x), bfhi(w.x), bflo(w.y), bfhi(w.y)} * r * gr[64 * j]; } } }
#undef IN
#undef BOTH
}

extern "C" void kernel_launch(void* const* d_in, const int* in_sizes, int n_in, void* d_out, int out_size, void* d_ws, size_t ws_size, hipStream_t stream) {
    static int grid = 0;
    if (grid == 0) {
        if (n_in != 24 || in_sizes[0] != M * DM || out_size != M * DM || ws_size < WS_END) {
            fprintf(stderr, "kernel_launch: built for 24 inputs, x/out of %d floats, >= %zu bytes of workspace; got n_in %d, in0 %d, out %d, ws %zu; nothing launched\n", M * DM, (size_t)WS_END, n_in, n_in > 0 ? in_sizes[0] : -1, out_size, ws_size);
            grid = -1; return; }
        int dev = 0, cus = 0;
        if (hipGetDevice(&dev) != hipSuccess || hipDeviceGetAttribute(&cus, hipDeviceAttributeMultiprocessorCount, dev) != hipSuccess) { fprintf(stderr, "kernel_launch: device query failed\n"); grid = -1; return; }
        if (hipFuncSetAttribute((const void*)fwd, hipFuncAttributeMaxDynamicSharedMemorySize, LDS_BYTES) != hipSuccess) { fprintf(stderr, "kernel_launch: hipFuncSetAttribute failed\n"); grid = -1; return; }
        int per_cu = 0;
        if (hipOccupancyMaxActiveBlocksPerMultiprocessor(&per_cu, (const void*)fwd, NWAVES * 64, LDS_BYTES) != hipSuccess || per_cu < 1) fprintf(stderr, "kernel_launch: note: occupancy query reports %d\n", per_cu);
        (void)hipGetLastError();
        if (cus != 256) { fprintf(stderr, "kernel_launch: built for a 256-CU device, found %d CUs; nothing launched\n", cus); grid = -1; return; }
        grid = cus;
    }
    if (grid < 0) return;
    (void)hipMemsetAsync((char*)d_ws + O_CTL, 0, CTL_ZERO_BYTES, stream);
    Args a{};
    for (int i = 0; i < 24; ++i) a.in[i] = (const float*)d_in[i];
    a.out = (float*)d_out; a.ws = (unsigned char*)d_ws; a.G = grid; a.pad = 0;
#if MK_ONE_LAUNCH
    a.ph_lo = 0; a.ph_hi = N_PHASES;
    hipLaunchKernelGGL(fwd, dim3(grid), dim3(NWAVES * 64), LDS_BYTES, stream, a);
#else
    for (int p = 0; p < N_PHASES; ++p) { a.ph_lo = p; a.ph_hi = p + 1; hipLaunchKernelGGL(fwd, dim3(grid), dim3(NWAVES * 64), LDS_BYTES, stream, a); }
#endif
}
```

```cpp
#include <hip/hip_runtime.h>
#include <cstdio>
#include <cstdint>

#ifndef MK_ONE_LAUNCH
#define MK_ONE_LAUNCH 1
#endif

#define LAS __attribute__((address_space(3)))
#define GAS __attribute__((address_space(1)))
typedef unsigned short bf16_t;
typedef short bf16x8 __attribute__((ext_vector_type(8)));
typedef short s16x4 __attribute__((ext_vector_type(4)));
typedef float f32x2 __attribute__((ext_vector_type(2)));
typedef float f32x4 __attribute__((ext_vector_type(4)));
typedef float f32x16 __attribute__((ext_vector_type(16)));
typedef unsigned u32x2 __attribute__((ext_vector_type(2)));
typedef unsigned u32x4 __attribute__((ext_vector_type(4)));

constexpr int NB = 2, T = 4096, DM = 4096, M = NB * T;
constexpr int NH = 16, NG = 4, HD = 128;
constexpr int IN_EVEN = 7216, IN_EVEN_P = 7424;
constexpr int FF = 11008, GW = 12288;
constexpr float EPS = 1e-6f;
constexpr size_t KVSZ = (size_t)NB * NG * T * HD;

constexpr size_t O_CTL = 0, CTL_ZERO_BYTES = 64u << 10;
constexpr size_t O_ROPE = 1u << 20;
constexpr size_t O_WM = O_ROPE + (512u << 10);
constexpr size_t O_STATS = O_WM + (512u << 10);
constexpr size_t O_KCMP = O_STATS + (64u << 10);
constexpr size_t O_VCMPT = O_KCMP + (512u << 10);
constexpr size_t O_SEL = O_VCMPT + (512u << 10);
constexpr size_t O_GATES = O_SEL + (256u << 10);
constexpr size_t O_W = 8u << 20;
constexpr size_t O_W_INE = O_W;
constexpr size_t O_W_OUTE = O_W_INE + (size_t)IN_EVEN_P * DM * 2;
constexpr size_t O_W_GU0 = O_W_OUTE + (size_t)DM * DM * 2;
constexpr size_t O_W_DN0 = O_W_GU0 + (size_t)2 * FF * DM * 2;
constexpr size_t O_W_GU1 = O_W_DN0 + (size_t)DM * FF * 2;
constexpr size_t O_W_DN1 = O_W_GU1 + (size_t)2 * FF * DM * 2;
constexpr size_t O_W_INO = O_W_DN1 + (size_t)DM * FF * 2;
constexpr size_t O_W_OUTO = O_W_INO + (size_t)2 * GW * DM * 2;
constexpr size_t O_W_POOL = O_W_OUTO + (size_t)DM * GW * 2;
constexpr size_t O_W_C1K = O_W_POOL + (size_t)4 * 512 * 512 * 2;
constexpr size_t O_W_C1V = O_W_C1K + (size_t)256 * 4096 * 2;
constexpr size_t O_W_C2K = O_W_C1V + (size_t)256 * 4096 * 2;
constexpr size_t O_W_C2V = O_W_C2K + (size_t)128 * 256 * 2;
constexpr size_t O_XB = O_W_C2V + (size_t)128 * 256 * 2;
constexpr size_t O_XB1 = O_XB + (size_t)M * DM * 2;
constexpr size_t O_HN = O_XB + (size_t)M * DM * 4;
constexpr size_t O_A = O_HN + (size_t)M * DM * 2;
constexpr size_t O_QH = O_A;
constexpr size_t O_KV = O_QH + (size_t)M * 2048 * 2;
constexpr size_t O_PIN = O_KV + 6 * KVSZ * 2;
constexpr size_t O_POOLED = O_PIN + (size_t)M * 2048 * 2;
constexpr size_t O_OACC = O_POOLED + (size_t)M * 2048 * 2;
constexpr size_t O_CAT = O_OACC + (size_t)M * 2048 * 4;
constexpr size_t O_A_END_EVEN = O_CAT + (size_t)M * DM * 2;
constexpr size_t O_H = O_A;
constexpr size_t O_U = O_A;
constexpr size_t O_V = O_U + (size_t)M * GW * 2;
constexpr size_t O_A_END_ODD = O_V + (size_t)M * GW * 2;
constexpr size_t O_VPART = O_A_END_ODD > O_A_END_EVEN ? O_A_END_ODD : O_A_END_EVEN;
constexpr size_t O_SSQP = O_VPART + (size_t)M * 192 * 2 * 4;
constexpr size_t WS_END = O_SSQP + (size_t)M * 64 * 4;
static_assert(O_GATES + (size_t)M * 48 * 4 <= O_W, "small buffers fit below the weights");
static_assert((O_W_OUTE % 256) == 0 && (O_W_GU0 % 256) == 0 && (O_W_DN0 % 256) == 0 && (O_W_INO % 256) == 0 && (O_XB % 256) == 0 && (O_A % 256) == 0 && (O_V % 256) == 0, "alignment");

constexpr int CW_TMO = 0, CW_BAR = 4096;
constexpr size_t O_CBIAS = 384u << 10;
constexpr size_t O_SSQ = 448u << 10;
constexpr size_t O_VSUMS = 256u << 10;

constexpr int RING_OFF = 0, RING_BYTES = 131072;
constexpr int LDS_BYTES = 147456;
constexpr int LDSCTL_OFF = LDS_BYTES - 1024, MISC_OFF = LDSCTL_OFF + 320;
constexpr int ROWSC_OFF = LDSCTL_OFF - 2048;
constexpr int NWAVES = 8;

typedef __bf16 bf16x2_t __attribute__((ext_vector_type(2)));
__device__ __forceinline__ unsigned cvt_pk_bf16(float lo, float hi) { f32x2 v = {lo, hi}; bf16x2_t b = __builtin_convertvector(v, bf16x2_t); return __builtin_bit_cast(unsigned, b); }
__device__ __forceinline__ float bf2f(unsigned short b) { return __uint_as_float(((unsigned)b) << 16); }
__device__ __forceinline__ float bflo(unsigned w) { return __uint_as_float(w << 16); }
__device__ __forceinline__ float bfhi(unsigned w) { return __uint_as_float(w & 0xffff0000u); }
__device__ __forceinline__ float sigmoidf_(float x) { return __builtin_amdgcn_rcpf(1.0f + __builtin_amdgcn_exp2f(-1.4426950408889634f * x)); }
__device__ __forceinline__ float gelu_tanh(float x) {
    const float y = 2.0f * 0.7978845608028654f * x * (1.0f + 0.044715f * x * x);
    return x * sigmoidf_(y);
}
__device__ __forceinline__ int lane_id() { unsigned z = 0u; asm volatile("" : "+s"(z)); return (int)__builtin_amdgcn_mbcnt_hi(~0u, __builtin_amdgcn_mbcnt_lo(~0u, z)); }
#define LDS_WAIT() asm volatile("s_waitcnt lgkmcnt(0)" ::: "memory")
#define VM_WAIT() asm volatile("s_waitcnt vmcnt(0)" ::: "memory")

namespace pg8 {
constexpr int BM = 256, BK = 64, HALF = 128, HTB = HALF * BK * 2, STAGE_BYTES = 8 * HTB, NXCD = 8, WGM = 8;
__host__ __device__ __forceinline__ int lds_byte(int r, int c) { const int st = (r >> 4) * 2 + (c >> 5), rr = r & 15, cc = c & 31, ob = rr * 64 + cc * 2; return st * 1024 + (ob ^ (((ob >> 9) & 1) << 5)); }
__host__ __device__ __forceinline__ void stage_rc(int b, int& R, int& C) { const int st = b / 1024, sb = b % 1024, swz = sb ^ (((sb >> 9) & 1) << 5); R = (st >> 1) * 16 + swz / 64; C = (st & 1) * 32 + (swz % 64) / 2; }
__host__ __device__ __forceinline__ int perm32(int rho) { const int n = rho >> 4, i = rho & 15; return 8 * (i >> 2) + 4 * n + (i & 3); }

struct Unit { int pm, pn; };
struct Gemm { const bf16_t* A; const bf16_t* Bt; int M, N, K, lda, ldb; };

struct StaticOrder {
    int nM, nN, nwg, G, c;
    __host__ __device__ __forceinline__ void init(int M_, int N_, int G_, int c_) { nM = M_ / BM; nN = N_ / BM; nwg = nM * nN; G = G_; c = c_; }
    __host__ __device__ __forceinline__ bool next(int i, Unit& u) const {
        const long L = (long)i * G + c; if (L >= nwg) return false;
        int wgid = (int)L; { const int q = nwg / NXCD, r = nwg % NXCD, xcd = wgid % NXCD, off = wgid / NXCD; wgid = (xcd < r ? xcd * (q + 1) : r * (q + 1) + (xcd - r) * q) + off; }
        const int nig = WGM * nN, gid = wgid / nig, fm = gid * WGM, gsz = (nM - fm) < WGM ? (nM - fm) : WGM;
        u.pm = fm + ((wgid % nig) % gsz); u.pn = (wgid % nig) / gsz; return true;
    }
    __device__ __forceinline__ void a_ready(const Unit&) const {}
    __device__ __forceinline__ void done(const Unit&) const {}
};


struct EpiInEven {
    static constexpr bool PERM = true, AFTER_DRAIN = false;
    bf16_t* QH; bf16_t* KV; bf16_t* PIN; float* GATES; const float* ROPE;
    __device__ __forceinline__ void operator()(const f32x4 (&acc)[2][2][4][2], const Unit& u, int wr, int wc, int fr, int fq) const {
        const int pn = u.pn;
#pragma unroll
        for (int ai = 0; ai < 2; ++ai)
#pragma unroll
            for (int m = 0; m < 4; ++m) {
                const int row = u.pm * BM + ai * HALF + wr * 64 + m * 16 + fr, b = row >> 12, t = row & 4095;
#pragma unroll
                for (int bj = 0; bj < 2; ++bj) {
                    f32x4 v0 = acc[ai][bj][m][0], v1 = acc[ai][bj][m][1];
                    if (pn < 20) {
                        const bool is_q = pn < 8; const int which = (pn - 8) >> 1;
                        if (wc == 0 && (is_q || !(which & 1))) {
                            f32x4 p0, p1;
#pragma unroll
                            for (int e = 0; e < 4; ++e) { p0[e] = __shfl_xor(v0[e], 32); p1[e] = __shfl_xor(v1[e], 32); }
                            const float* cp = ROPE + t * 16 + 8 * (fq & 1);
                            const f32x4 c0 = *(const f32x4*)cp, c1 = *(const f32x4*)(cp + 4), s0 = *(const f32x4*)(cp + 65536), s1 = *(const f32x4*)(cp + 65536 + 4);
                            if (fq < 2) { v0 = v0 * c0 - p0 * s0; v1 = v1 * c1 - p1 * s1; } else { v0 = v0 * c0 + p0 * s0; v1 = v1 * c1 + p1 * s1; }
                        }
                        const int d0 = wc * 32 + 8 * fq;
                        bf16_t* dst = is_q ? QH + ((size_t)((b * 16 + 2 * pn + bj) * 4096 + t)) * 128 + d0
                                           : KV + (size_t)which * KVSZ + ((size_t)((b * 4 + ((pn - 8) & 1) * 2 + bj) * 4096 + t)) * 128 + d0;
                        u32x4 w; w.x = cvt_pk_bf16(v0[0], v0[1]); w.y = cvt_pk_bf16(v0[2], v0[3]); w.z = cvt_pk_bf16(v1[0], v1[1]); w.w = cvt_pk_bf16(v1[2], v1[3]);
                        *(u32x4*)dst = w;
                    } else if (pn < 28) {
                        u32x4 w; w.x = cvt_pk_bf16(v0[0], v0[1]); w.y = cvt_pk_bf16(v0[2], v0[3]); w.z = cvt_pk_bf16(v1[0], v1[1]); w.w = cvt_pk_bf16(v1[2], v1[3]);
                        *(u32x4*)(PIN + (size_t)row * 2048 + (pn - 20) * 256 + bj * HALF + wc * 32 + 8 * fq) = w;
                    } else {
                        const int col0 = wc * 32 + 8 * fq;
                        if (bj == 0 && col0 <= 40) {
                            f32x4 g0, g1;
#pragma unroll
                            for (int e = 0; e < 4; ++e) { g0[e] = sigmoidf_(v0[e]); g1[e] = sigmoidf_(v1[e]); }
                            float* gp = GATES + (size_t)row * 48 + col0; *(f32x4*)gp = g0; *(f32x4*)(gp + 4) = g1;
                        }
                    }
                }
            }
    }
};
struct EpiScaleBf16 {
    static constexpr bool PERM = true, AFTER_DRAIN = false;
    bf16_t* O; int ldc; const float* scale;
    __device__ __forceinline__ void operator()(const f32x4 (&acc)[2][2][4][2], const Unit& u, int wr, int wc, int fr, int fq) const {
        const int row0 = u.pm * BM + wr * 64 + fr, col0 = u.pn * BM + wc * 32 + 8 * fq;
#pragma unroll
        for (int bj = 0; bj < 2; ++bj) {
            const f32x4 sc0 = *(const f32x4*)(scale + col0 + bj * HALF), sc1 = *(const f32x4*)(scale + col0 + bj * HALF + 4);
#pragma unroll
            for (int ai = 0; ai < 2; ++ai)
#pragma unroll
                for (int m = 0; m < 4; ++m) { const f32x4 v0 = acc[ai][bj][m][0] * sc0, v1 = acc[ai][bj][m][1] * sc1;
                    u32x4 w; w.x = cvt_pk_bf16(v0[0], v0[1]); w.y = cvt_pk_bf16(v0[2], v0[3]); w.z = cvt_pk_bf16(v1[0], v1[1]); w.w = cvt_pk_bf16(v1[2], v1[3]);
                    *(u32x4*)(O + (size_t)(row0 + ai * HALF + m * 16) * ldc + col0 + bj * HALF) = w; }
        }
    }
};
template <bool BASE_F32> struct EpiResid {
    static constexpr bool PERM = true, AFTER_DRAIN = false;
    const void* base; bf16_t* out; int ldc; float* ssqp;
    __device__ __forceinline__ void operator()(const f32x4 (&acc)[2][2][4][2], const Unit& u, int wr, int wc, int fr, int fq) const {
        const int row0 = u.pm * BM + wr * 64 + fr, col0 = u.pn * BM + wc * 32 + 8 * fq;
#pragma unroll
        for (int ai = 0; ai < 2; ++ai) { f32x4 b0[4][2], b1[4][2];
#pragma unroll
            for (int m = 0; m < 4; ++m) { const size_t off = (size_t)(row0 + ai * HALF + m * 16) * ldc + col0;
#pragma unroll
                for (int bj = 0; bj < 2; ++bj) {
                    if constexpr (BASE_F32) { const float* bp = (const float*)base + off + bj * HALF; b0[m][bj] = *(const f32x4*)bp; b1[m][bj] = *(const f32x4*)(bp + 4); }
                    else { const u32x4 w = *(const u32x4*)((const bf16_t*)base + off + bj * HALF); b0[m][bj] = (f32x4){bflo(w.x), bfhi(w.x), bflo(w.y), bfhi(w.y)}; b1[m][bj] = (f32x4){bflo(w.z), bfhi(w.z), bflo(w.w), bfhi(w.w)}; } } }
#pragma unroll
            for (int m = 0; m < 4; ++m) { const int row = row0 + ai * HALF + m * 16; const size_t off = (size_t)row * ldc + col0; float sq = 0.f;
#pragma unroll
                for (int bj = 0; bj < 2; ++bj) { const f32x4 o0 = b0[m][bj] + acc[ai][bj][m][0], o1 = b1[m][bj] + acc[ai][bj][m][1];
                    sq += ((o0[0] * o0[0] + o0[1] * o0[1]) + (o0[2] * o0[2] + o0[3] * o0[3])) + ((o1[0] * o1[0] + o1[1] * o1[1]) + (o1[2] * o1[2] + o1[3] * o1[3]));
                    u32x4 w; w.x = cvt_pk_bf16(o0[0], o0[1]); w.y = cvt_pk_bf16(o0[2], o0[3]); w.z = cvt_pk_bf16(o1[0], o1[1]); w.w = cvt_pk_bf16(o1[2], o1[3]);
                    *(u32x4*)(out + off + bj * HALF) = w; }
                sq += __shfl_xor(sq, 16); sq += __shfl_xor(sq, 32);
                if (fq == 0) ssqp[(size_t)row * 64 + u.pn * 4 + wc] = sq; }
            asm volatile("" ::: "memory"); }
    }
};
__device__ __forceinline__ float row_rstd_from_partials(const float* ssqp, int row) { const f32x4* p = (const f32x4*)(ssqp + (size_t)row * 64); float t = 0.f;
#pragma unroll
    for (int i = 0; i < 16; ++i) { const f32x4 v = p[i]; t += (v[0] + v[1]) + (v[2] + v[3]); }
    return 1.0f / sqrtf(t * (1.0f / DM) + EPS); }
struct RowScale { const LAS float* tab; int pm0;
    __device__ __forceinline__ float get(int pm, int r_in_panel) const { return pm == pm0 ? tab[r_in_panel] : __builtin_nanf(""); } };
__device__ __forceinline__ void build_row_scale(LAS float* tab, const float* ssqp, int pm, int tid) {
    const int r = tid >> 1, h = tid & 1; const f32x4* p = (const f32x4*)(ssqp + (size_t)(pm * 256 + r) * 64 + 32 * h); float t = 0.f;
#pragma unroll
    for (int i = 0; i < 8; ++i) { const f32x4 v = p[i]; t += (v[0] + v[1]) + (v[2] + v[3]); }
    const float o = __shfl_xor(t, 1); const float tot = h ? (o + t) : (t + o);
    if (h == 0) tab[r] = 1.0f / sqrtf(tot * (1.0f / DM) + EPS); }
struct EpiSwiGLU {
    static constexpr bool PERM = true, AFTER_DRAIN = false;
    bf16_t* H; int ldc; RowScale rsc;
    __device__ __forceinline__ void operator()(const f32x4 (&acc)[2][2][4][2], const Unit& u, int wr, int wc, int fr, int fq) const {
        const int row0 = u.pm * BM + wr * 64 + fr, col0 = u.pn * HALF + wc * 32 + 8 * fq;
        float rs[2][4];
#pragma unroll
        for (int ai = 0; ai < 2; ++ai)
#pragma unroll
            for (int m = 0; m < 4; ++m) rs[ai][m] = rsc.get(u.pm, ai * HALF + wr * 64 + m * 16 + fr);
#pragma unroll
        for (int ai = 0; ai < 2; ++ai)
#pragma unroll
            for (int m = 0; m < 4; ++m) { f32x4 h0, h1; const float r = rs[ai][m];
#pragma unroll
                for (int e = 0; e < 4; ++e) { const float g0 = acc[ai][0][m][0][e] * r, g1 = acc[ai][0][m][1][e] * r;
                    h0[e] = g0 * sigmoidf_(g0) * (acc[ai][1][m][0][e] * r); h1[e] = g1 * sigmoidf_(g1) * (acc[ai][1][m][1][e] * r); }
                u32x4 w; w.x = cvt_pk_bf16(h0[0], h0[1]); w.y = cvt_pk_bf16(h0[2], h0[3]); w.z = cvt_pk_bf16(h1[0], h1[1]); w.w = cvt_pk_bf16(h1[2], h1[3]);
                *(u32x4*)(H + (size_t)(row0 + ai * HALF + m * 16) * ldc + col0) = w; }
    }
};
struct EpiGeluSplit {
    static constexpr bool PERM = true, AFTER_DRAIN = false;
    bf16_t* O0; bf16_t* O1; int ldc; int split; float* part; RowScale rsc;
    __device__ __forceinline__ void operator()(const f32x4 (&acc)[2][2][4][2], const Unit& u, int wr, int wc, int fr, int fq) const {
        const int row0 = u.pm * BM + wr * 64 + fr; int colt = u.pn * BM; bf16_t* base = O0;
        const bool is_v = colt >= split;
        if (is_v) { base = O1; colt -= split; }
        const int col0 = colt + wc * 32 + 8 * fq;
#pragma unroll
        for (int ai = 0; ai < 2; ++ai)
#pragma unroll
            for (int m = 0; m < 4; ++m) { float s1 = 0.f, s2 = 0.f; const float r = rsc.get(u.pm, ai * HALF + wr * 64 + m * 16 + fr);
#pragma unroll
                for (int bj = 0; bj < 2; ++bj) { f32x4 v0, v1;
#pragma unroll
                    for (int e = 0; e < 4; ++e) { v0[e] = gelu_tanh(acc[ai][bj][m][0][e] * r); v1[e] = gelu_tanh(acc[ai][bj][m][1][e] * r); }
                    u32x4 w; w.x = cvt_pk_bf16(v0[0], v0[1]); w.y = cvt_pk_bf16(v0[2], v0[3]); w.z = cvt_pk_bf16(v1[0], v1[1]); w.w = cvt_pk_bf16(v1[2], v1[3]);
                    *(u32x4*)(base + (size_t)(row0 + ai * HALF + m * 16) * ldc + col0 + bj * HALF) = w;
                    if (is_v) {
                        const float r0 = bflo(w.x), r1 = bfhi(w.x), r2 = bflo(w.y), r3 = bfhi(w.y), r4 = bflo(w.z), r5 = bfhi(w.z), r6 = bflo(w.w), r7 = bfhi(w.w);
                        s1 += ((r0 + r1) + (r2 + r3)) + ((r4 + r5) + (r6 + r7)); s2 += ((r0 * r0 + r1 * r1) + (r2 * r2 + r3 * r3)) + ((r4 * r4 + r5 * r5) + (r6 * r6 + r7 * r7)); } }
                if (is_v) {
                    s1 += __shfl_xor(s1, 16); s1 += __shfl_xor(s1, 32); s2 += __shfl_xor(s2, 16); s2 += __shfl_xor(s2, 32);
                    if (fq == 0) { float* sp = part + ((size_t)(row0 + ai * HALF + m * 16) * 192 + (size_t)(u.pn - split / BM) * 4 + wc) * 2; *(f32x2*)sp = (f32x2){s1, s2}; } } }
    }
};

template <class Epi, class Sched, bool ALIGN_EPI = false, bool SP2 = false>
__device__ __forceinline__ void gemm_phase(LAS unsigned char* lds, const Gemm g, const Sched& S, const Epi& E, int wid, int lane) {
    const int tid = wid * 64 + lane, wr = wid >> 2, wc = wid & 3, fr = lane & 15, fq = lane >> 4;
    const int K = g.K, nt = K / BK;
    unsigned voffA[2], voffB[2];
#pragma unroll
    for (int i = 0; i < 2; ++i) { int R, C; stage_rc(tid * 16 + i * 8192, R, C); const int Rb = Epi::PERM ? ((R & ~31) + perm32(R & 31)) : R;
        voffA[i] = (unsigned)(R * g.lda + C) * 2u; voffB[i] = (unsigned)(Rb * g.ldb + C) * 2u; }
    const size_t kstep = (size_t)(BK * 2);
    const size_t hsA = (size_t)HALF * g.lda * 2, hsB = (size_t)HALF * g.ldb * 2;
    const size_t tsA = 2 * hsA, tsB = 2 * hsB;
    const unsigned ldsw = (unsigned)wid * 1024u;
    const int aoff = lds_byte(wr * 64 + fr, fq * 8), boff = lds_byte(wc * 32 + fr, fq * 8);
#define PG8_SA(b, h) (((b) * 2 + (h)) * HTB)
#define PG8_SB(b, h) ((4 + (b) * 2 + (h)) * HTB)
#define PG8_STAGE(bufoff, gbase, voff) do { _Pragma("unroll") for (int _i = 0; _i < 2; ++_i) \
        __builtin_amdgcn_global_load_lds((const unsigned*)((const char*)(gbase) + (voff)[_i]), (LAS unsigned*)(lds + (bufoff) + ldsw + _i * 8192), 16, 0, 0); } while (0)
#define PG8_LDA(dst, b, h) do { _Pragma("unroll") for (int m = 0; m < 4; ++m) _Pragma("unroll") for (int k = 0; k < 2; ++k) dst[m][k] = *(const LAS bf16x8*)(lds + PG8_SA(b, h) + aoff + m * 2048 + k * 1024); } while (0)
#define PG8_LDB(dst, b, h) do { _Pragma("unroll") for (int n = 0; n < 2; ++n) _Pragma("unroll") for (int k = 0; k < 2; ++k) dst[n][k] = *(const LAS bf16x8*)(lds + PG8_SB(b, h) + boff + n * 2048 + k * 1024); } while (0)
#define PG8_MMA(ai, bj, At, Bt) do { __builtin_amdgcn_s_setprio(1); _Pragma("unroll") for (int m = 0; m < 4; ++m) _Pragma("unroll") for (int n = 0; n < 2; ++n) _Pragma("unroll") for (int k = 0; k < 2; ++k) \
        acc[ai][bj][m][n] = __builtin_amdgcn_mfma_f32_16x16x32_bf16(Bt[n][k], At[m][k], acc[ai][bj][m][n], 0, 0, 0); __builtin_amdgcn_s_setprio(0); } while (0)
#define PG8_WAIT_V(n) asm volatile("s_waitcnt vmcnt(" #n ")" ::: "memory")
#define PG8_WAIT_L(n) asm volatile("s_waitcnt lgkmcnt(" #n ")" ::: "memory")
#define PG8_BAR __builtin_amdgcn_s_barrier()
#define PG8_SCHED __builtin_amdgcn_sched_barrier(0)
    Unit cur, nxt; int ui = 0;
    if (!S.next(0, cur)) return;
    f32x4 acc[2][2][4][2];
#pragma unroll
    for (int a = 0; a < 2; ++a)
#pragma unroll
        for (int b = 0; b < 2; ++b)
#pragma unroll
            for (int m = 0; m < 4; ++m)
#pragma unroll
                for (int n = 0; n < 2; ++n) acc[a][b][m][n] = (f32x4){0.f, 0.f, 0.f, 0.f};
    bf16x8 At[4][2], B0[2][2], B1[2][2];
    const char* cA = (const char*)g.A + (size_t)cur.pm * tsA; const char* cB = (const char*)g.Bt + (size_t)cur.pn * tsB;
    S.a_ready(cur);
    if constexpr (SP2) {
        PG8_STAGE(PG8_SB(0, 0), cB, voffB); PG8_STAGE(PG8_SB(0, 1), cB + hsB, voffB); PG8_STAGE(PG8_SA(0, 0), cA, voffA); PG8_STAGE(PG8_SA(0, 1), cA + hsA, voffA);
        if (wr == 1) PG8_BAR;
        PG8_WAIT_V(2); PG8_BAR;
        PG8_STAGE(PG8_SB(1, 0), cB + kstep, voffB); PG8_STAGE(PG8_SA(1, 0), cA + kstep, voffA); PG8_STAGE(PG8_SB(1, 1), cB + hsB + kstep, voffB);
        PG8_WAIT_V(6); PG8_BAR;
    } else {
        PG8_STAGE(PG8_SB(0, 0), cB, voffB); PG8_STAGE(PG8_SA(0, 0), cA, voffA); PG8_STAGE(PG8_SB(0, 1), cB + hsB, voffB); PG8_STAGE(PG8_SA(0, 1), cA + hsA, voffA);
        if (wr == 1) PG8_BAR;
        PG8_WAIT_V(4); PG8_BAR;
        PG8_STAGE(PG8_SB(1, 0), cB + kstep, voffB); PG8_STAGE(PG8_SA(1, 0), cA + kstep, voffA); PG8_STAGE(PG8_SB(1, 1), cB + hsB + kstep, voffB);
        PG8_WAIT_V(6); PG8_BAR;
    }
    for (;;) {
        const bool has_next = S.next(ui + 1, nxt);
        const char* nA = has_next ? (const char*)g.A + (size_t)nxt.pm * tsA : cA; const char* nB = has_next ? (const char*)g.Bt + (size_t)nxt.pn * tsB : cB;
        for (int t = 0; t < nt; t += 2) {
            const bool last = (t == nt - 2);
            const char* a1 = cA + (size_t)(t + 1) * kstep;
            const char* a2 = last ? nA : cA + (size_t)(t + 2) * kstep; const char* b2 = last ? nB : cB + (size_t)(t + 2) * kstep;
            const char* a3 = a2 + kstep; const char* b3 = b2 + kstep;
            if (last && has_next) S.a_ready(nxt);
            if constexpr (SP2) {
            PG8_LDB(B0, 0, 0); PG8_LDB(B1, 0, 1); PG8_SCHED; PG8_LDA(At, 0, 0); PG8_STAGE(PG8_SA(1, 1), a1 + hsA, voffA);
            PG8_WAIT_V(8); PG8_WAIT_L(0); PG8_BAR; PG8_MMA(0, 0, At, B0); PG8_MMA(0, 1, At, B1); PG8_BAR; PG8_SCHED;
            PG8_LDA(At, 0, 1); PG8_STAGE(PG8_SB(0, 0), b2, voffB); PG8_STAGE(PG8_SB(0, 1), b2 + hsB, voffB); PG8_STAGE(PG8_SA(0, 0), a2, voffA);
            PG8_WAIT_V(8); PG8_WAIT_L(0); PG8_BAR; PG8_MMA(1, 0, At, B0); PG8_MMA(1, 1, At, B1); PG8_BAR; PG8_SCHED;
            PG8_LDB(B0, 1, 0); PG8_LDB(B1, 1, 1); PG8_SCHED; PG8_LDA(At, 1, 0); PG8_STAGE(PG8_SA(0, 1), a2 + hsA, voffA);
            PG8_WAIT_V(8); PG8_WAIT_L(0); PG8_BAR; PG8_MMA(0, 0, At, B0); PG8_MMA(0, 1, At, B1); PG8_BAR; PG8_SCHED;
            PG8_LDA(At, 1, 1); PG8_STAGE(PG8_SB(1, 0), b3, voffB); PG8_STAGE(PG8_SB(1, 1), b3 + hsB, voffB); PG8_STAGE(PG8_SA(1, 0), a3, voffA);
            PG8_WAIT_V(8); PG8_WAIT_L(0); PG8_BAR; PG8_MMA(1, 0, At, B0); PG8_MMA(1, 1, At, B1); PG8_BAR; PG8_SCHED;
            } else {
            PG8_LDB(B0, 0, 0); PG8_SCHED; PG8_LDA(At, 0, 0); PG8_STAGE(PG8_SA(1, 1), a1 + hsA, voffA);
            PG8_WAIT_L(8); PG8_BAR; PG8_WAIT_L(0); PG8_MMA(0, 0, At, B0); PG8_BAR; PG8_SCHED;
            PG8_LDB(B1, 0, 1); PG8_STAGE(PG8_SB(0, 0), b2, voffB);
            PG8_BAR; PG8_WAIT_L(0); PG8_MMA(0, 1, At, B1); PG8_BAR;
            PG8_LDA(At, 0, 1); PG8_STAGE(PG8_SA(0, 0), a2, voffA);
            PG8_BAR; PG8_WAIT_L(0); PG8_MMA(1, 0, At, B0); PG8_BAR; PG8_SCHED;
            PG8_STAGE(PG8_SB(0, 1), b2 + hsB, voffB);
            PG8_WAIT_V(6); PG8_BAR; PG8_MMA(1, 1, At, B1); PG8_BAR;
            PG8_LDB(B0, 1, 0); PG8_SCHED; PG8_LDA(At, 1, 0); PG8_STAGE(PG8_SA(0, 1), a2 + hsA, voffA);
            PG8_WAIT_L(8); PG8_BAR; PG8_WAIT_L(0); PG8_MMA(0, 0, At, B0); PG8_BAR; PG8_SCHED;
            PG8_LDB(B1, 1, 1); PG8_STAGE(PG8_SB(1, 0), b3, voffB);
            PG8_BAR; PG8_WAIT_L(0); PG8_MMA(0, 1, At, B1); PG8_BAR;
            PG8_LDA(At, 1, 1); PG8_STAGE(PG8_SA(1, 0), a3, voffA);
            PG8_BAR; PG8_WAIT_L(0); PG8_MMA(1, 0, At, B0); PG8_BAR; PG8_SCHED;
            PG8_STAGE(PG8_SB(1, 1), b3 + hsB, voffB);
            PG8_WAIT_V(6); PG8_BAR; PG8_MMA(1, 1, At, B1); PG8_BAR;
            }
        }
        if constexpr (ALIGN_EPI) { if (wr == 0) PG8_BAR; }
        if constexpr (!Epi::AFTER_DRAIN) { E(acc, cur, wr, wc, fr, fq); S.done(cur); }
        if (!has_next) break;
#pragma unroll
        for (int a = 0; a < 2; ++a)
#pragma unroll
            for (int b = 0; b < 2; ++b)
#pragma unroll
                for (int m = 0; m < 4; ++m)
#pragma unroll
                    for (int n = 0; n < 2; ++n) acc[a][b][m][n] = (f32x4){0.f, 0.f, 0.f, 0.f};
        cur = nxt; cA = nA; cB = nB; ++ui;
        if constexpr (ALIGN_EPI) { if (wr == 1) PG8_BAR; }
    }
    PG8_WAIT_V(0);
    if constexpr (!ALIGN_EPI) { if (wr == 0) PG8_BAR; }
    PG8_BAR;
#undef PG8_SA
#undef PG8_SB
#undef PG8_STAGE
#undef PG8_LDA
#undef PG8_LDB
#undef PG8_MMA
#undef PG8_WAIT_V
#undef PG8_WAIT_L
#undef PG8_BAR
#undef PG8_SCHED
}
}

namespace swa {
constexpr int D = 128;
constexpr float SCALE = 0.08838834764831845f;
constexpr float THR = 8.f;
constexpr int NW = 8, QBLK = 32, KVBLK = 64, QB = NW * QBLK;
constexpr int SHM_V = KVBLK * D * 2, SHM_K = KVBLK * D * 2;
constexpr int LDS_BYTES_ATT = 2 * SHM_V + 2 * SHM_K + NW * 64 * 4;
#define KSWZ(row, colB) ((row) * 256 + ((colB) ^ (((row) & 7) << 4)))
#define SBAR() __builtin_amdgcn_sched_barrier(0)
__device__ __forceinline__ int v_st(int k, int c) { const int kk = (k & ~0xC) | ((k & 4) << 1) | ((k & 8) >> 1); return ((kk >> 3) * 4 + (c >> 5)) * 512 + ((kk & 7) * 32 + (c & 31)) * 2; }
__device__ __forceinline__ int v_rd_base(int lane) { return ((lane & 3) << 3) | (((lane >> 2) & 3) << 6) | (((lane >> 4) & 1) << 5) | (((lane >> 5) & 1) << 8); }
constexpr int v_rd_off(int d0, int ks, int half) { return d0 * 512 + ks * 4096 + half * 2048; }
__device__ __forceinline__ int crow(int r, int hi) { return (r & 3) + 8 * (r >> 2) + 4 * hi; }
__device__ __forceinline__ bf16x8 load8(const bf16_t* p) { return *reinterpret_cast<const bf16x8*>(p); }
__device__ __forceinline__ void mask_tile(f32x16& p0, f32x16& p1, int dq, unsigned W) {
    const float NEG = -__builtin_inff();
#pragma unroll
    for (int r = 0; r < 16; ++r) {
        const int c = (r & 3) + 8 * (r >> 2);
        if ((unsigned)(dq - c) >= W) p0[r] = NEG;
        if ((unsigned)(dq - c - 32) >= W) p1[r] = NEG;
    }
}
__device__ __forceinline__ void partialSM(f32x16& p0, f32x16& p1, float& m_reg, float& mn, float& alpha) {
    float pmax = p0[0];
#pragma unroll
    for (int r = 1; r < 16; ++r) pmax = fmaxf(pmax, p0[r]);
#pragma unroll
    for (int r = 0; r < 16; ++r) pmax = fmaxf(pmax, p1[r]);
    { auto rr = __builtin_amdgcn_permlane32_swap(__float_as_uint(pmax), __float_as_uint(pmax), false, false);
      pmax = fmaxf(__uint_as_float(rr[0]), __uint_as_float(rr[1])); }
    constexpr float C2 = 1.4426950408889634f * SCALE;
    if (__builtin_expect(__all((pmax - m_reg) * SCALE <= THR), 1)) { mn = m_reg; alpha = 1.f; }
    else { mn = fmaxf(m_reg, pmax); alpha = __builtin_amdgcn_exp2f((m_reg - mn) * C2); m_reg = mn; }
    const float mnL = -mn * C2;
#pragma unroll
    for (int r = 0; r < 16; ++r) p0[r] = fmaf(p0[r], C2, mnL);
#pragma unroll
    for (int r = 0; r < 16; ++r) p1[r] = fmaf(p1[r], C2, mnL);
#pragma unroll
    for (int r = 0; r < 16; ++r) p0[r] = __builtin_amdgcn_exp2f(p0[r]);
}
__device__ __forceinline__ void finishSM(f32x16& p0, f32x16& p1, float alpha, float& l_reg, bf16x8& pa0, bf16x8& pa1, bf16x8& pa2, bf16x8& pa3) {
#pragma unroll
    for (int r = 0; r < 16; ++r) p1[r] = __builtin_amdgcn_exp2f(p1[r]);
    float ps = 0;
#pragma unroll
    for (int r = 0; r < 16; ++r) ps += p0[r];
#pragma unroll
    for (int r = 0; r < 16; ++r) ps += p1[r];
    { auto rr = __builtin_amdgcn_permlane32_swap(__float_as_uint(ps), __float_as_uint(ps), false, false);
      ps = __uint_as_float(rr[0]) + __uint_as_float(rr[1]); }
    l_reg = l_reg * alpha + ps;
#define PK4(P, B_, OUT) do { unsigned a0 = cvt_pk_bf16(P[B_+0], P[B_+1]), a1 = cvt_pk_bf16(P[B_+2], P[B_+3]);                          \
        unsigned b0 = cvt_pk_bf16(P[B_+4], P[B_+5]), b1 = cvt_pk_bf16(P[B_+6], P[B_+7]);                                             \
        auto r0 = __builtin_amdgcn_permlane32_swap(a0, b0, false, false); auto r1 = __builtin_amdgcn_permlane32_swap(a1, b1, false, false); \
        u32x4 w = {r0[0], r1[0], r0[1], r1[1]}; OUT = *reinterpret_cast<bf16x8*>(&w); } while (0)
    PK4(p0, 0, pa0); PK4(p0, 8, pa1); PK4(p1, 0, pa2); PK4(p1, 8, pa3);
#undef PK4
}
template <int KB, bool SK>
__device__ __forceinline__ void qkt(f32x16& p0, f32x16& p1, const char* K_lds, int r32, int hi, const bf16x8* qr, bool act) {
    if (SK && !act) { const float NEG = -__builtin_inff();
#pragma unroll
        for (int r = 0; r < 16; ++r) { p0[r] = NEG; p1[r] = NEG; } return; }
    p0 = f32x16{}; p1 = f32x16{};
    const char* kb[4];
#pragma unroll
    for (int dd = 0; dd < 4; ++dd) kb[dd] = K_lds + KB * SHM_K + KSWZ(r32, (dd * 16 + hi * 8) * 2);
#pragma unroll
    for (int d0 = 0; d0 < 8; ++d0) { const char* a = kb[d0 & 3] + (d0 >> 2) * 128;
        bf16x8 b0 = *reinterpret_cast<const bf16x8*>(a);
        bf16x8 b1 = *reinterpret_cast<const bf16x8*>(a + 32 * 256);
        p0 = __builtin_amdgcn_mfma_f32_32x32x16_bf16(b0, qr[d0], p0, 0, 0, 0);
        p1 = __builtin_amdgcn_mfma_f32_32x32x16_bf16(b1, qr[d0], p1, 0, 0, 0); }
}
template <int VB, bool SK>
__device__ __forceinline__ void pv_tile(f32x16* o, int vb0, bf16x8 pa0, bf16x8 pa1, bf16x8 pa2, bf16x8 pa3, bool act) {
    if (SK && !act) return;
#define TRRD(dst, off) asm volatile("ds_read_b64_tr_b16 %0, %1 offset:%2" : "=&v"(dst) : "v"(vb0), "i"(off) : "memory")
#define PV_D0(d0) do { s16x4 l0, l1, l2, l3, h0, h1, h2, h3; constexpr int b_ = VB * SHM_V + v_rd_off(d0, 0, 0); \
        TRRD(l0, b_); TRRD(h0, b_ + 2048); TRRD(l1, b_ + 4096); TRRD(h1, b_ + 6144); TRRD(l2, b_ + 8192); TRRD(h2, b_ + 10240); TRRD(l3, b_ + 12288); TRRD(h3, b_ + 14336); \
        asm volatile("s_waitcnt lgkmcnt(0)" ::: "memory"); SBAR();   \
        o[d0] = __builtin_amdgcn_mfma_f32_32x32x16_bf16(pa0, (bf16x8){l0[0], l0[1], l0[2], l0[3], h0[0], h0[1], h0[2], h0[3]}, o[d0], 0, 0, 0);   \
        o[d0] = __builtin_amdgcn_mfma_f32_32x32x16_bf16(pa1, (bf16x8){l1[0], l1[1], l1[2], l1[3], h1[0], h1[1], h1[2], h1[3]}, o[d0], 0, 0, 0);   \
        o[d0] = __builtin_amdgcn_mfma_f32_32x32x16_bf16(pa2, (bf16x8){l2[0], l2[1], l2[2], l2[3], h2[0], h2[1], h2[2], h2[3]}, o[d0], 0, 0, 0);   \
        o[d0] = __builtin_amdgcn_mfma_f32_32x32x16_bf16(pa3, (bf16x8){l3[0], l3[1], l3[2], l3[3], h3[0], h3[1], h3[2], h3[3]}, o[d0], 0, 0, 0); } while (0)
    PV_D0(0); PV_D0(1); PV_D0(2); PV_D0(3);
#undef PV_D0
#undef TRRD
}
struct BlockRef { const bf16_t* Q; const bf16_t* K; const bf16_t* V; int P0; int b, h; };
struct Seam { bf16x8 qr[8]; bf16x8 st_v0, st_v1, st_k0, st_k1; };
struct Ctx { float* OACC; bf16_t* CAT; const float* GATES; const unsigned long long* SEL; };
__device__ __forceinline__ int swa_jlo(int P0, int W) { const int lowk = P0 - W + 1; return lowk > 0 ? lowk / KVBLK : 0; }
#define ROWU(p, k0, h) ((p) + (size_t)((k0) + 32 * (h)) * D + loff)
#define VMW() asm volatile("s_waitcnt vmcnt(0)" ::: "memory")
#define VMWN(n) asm volatile("s_waitcnt vmcnt(%0)" :: "i"(n) : "memory")
#define SLOAD_H(Kp, Vp, k0) do { S.st_v0 = load8(ROWU(Vp, k0, 0)); S.st_v1 = load8(ROWU(Vp, k0, 1));              \
                         S.st_k0 = load8(ROWU(Kp, k0, 0)); S.st_k1 = load8(ROWU(Kp, k0, 1)); } while (0)
#define SWRITE_HK(bf) do { *(bf16x8*)(K_lds + (bf) * SHM_K + kws) = S.st_k0; *(bf16x8*)(K_lds + (bf) * SHM_K + kws + 32 * 256) = S.st_k1; } while (0)
#define SWRITE_HV(bf) do { *(bf16x8*)(V_lds + (bf) * SHM_V + vst0) = S.st_v0; *(bf16x8*)(V_lds + (bf) * SHM_V + vst1) = S.st_v1; } while (0)
#define SWRITE_H(bf) do { SWRITE_HV(bf); SWRITE_HK(bf); } while (0)
__device__ __forceinline__ void swa_prime(const BlockRef& cur, int W, char* lds, Seam& S, int wid, int lane) {
    const int tid = wid * 64 + lane, r32 = lane & 31, hi = lane >> 5;
    const int sr = tid >> 4, sc = (tid & 15) * 8, kws = KSWZ(sr, sc * 2); char* K_lds = lds + 2 * SHM_V;
    const unsigned loff = (unsigned)(sr * D + sc), qoff = (unsigned)(r32 * D + hi * 8);
    const int kb0 = swa_jlo(cur.P0, W) * KVBLK;
#pragma unroll
    for (int d0 = 0; d0 < 8; ++d0) S.qr[d0] = load8(cur.Q + (size_t)(wid * QBLK) * D + d0 * 16 + qoff);
    SLOAD_H(cur.K, cur.V, kb0); VMW(); SWRITE_HK(0);
    __syncthreads();
}
template <int MODE, bool SK>
__device__ __forceinline__ void swa_block(const BlockRef& cur, const BlockRef& nxt, int W, int Wn, char* lds, Seam& S, const Ctx& X, int wid, int lane) {
    constexpr int skv = 4096;
    const int tid = wid * 64 + lane, r32 = lane & 31, hi = lane >> 5;
    const int j_lo = swa_jlo(cur.P0, W);
    int j_hi = (cur.P0 + QB - 1) / KVBLK + 1; if (j_hi > skv / KVBLK) j_hi = skv / KVBLK;
    const int NT = j_hi - j_lo;
    const int kbn = swa_jlo(nxt.P0, Wn) * KVBLK;
    const int qlo = cur.P0 + wid * QBLK, qm = qlo + r32 - 4 * hi;
    char* V_lds = lds; char* K_lds = lds + 2 * SHM_V;
    float* ws = (float*)(lds + 2 * SHM_V + 2 * SHM_K) + wid * 64; float* li_l = ws, * al_l = ws + 32;
    float m_reg = -1e30f, l_reg = 0; f32x16 o[4] = {};
    const int sr = tid >> 4, sc = (tid & 15) * 8, vst0 = v_st(sr, sc), vst1 = v_st(32 + sr, sc), kws = KSWZ(sr, sc * 2);
    const unsigned loff = (unsigned)(sr * D + sc), qoff = (unsigned)(r32 * D + hi * 8);
    const int vb0 = (int)(uintptr_t)V_lds + v_rd_base(lane);
    const bf16_t* Kh = cur.K; const bf16_t* Vh = cur.V;
    unsigned long long sel_ = ~0ull;
    if constexpr (MODE == 1) sel_ = X.SEL[(size_t)(cur.b * NG + (cur.h >> 2)) * T + qlo + r32];
#define RESC(a) do { if (__any((a) < 1.f)) { if (hi == 0) al_l[r32] = (a); asm volatile("s_waitcnt lgkmcnt(0)" ::: "memory");              \
                     for (int d_ = 0; d_ < 4; ++d_) for (int r = 0; r < 16; ++r) o[d_][r] *= al_l[crow(r, hi)]; } } while (0)
#define KBASE(t) ((j_lo + (t)) * KVBLK)
#define ACT(t) (KBASE(t) <= qlo + QBLK - 1 && KBASE(t) + KVBLK - 1 >= qlo - W + 1)
#define MASKT(P0_, P1_, t) do { const int kb_ = KBASE(t); if ((!SK || ACT(t)) && (kb_ + KVBLK - 1 > qlo || kb_ <= qlo + QBLK - 1 - W)) mask_tile(P0_, P1_, qm - kb_, (unsigned)W); \
        if constexpr (MODE == 1) { if (!((sel_ >> (j_lo + (t))) & 1ull)) { const float NEG_ = -__builtin_inff(); _Pragma("unroll") for (int r_ = 0; r_ < 16; ++r_) { P0_[r_] = NEG_; P1_[r_] = NEG_; } } } } while (0)
    constexpr int NQL = 8;
#define SEAM_K0() do { VMWN(NQL); SWRITE_HK(0); SBAR(); } while (0)
    f32x16 pA0, pA1, pB0, pB1; float mnA, mnB, alA, alB; bf16x8 pa0, pa1, pa2, pa3;
    SWRITE_HV(0); SBAR();
    if (NT > 1) { SLOAD_H(Kh, Vh, KBASE(1)); }
    SBAR(); qkt<0, SK>(pA0, pA1, K_lds, r32, hi, S.qr, ACT(0));
    MASKT(pA0, pA1, 0); partialSM(pA0, pA1, m_reg, mnA, alA);
    if (NT > 1) { VMW(); SWRITE_H(1); }
    __syncthreads();
#define HALF_STEP(PX0, PX1, mnX, alX, PY0, PY1, alY, t, KB, VB, SB) do {                                                      \
        SBAR(); qkt<KB, SK>(PX0, PX1, K_lds, r32, hi, S.qr, ACT(t));                                             \
        finishSM(PY0, PY1, alY, l_reg, pa0, pa1, pa2, pa3); SBAR();                                                           \
        if ((t) + 1 < NT) { SLOAD_H(Kh, Vh, KBASE((t) + 1)); SBAR(); }                                               \
        pv_tile<VB, SK>(o, vb0, pa0, pa1, pa2, pa3, ACT((t) - 1)); MASKT(PX0, PX1, (t)); partialSM(PX0, PX1, m_reg, mnX, alX);                                        \
        __syncthreads();                                                                                                      \
        if ((t) + 1 < NT) { VMW(); SWRITE_H(SB); }                                                                          \
        RESC(alX); __syncthreads(); } while (0)
    for (int t = 1; t + 1 < NT; t += 2) {
        HALF_STEP(pB0, pB1, mnB, alB, pA0, pA1, alA, t, 1, 0, 0);
        HALF_STEP(pA0, pA1, mnA, alA, pB0, pB1, alB, t + 1, 0, 1, 1);
    }
    const bool even = (NT & 1) == 0;
    if (even) { SBAR(); qkt<1, SK>(pB0, pB1, K_lds, r32, hi, S.qr, ACT(NT - 1)); SBAR(); }
    SLOAD_H(nxt.K, nxt.V, kbn); SBAR();
#pragma unroll
    for (int d0 = 0; d0 < 8; ++d0) S.qr[d0] = load8(nxt.Q + (size_t)(wid * QBLK) * D + d0 * 16 + qoff);
    SBAR();
    finishSM(pA0, pA1, alA, l_reg, pa0, pa1, pa2, pa3); SBAR();
    pv_tile<0, SK>(o, vb0, pa0, pa1, pa2, pa3, ACT(even ? NT - 2 : NT - 1));
    if (even) { MASKT(pB0, pB1, NT - 1); partialSM(pB0, pB1, m_reg, mnB, alB); __syncthreads(); RESC(alB);
        finishSM(pB0, pB1, alB, l_reg, pa0, pa1, pa2, pa3); SBAR(); pv_tile<1, SK>(o, vb0, pa0, pa1, pa2, pa3, ACT(NT - 1)); }
    SBAR(); SEAM_K0();
    if (hi == 0) li_l[r32] = __builtin_amdgcn_rcpf(l_reg) * X.GATES[(size_t)(cur.b * T + qlo + r32) * 48 + 3 * cur.h + (MODE == 1 ? 1 : 2)];
    asm volatile("s_waitcnt lgkmcnt(0)" ::: "memory");
    float rli[16];
#pragma unroll
    for (int r = 0; r < 16; ++r) rli[r] = li_l[crow(r, hi)];
    int hie = hi; asm volatile("" : "+v"(hie));
    const unsigned eo = (unsigned)(4 * hie * D + r32), ec = (unsigned)(4 * hie * DM + r32);
    float* Ob = X.OACC + ((size_t)(cur.b * NH + cur.h) * T + qlo) * D;
    bf16_t* Cb = X.CAT + (size_t)(cur.b * T + qlo) * DM + cur.h * HD;
#pragma unroll
    for (int r = 0; r < 16; ++r) { const int cr = (r & 3) + 8 * (r >> 2);
        float* op = Ob + (size_t)cr * D + eo;
        float ov[4];
#pragma unroll
        for (int d0 = 0; d0 < 4; ++d0) ov[d0] = op[d0 * 32];
#pragma unroll
        for (int d0 = 0; d0 < 4; ++d0) { const float v = ov[d0] + o[d0][r] * rli[r];
            if constexpr (MODE == 1) { op[d0 * 32] = v; }
            else { const float vn = __shfl_xor(v, 1);
                   if ((r32 & 1) == 0) *(unsigned*)(Cb + (size_t)cr * DM + d0 * 32 + ec) = cvt_pk_bf16(v, vn); } }
        asm volatile("" ::: "memory"); }
    __syncthreads();
#undef RESC
#undef KBASE
#undef ACT
#undef MASKT
#undef SEAM_K0
#undef HALF_STEP
}
#undef ROWU
#undef VMW
#undef VMWN
#undef SLOAD_H
#undef SWRITE_HK
#undef SWRITE_HV
#undef SWRITE_H

__host__ __device__ inline int swa_nramp(int nqb, int W) { const int t = W - 1; const int n = t < 0 ? 0 : t / QB + 1; return n > nqb ? nqb : n; }
struct SwaItem { int bh, qb0, qb1; };
__device__ __forceinline__ SwaItem swa_decode(int L, int nqb, int nx, int nramp) {
    SwaItem it; const int xcd = L & 7, k = L >> 3; it.bh = xcd * 4 + k / nx; const int x = k % nx;
    const int ns = nqb - nramp;
    if (x < ns) { it.qb0 = it.qb1 = nqb - 1 - x; } else { it.qb0 = x - ns; it.qb1 = nramp - 1 - it.qb0; }
    return it;
}
template <int MODE>
__device__ __forceinline__ BlockRef swa_ref(const SwaItem& it, int pass, const bf16_t* Q, const bf16_t* K, const bf16_t* V) {
    const int qb = pass ? it.qb1 : it.qb0, kvh = it.bh >> 2;
    BlockRef r; r.Q = Q + ((size_t)it.bh * T + (size_t)qb * QB) * D; r.K = K + (size_t)kvh * T * D; r.V = V + (size_t)kvh * T * D; r.P0 = qb * QB; r.b = it.bh >> 4; r.h = it.bh & 15;
    return r;
}
template <int MODE, bool SK>
__device__ __forceinline__ void swa_phase(char* lds, const bf16_t* Q, const bf16_t* K, const bf16_t* V, const Ctx& X, int W, int Wdeal, int c, int G, int wid, int lane) {
    constexpr int nqb = T / QB;
    const int nramp = swa_nramp(nqb, Wdeal),
               nx = (nramp + 1) / 2 + (nqb - nramp), total = nx * NB * NH;
    int L = c; if (L >= total) return;
    SwaItem it = swa_decode(L, nqb, nx, nramp); int pass = 0;
    BlockRef cur = swa_ref<MODE>(it, 0, Q, K, V);
    Seam S;
    swa_prime(cur, W, lds, S, wid, lane);
    for (;;) {
        const bool more_pass = pass == 0 && it.qb1 != it.qb0, more_item = L + G < total, last = !more_pass && !more_item;
        SwaItem itn = it; int passn = pass + 1, Ln = L;
        if (!more_pass) { passn = 0; Ln = more_item ? L + G : L; itn = swa_decode(Ln, nqb, nx, nramp); }
        const BlockRef nxt = last ? cur : swa_ref<MODE>(itn, passn, Q, K, V);
        swa_block<MODE, SK>(cur, nxt, W, W, lds, S, X, wid, lane);
        if (last) break;
        cur = nxt; it = itn; pass = passn; L = Ln;
    }
}
}

#define XB_TMO      128
#define XB_XCNT(j)  (256  + 64 * (j))
#define XB_XSUB(j)  (1280 + 64 * (j))
#define XB_XGEN(j)  (2304 + 64 * (j))
#define XB_TOP      3328
#define XB_TOPGEN   3392
#define XCD_BAR_WORDS 3456
#define XB_SPIN_CAP (1u << 18)
__device__ __forceinline__ unsigned xb_ld(unsigned* p)              { return __hip_atomic_load(p, __ATOMIC_RELAXED, __HIP_MEMORY_SCOPE_AGENT); }
__device__ __forceinline__ unsigned xb_add(unsigned* p, unsigned v) { return __hip_atomic_fetch_add(p, v, __ATOMIC_RELAXED, __HIP_MEMORY_SCOPE_AGENT); }
__device__ __forceinline__ unsigned xb_xcc_id() { return (unsigned)__builtin_amdgcn_s_getreg((3 << 11) | 20) & 0xFu; }
#define XB_SPIN(cond, bar) do { unsigned _sp = 0; while (cond) { __builtin_amdgcn_s_sleep(1); \
    if ((++_sp & 255u) == 0u) { if (xb_ld(&(bar)[XB_TMO])) break; if (_sp > XB_SPIN_CAP) { atomicAdd(&(bar)[XB_TMO], 1u); break; } } } } while (0)
struct XcdBarrier { unsigned* bar; unsigned x; volatile LAS unsigned* st; };
__device__ __forceinline__ XcdBarrier xcd_barrier_post(unsigned* bar, volatile LAS unsigned* st, bool t0) {
    XcdBarrier b; b.bar = bar; b.x = xb_xcc_id(); b.st = st;
    if (t0) (void)xb_add(&bar[XB_XCNT(b.x)], 1u);
    return b;
}
__device__ __forceinline__ void xcd_barrier_complete(unsigned* bar, unsigned x, unsigned& nloc, unsigned& nx) {
    const unsigned G = gridDim.x * gridDim.y * gridDim.z;
    unsigned sum, cnt, mine, sp = 0u;
    for (;;) {
        sum = 0u; cnt = 0u; mine = 0u;
#pragma unroll
        for (unsigned j = 0; j < 16; ++j) { const unsigned c = xb_ld(&bar[XB_XCNT(j)]); sum += c; cnt += (c > 0u) ? 1u : 0u; mine = (j == x) ? c : mine; }
        if (sum == G) break;
        __builtin_amdgcn_s_sleep(1);
        if ((++sp & 255u) == 0u) { if (xb_ld(&bar[XB_TMO])) break; if (sp > XB_SPIN_CAP) { atomicAdd(&bar[XB_TMO], 1u); break; } }
    }
    nloc = mine > 0u ? mine : 1u; nx = cnt > 0u ? cnt : 1u;
}
__device__ __forceinline__ void xcd_barrier(const XcdBarrier& b, bool t0) {
    asm volatile("s_waitcnt vmcnt(0)" ::: "memory");
    __syncthreads();
    if (t0) {
        unsigned* bar = b.bar;
        __builtin_amdgcn_s_waitcnt(0);
        unsigned nloc = b.st[0], nx = b.st[1];
        if (nloc == 0u) { xcd_barrier_complete(bar, b.x, nloc, nx); b.st[0] = nloc; b.st[1] = nx; }
        const unsigned old = xb_add(&bar[XB_XSUB(b.x)], 1u);
        const unsigned gen = old / nloc;
        if (old + 1u == (gen + 1u) * nloc) {
            __builtin_amdgcn_fence(__ATOMIC_RELEASE, "agent");
            asm volatile("s_waitcnt vmcnt(0)" ::: "memory");
            const unsigned og = xb_add(&bar[XB_TOP], 1u);
            const unsigned tg = og / nx;
            if (og + 1u == (tg + 1u) * nx) xb_add(&bar[XB_TOPGEN], 1u);
            else XB_SPIN(xb_ld(&bar[XB_TOPGEN]) == tg, bar);
            __builtin_amdgcn_fence(__ATOMIC_ACQUIRE, "agent");
            xb_add(&bar[XB_XGEN(b.x)], 1u);
            asm volatile("s_waitcnt vmcnt(0)" ::: "memory");
        } else {
            XB_SPIN(xb_ld(&bar[XB_XGEN(b.x)]) == gen, bar);
            __builtin_amdgcn_fence(__ATOMIC_ACQUIRE, "agent");
            asm volatile("s_waitcnt vmcnt(0)" ::: "memory");
        }
    }
    __syncthreads();
}

struct Args {
    const float* in[24]; float* out; unsigned char* ws; int ph_lo, ph_hi, G, pad;
};
__device__ __forceinline__ float wave_sum(float v) {
#pragma unroll
    for (int o = 1; o < 64; o <<= 1) v += __shfl_xor(v, o);
    return v;
}
__device__ __forceinline__ f32x4 mfma16(bf16x8 a, bf16x8 b, f32x4 c) { return __builtin_amdgcn_mfma_f32_16x16x32_bf16(a, b, c, 0, 0, 0); }

__device__ __forceinline__ void tr_load(const float* W, int ldw, int k0, int n0, int lane, f32x4 (&v)[16]) {
    const float* src = W + (size_t)(k0 + (lane >> 4)) * ldw + n0 + 4 * (lane & 15);
#pragma unroll
    for (int i = 0; i < 16; ++i) v[i] = __builtin_nontemporal_load((const f32x4*)(src + (size_t)(4 * i) * ldw));
}
__device__ __forceinline__ void tr_finish(const f32x4 (&v)[16], int k0, bf16_t* WT, size_t drow0, int ldt, LAS float* scr, int lane, const float* gn  ) {
#pragma unroll
    for (int i = 0; i < 16; ++i) { LAS float* s = scr + ((lane >> 4) + 4 * i) * 65 + 4 * (lane & 15); s[0] = v[i][0]; s[1] = v[i][1]; s[2] = v[i][2]; s[3] = v[i][3]; }
    LDS_WAIT();
    const int c = lane & 7;
    f32x4 g0 = {1.f, 1.f, 1.f, 1.f}, g1 = {1.f, 1.f, 1.f, 1.f};
    if (gn) { g0 = *(const f32x4*)(gn + 8 * c); g1 = *(const f32x4*)(gn + 8 * c + 4); }
#pragma unroll
    for (int j = 0; j < 8; ++j) { const int n = (lane >> 3) + 8 * j; const LAS float* s = scr + (8 * c) * 65 + n;
        u32x4 o; o.x = cvt_pk_bf16(s[0 * 65] * g0[0], s[1 * 65] * g0[1]); o.y = cvt_pk_bf16(s[2 * 65] * g0[2], s[3 * 65] * g0[3]); o.z = cvt_pk_bf16(s[4 * 65] * g1[0], s[5 * 65] * g1[1]); o.w = cvt_pk_bf16(s[6 * 65] * g1[2], s[7 * 65] * g1[3]);
        if (ldt > 0) *(u32x4*)(WT + (drow0 + n) * (size_t)ldt + k0 + 8 * c) = o;
        else { const int row = (int)drow0 + n, k = k0 + 8 * c;
               *(u32x4*)(WT + ((size_t)((row >> 4) * ((-ldt) >> 5) + (k >> 5)) * 64 + ((k >> 3) & 3) * 16 + (row & 15)) * 8) = o; } }
    LDS_WAIT();
}
__device__ __forceinline__ void rms_row_bf16(const float* xrow, const float* gain, bf16_t* orow, int lane) {
    const f32x4* xr = (const f32x4*)xrow + lane; const f32x4* gr = (const f32x4*)gain + lane;
    f32x4 v[16]; float s = 0.f;
#pragma unroll
    for (int j = 0; j < 16; ++j) { v[j] = xr[64 * j]; s += (v[j][0] * v[j][0] + v[j][1] * v[j][1]) + (v[j][2] * v[j][2] + v[j][3] * v[j][3]); }
    const float r = 1.0f / sqrtf(wave_sum(s) * (1.0f / DM) + EPS);
    u32x2* o8 = (u32x2*)orow + lane;
#pragma unroll
    for (int j = 0; j < 16; ++j) { const f32x4 g = gr[64 * j]; u32x2 w; w.x = cvt_pk_bf16(v[j][0] * r * g[0], v[j][1] * r * g[1]); w.y = cvt_pk_bf16(v[j][2] * r * g[2], v[j][3] * r * g[3]); o8[64 * j] = w; }
}
__device__ __forceinline__ void rms_row_f32(const float* xrow, const float* gain, float* orow, int lane) {
    const f32x4* xr = (const f32x4*)xrow + lane; const f32x4* gr = (const f32x4*)gain + lane;
    f32x4 v[16]; float s = 0.f;
#pragma unroll
    for (int j = 0; j < 16; ++j) { v[j] = xr[64 * j]; s += (v[j][0] * v[j][0] + v[j][1] * v[j][1]) + (v[j][2] * v[j][2] + v[j][3] * v[j][3]); }
    const float r = 1.0f / sqrtf(wave_sum(s) * (1.0f / DM) + EPS);
    f32x4* o = (f32x4*)orow + lane;
#pragma unroll
    for (int j = 0; j < 16; ++j) { const f32x4 g = gr[64 * j]; o[64 * j] = v[j] * r * g; }
}

__device__ const float ROPE_INV_FREQ[16] = {1.0f, 0.44036659598350525f, 0.1939227432012558f, 0.08539710193872452f, 0.03760603070259094f, 0.01656043902039528f, 0.007292664609849453f,
    0.0032114458736032248f, 0.0014142135623842478f, 0.000622772378847003f, 0.00027424818836152554f, 0.00012076973507646471f, 5.318296098266728e-05f, 2.34199997066753e-05f,
    1.0313386155758053e-05f, 4.541670477919979e-06f};

__device__ __forceinline__ void compress_item(LAS unsigned char* lds, int which, int rt, const bf16_t* X0, const float* cb, const bf16_t* W1, const bf16_t* W2,
                                              bf16_t* KCMP, bf16_t* VCMPT, int wave, int lane) {
    const int fr = lane & 15, q4 = lane >> 4;
    const int bgi = (rt * 16) >> 8, n = ((rt * 16) & 255) + fr;
    const bf16_t* X = X0 + (size_t)bgi * T * HD + 8 * q4;
    f32x4 acc0 = {0.f, 0.f, 0.f, 0.f}, acc1 = {0.f, 0.f, 0.f, 0.f};
    const bf16_t* w1p = W1 + ((size_t)(2 * wave) * 128 * 64 + lane) * 8;
#define CMP_LOADG(gq, A, B0, B1) do { _Pragma("unroll") for (int j = 0; j < 8; ++j) { const int ks = 8 * (gq) + j; int tok = 16 * n + 2 * (gq) + (j >> 2); tok = tok > (T - 1) ? (T - 1) : tok; \
        A[j] = *(const bf16x8*)(X + (size_t)tok * HD + 32 * (j & 3)); B0[j] = *(const bf16x8*)(w1p + (size_t)ks * 512); B1[j] = *(const bf16x8*)(w1p + (size_t)(128 + ks) * 512); } } while (0)
#define CMP_COMPG(A, B0, B1) do { _Pragma("unroll") for (int j = 0; j < 8; ++j) { acc0 = mfma16(A[j], B0[j], acc0); acc1 = mfma16(A[j], B1[j], acc1); } } while (0)
    bf16x8 a_0[8], b0_0[8], b1_0[8], a_1[8], b0_1[8], b1_1[8];
    CMP_LOADG(0, a_0, b0_0, b1_0);
    for (int gq = 0; gq < 16; gq += 2) {
        CMP_LOADG(gq + 1, a_1, b0_1, b1_1);
        CMP_COMPG(a_0, b0_0, b1_0);
        if (gq + 2 < 16) CMP_LOADG(gq + 2, a_0, b0_0, b1_0);
        CMP_COMPG(a_1, b0_1, b1_1);
    }
#undef CMP_LOADG
#undef CMP_COMPG
    const float cb0 = cb[32 * wave + fr], cb1 = cb[32 * wave + 16 + fr];
    LAS unsigned short* hid = (LAS unsigned short*)lds;
#pragma unroll
    for (int i = 0; i < 4; ++i) {
        hid[(4 * q4 + i) * 264 + 32 * wave + fr] = (unsigned short)(cvt_pk_bf16(gelu_tanh(acc0[i] + cb0), 0.f) & 0xffffu);
        hid[(4 * q4 + i) * 264 + 32 * wave + 16 + fr] = (unsigned short)(cvt_pk_bf16(gelu_tanh(acc1[i] + cb1), 0.f) & 0xffffu);
    }
    LDS_WAIT(); __syncthreads();
    f32x4 o = {0.f, 0.f, 0.f, 0.f};
    const bf16_t* w2p = W2 + (size_t)(16 * wave + fr) * 256 + 8 * q4;
#pragma unroll
    for (int ks = 0; ks < 8; ++ks) { const bf16x8 a2 = *(const LAS bf16x8*)(hid + fr * 264 + 32 * ks + 8 * q4); const bf16x8 b2 = *(const bf16x8*)(w2p + 32 * ks); o = mfma16(a2, b2, o); }
    const int nn = ((rt * 16) & 255) + 4 * q4, dcol = 16 * wave + fr;
    if (which == 0) {
#pragma unroll
        for (int i = 0; i < 4; ++i) { const int n_ = nn + i;
            KCMP[((size_t)((bgi * 16 + (n_ >> 4)) * 4 + (dcol >> 5)) * 64 + ((dcol >> 3) & 3) * 16 + (n_ & 15)) * 8 + (dcol & 7)] = (bf16_t)(cvt_pk_bf16(o[i], 0.f) & 0xffffu); }
    } else {
        u32x2 w; w.x = cvt_pk_bf16(o[0], o[1]); w.y = cvt_pk_bf16(o[2], o[3]);
        *(u32x2*)(VCMPT + ((size_t)((bgi * 8 + (dcol >> 4)) * 8 + (nn >> 5)) * 64 + ((nn >> 3) & 3) * 16 + (dcol & 15)) * 8 + (nn & 7)) = w;
    }
    __syncthreads();
}

__device__ __forceinline__ void cmp_attn_item(LAS unsigned char* lds, int bg, int tt, const bf16_t* QH, const bf16_t* KCMP, const bf16_t* VCMPT, const float* GATES,
                                              float* OACC, unsigned long long* SEL, int wave, int lane) {
    const int fr = lane & 15, q4 = lane >> 4, b = bg >> 2, g = bg & 3;
    const int t0w = tt * 32 + wave * 4;
    LAS unsigned short* pL = (LAS unsigned short*)(lds + wave * 8448);
    LAS float* impL = (LAS float*)(lds + 8 * 8448 + wave * 4160);
    LAS float* scL = (LAS float*)(lds + 8 * 8448 + 8 * 4160 + wave * 1024);
    const bf16_t* qrow = QH + ((size_t)((b * NH + g * 4 + (fr & 3)) * T + t0w + (fr >> 2))) * HD + 8 * q4;
    bf16x8 aq[4];
#pragma unroll
    for (int ks = 0; ks < 4; ++ks) aq[ks] = *(const bf16x8*)(qrow + 32 * ks);
    const bf16_t* kb = KCMP + ((size_t)bg * 16 * 4 * 64 + lane) * 8;
    const int nlast = (t0w + 3 >= 31) ? ((t0w + 3 - 31) >> 4) : -1, Tmax = nlast >> 4, Kmax = nlast >> 5;
    f32x4 s[16];
#pragma unroll
    for (int Tt = 0; Tt < 16; ++Tt) { f32x4 a = {0.f, 0.f, 0.f, 0.f};
        if (Tt <= Tmax) {
#pragma unroll
            for (int ks = 0; ks < 4; ++ks) { const bf16x8 bk = *(const bf16x8*)(kb + (size_t)(Tt * 4 + ks) * 512); a = mfma16(aq[ks], bk, a); } }
        s[Tt] = a; }
    const int t = t0w + q4;
    const int nmax = (t >= 31) ? ((t - 31) >> 4) : -1;
    const float NEGI = -__builtin_inff();
    float mx[4] = {NEGI, NEGI, NEGI, NEGI};
#pragma unroll
    for (int Tt = 0; Tt < 16; ++Tt) { const bool valid = (16 * Tt + fr) <= nmax;
#pragma unroll
        for (int i = 0; i < 4; ++i) mx[i] = valid ? fmaxf(mx[i], s[Tt][i]) : mx[i]; }
#pragma unroll
    for (int i = 0; i < 4; ++i) {
#pragma unroll
        for (int o = 1; o < 16; o <<= 1) mx[i] = fmaxf(mx[i], __shfl_xor(mx[i], o)); }
    constexpr float C2 = 1.4426950408889634f * 0.08838834764831845f;
    float sum[4] = {0.f, 0.f, 0.f, 0.f};
#pragma unroll
    for (int Tt = 0; Tt < 16; ++Tt) { const bool valid = (16 * Tt + fr) <= nmax;
#pragma unroll
        for (int i = 0; i < 4; ++i) { const float p = valid ? __builtin_amdgcn_exp2f((s[Tt][i] - mx[i]) * C2) : 0.f; s[Tt][i] = p; sum[i] += p; } }
#pragma unroll
    for (int i = 0; i < 4; ++i) {
#pragma unroll
        for (int o = 1; o < 16; o <<= 1) sum[i] += __shfl_xor(sum[i], o);
        sum[i] = sum[i] > 0.f ? 1.0f / sum[i] : 0.f; }
#pragma unroll
    for (int Tt = 0; Tt < 16; ++Tt) {
#pragma unroll
        for (int i = 0; i < 4; ++i) s[Tt][i] *= sum[i];
        impL[q4 * 260 + 16 * Tt + fr] = ((s[Tt][0] + s[Tt][1]) + s[Tt][2]) + s[Tt][3];
#pragma unroll
        for (int i = 0; i < 4; ++i) pL[(4 * q4 + i) * 264 + 16 * Tt + fr] = (unsigned short)(cvt_pk_bf16(s[Tt][i], 0.f) & 0xffffu);
    }
    LDS_WAIT();
    bf16x8 pf[8];
#pragma unroll
    for (int ks = 0; ks < 8; ++ks) pf[ks] = *(const LAS bf16x8*)(pL + fr * 264 + 32 * ks + 8 * q4);
    const bf16_t* vb = VCMPT + ((size_t)bg * 8 * 8 * 64 + lane) * 8;
    float gt[4];
#pragma unroll
    for (int i = 0; i < 4; ++i) gt[i] = GATES[(size_t)(b * T + t) * 48 + 3 * (g * 4 + i) + 0];
#pragma unroll
    for (int Dt = 0; Dt < 8; ++Dt) { f32x4 o = {0.f, 0.f, 0.f, 0.f};
#pragma unroll
        for (int ks = 0; ks < 8; ++ks) if (ks <= Kmax) { const bf16x8 bv = *(const bf16x8*)(vb + (size_t)(Dt * 8 + ks) * 512); o = mfma16(pf[ks], bv, o); }
#pragma unroll
        for (int i = 0; i < 4; ++i) OACC[((size_t)((b * NH + g * 4 + i) * T + t)) * HD + 16 * Dt + fr] = o[i] * gt[i]; }
    const LAS float* im = impL + q4 * 260;
    const int cur = t >> 6;
    float myv[4];
#pragma unroll
    for (int k = 0; k < 4; ++k) { const int jj = fr + 16 * k;
        const float m0 = jj > 0 ? im[4 * jj - 1] : 0.f, m1 = im[4 * jj], m2 = im[4 * jj + 1], m3 = im[4 * jj + 2], nx = im[4 * jj + 3];
        float sc = (((m0 + m1) + m2) + m3) - 0.5f * m0 + 0.5f * nx;
        sc = (jj == cur || jj == 0) ? 1e30f : (jj > cur ? -1e30f : sc);
        myv[k] = sc; scL[q4 * 64 + jj] = sc; }
    LDS_WAIT();
    int rank[4] = {0, 0, 0, 0};
#pragma unroll 8
    for (int i = 0; i < 64; ++i) { const float si = scL[q4 * 64 + i];
#pragma unroll
        for (int k = 0; k < 4; ++k) rank[k] += ((si > myv[k]) || (si == myv[k] && i < fr + 16 * k)) ? 1 : 0; }
    unsigned long long msk = 0ull;
#pragma unroll
    for (int k = 0; k < 4; ++k) { const unsigned long long bal = __ballot(rank[k] < 16); msk |= ((bal >> (16 * q4)) & 0xffffull) << (16 * k); }
    if (fr == 0) SEL[(size_t)bg * T + t] = msk;
    LDS_WAIT();
}

__device__ __forceinline__ void gate_task(LAS unsigned char* lds, int g, int dq, int bc0, int nbc, const bf16_t* V, bf16_t* U, const float* SUMS, const float* ln_g, const float* ln_b,
                                          const bf16_t* WM, const float* bs, int tid, int wave, int lane) {
    const int fr = lane & 15, q4 = lane >> 4;
    const int col0 = g * 768 + dq * 128;
    const int cc = tid & 15, s0 = tid >> 4;
    const f32x4 lg0 = *(const f32x4*)(ln_g + col0 + 8 * cc), lg1 = *(const f32x4*)(ln_g + col0 + 8 * cc + 4), lb0 = *(const f32x4*)(ln_b + col0 + 8 * cc), lb1 = *(const f32x4*)(ln_b + col0 + 8 * cc + 4);
    bf16x8 wf[4];
    const bf16_t* wp = WM + ((size_t)g * 128 + 16 * wave + fr) * 128 + 8 * q4;
#pragma unroll
    for (int ks = 0; ks < 4; ++ks) wf[ks] = *(const bf16x8*)(wp + 32 * ks);
    const int tt = 16 * wave + fr, kmax = wave >> 1;
    const float bias = bs[g * 128 + tt];
    const unsigned kf = (unsigned)((fr >> 3) ^ ((fr & 7) << 1)), rdl = ((unsigned)q4 ^ kf) << 4;
    u32x4 vraw[4]; f32x2 st[4];
    const bf16_t* vp = V + (size_t)(bc0 * 128 + s0) * GW + col0 + 8 * cc;
    const float* sp = SUMS + (size_t)(bc0 * 128 + s0) * 2;
#pragma unroll
    for (int j = 0; j < 4; ++j) { vraw[j] = *(const u32x4*)(vp + (size_t)(32 * j) * GW); st[j] = *(const f32x2*)(sp + 64 * j); }
    for (int i = 0; i < nbc; ++i) {
        const int row0 = (bc0 + i) * 128;
#pragma unroll
        for (int j = 0; j < 4; ++j) { const int sidx = s0 + 32 * j;
            const float mean = st[j][0] * (1.0f / GW); float var = st[j][1] * (1.0f / GW) - mean * mean; var = var > 0.f ? var : 0.f; const float rstd = 1.0f / sqrtf(var + EPS);
            const float x[8] = {bflo(vraw[j].x), bfhi(vraw[j].x), bflo(vraw[j].y), bfhi(vraw[j].y), bflo(vraw[j].z), bfhi(vraw[j].z), bflo(vraw[j].w), bfhi(vraw[j].w)};
#pragma unroll
            for (int e = 0; e < 8; ++e) { const float gg = e < 4 ? lg0[e & 3] : lg1[e & 3], bb = e < 4 ? lb0[e & 3] : lb1[e & 3];
                const float y = (x[e] - mean) * rstd * gg + bb;
                const unsigned off = (unsigned)(8 * cc + e) * 256u + ((((unsigned)(sidx >> 3)) ^ ((unsigned)cc ^ (unsigned)(2 * e))) & 15u) * 16u + (unsigned)(sidx & 7) * 2u;
                *(LAS unsigned short*)(lds + off) = (unsigned short)(cvt_pk_bf16(y, 0.f) & 0xffffu); } }
        if (i + 1 < nbc) {
            const bf16_t* vn = V + (size_t)(row0 + 128 + s0) * GW + col0 + 8 * cc; const float* sn = SUMS + (size_t)(row0 + 128 + s0) * 2;
#pragma unroll
            for (int j = 0; j < 4; ++j) { vraw[j] = *(const u32x4*)(vn + (size_t)(32 * j) * GW); st[j] = *(const f32x2*)(sn + 64 * j); } }
        bf16_t* up = U + (size_t)(row0 + tt) * GW + col0 + 4 * q4;
        u32x2 u4[8];
#pragma unroll
        for (int nt = 0; nt < 8; ++nt) u4[nt] = *(const u32x2*)(up + 16 * nt);
        LDS_WAIT(); __syncthreads();
#pragma unroll
        for (int nt = 0; nt < 8; ++nt) { f32x4 acc = {0.f, 0.f, 0.f, 0.f};
#pragma unroll
            for (int ks = 0; ks < 4; ++ks) if (ks <= kmax) { const bf16x8 af = *(const LAS bf16x8*)(lds + (unsigned)(16 * nt + fr) * 256u + ((unsigned)(((4 * ks) ^ (2 * nt)) << 4) ^ rdl)); acc = mfma16(af, wf[ks], acc); }
            u32x2 w; w.x = cvt_pk_bf16(bflo(u4[nt].x) * (acc[0] + bias), bfhi(u4[nt].x) * (acc[1] + bias)); w.y = cvt_pk_bf16(bflo(u4[nt].y) * (acc[2] + bias), bfhi(u4[nt].y) * (acc[3] + bias));
            *(u32x2*)(up + 16 * nt) = w; }
        __syncthreads();
    }
}

template <int W> __device__ __forceinline__ void pool_chunk(const bf16_t* PIN, bf16_t* POOLED, int row, int c8) {
    const int t = row & (T - 1), cnt = (t + 1) < W ? (t + 1) : W;
    u32x4 v[W];
#pragma unroll
    for (int i = 0; i < W; ++i) { const int ri = (i <= t) ? row - i : row; v[i] = *(const u32x4*)(PIN + (size_t)ri * 2048 + c8); }
    float sm[8] = {0.f, 0.f, 0.f, 0.f, 0.f, 0.f, 0.f, 0.f};
#pragma unroll
    for (int i = 0; i < W; ++i) { const float k = (i <= t) ? 1.f : 0.f;
        sm[0] += k * bflo(v[i].x); sm[1] += k * bfhi(v[i].x); sm[2] += k * bflo(v[i].y); sm[3] += k * bfhi(v[i].y); sm[4] += k * bflo(v[i].z); sm[5] += k * bfhi(v[i].z); sm[6] += k * bflo(v[i].w); sm[7] += k * bfhi(v[i].w); }
    const float fc = (float)cnt; const u32x4 cur = v[0];
    u32x4 w; w.x = cvt_pk_bf16(sm[0] / fc - bflo(cur.x), sm[1] / fc - bfhi(cur.x)); w.y = cvt_pk_bf16(sm[2] / fc - bflo(cur.y), sm[3] / fc - bfhi(cur.y));
    w.z = cvt_pk_bf16(sm[4] / fc - bflo(cur.z), sm[5] / fc - bfhi(cur.z)); w.w = cvt_pk_bf16(sm[6] / fc - bflo(cur.w), sm[7] / fc - bfhi(cur.w));
    *(u32x4*)(POOLED + (size_t)row * 2048 + c8) = w;
}

constexpr int N_PHASES = 19;
constexpr int I_INE1 = 64 * 80, I_INE2 = 64 * 32, I_OUTE = 64 * 64, I_G = 64 * 172, I_DN = 172 * 64, I_INO = 64 * 384, I_OUTO = 192 * 64, I_POOL = 8 * 8, I_C1 = 64 * 4, I_C2 = 4 * 2;
constexpr int NIT_A = I_INE1 + I_INE2 + 4 * I_POOL + 2 * I_C1 + 2 * I_C2;
constexpr int NIT_P0 = NIT_A + 4 * I_G + I_INO;
constexpr int NIT_T1 = NIT_P0 + I_DN + I_OUTE;
constexpr int NIT_T8 = NIT_T1 + I_OUTO;
constexpr int NITEMS = NIT_T8 + I_DN;
#ifndef PH_MASK
#define PH_MASK 0x7FFFF
#endif
typedef const __attribute__((address_space(4))) Args* KArgs;
__device__ __forceinline__ KArgs kargs() { unsigned long long v = (unsigned long long)__builtin_amdgcn_kernarg_segment_ptr(); asm volatile("" : "+s"(v)); return (KArgs)v; }
#define WSP(type, off) ((type*)(ws + (off)))

struct ConvJob { int cnt, in_idx; unsigned src_off; unsigned long long dst_off; int ldw, K, nblk, col0, drow0, mode, gain_idx, gain_off; };
__device__ const ConvJob CONV_JOBS[19] = {
    {I_INE1, 2, 0u, O_W_INE, IN_EVEN, 4096, 80, 0, 0, 0, -1, 0},
    {I_INE2, 2, 0u, O_W_INE, IN_EVEN, 4096, 32, 5168, 5120, 0, -1, 0},
    {I_POOL, 9, 0u, O_W_POOL, 512, 512, 8, 0, 0, 0, -1, 0},
    {I_POOL, 9, 1u * 512 * 512, O_W_POOL + 1ull * 512 * 512 * 2, 512, 512, 8, 0, 0, 0, -1, 0},
    {I_POOL, 9, 2u * 512 * 512, O_W_POOL + 2ull * 512 * 512 * 2, 512, 512, 8, 0, 0, 0, -1, 0},
    {I_POOL, 9, 3u * 512 * 512, O_W_POOL + 3ull * 512 * 512 * 2, 512, 512, 8, 0, 0, 0, -1, 0},
    {I_C1, 5, 0u, O_W_C1K, 256, 4096, 4, 0, 0, 2, -1, 0},
    {I_C1, 7, 0u, O_W_C1V, 256, 4096, 4, 0, 0, 2, -1, 0},
    {I_C2, 6, 0u, O_W_C2K, 128, 256, 2, 0, 0, 0, -1, 0},
    {I_C2, 8, 0u, O_W_C2V, 128, 256, 2, 0, 0, 0, -1, 0},
    {I_G, 20, 0u, O_W_GU0, FF, 4096, 172, 0, 0, 1, 19, 0},
    {I_G, 21, 0u, O_W_GU0, FF, 4096, 172, 0, 128, 1, 19, 0},
    {I_G, 20, (unsigned)(DM * FF), O_W_GU1, FF, 4096, 172, 0, 0, 1, 19, DM},
    {I_G, 21, (unsigned)(DM * FF), O_W_GU1, FF, 4096, 172, 0, 128, 1, 19, DM},
    {I_INO, 13, 0u, O_W_INO, 2 * GW, 4096, 384, 0, 0, 0, 12, 0},
    {I_DN, 22, 0u, O_W_DN0, 4096, FF, 64, 0, 0, 0, -1, 0},
    {I_OUTE, 11, 0u, O_W_OUTE, 4096, 4096, 64, 0, 0, 0, -1, 0},
    {I_OUTO, 18, 0u, O_W_OUTO, 4096, GW, 64, 0, 0, 0, -1, 0},
    {I_DN, 22, (unsigned)(DM * FF), O_W_DN1, 4096, FF, 64, 0, 0, 0, -1, 0}};
#define CONV_DECODE(it_, osrc, odst, oldw, oK, k0, n0, drow, ogn) const float* osrc; bf16_t* odst; const float* ogn; int oldw, oK, k0, n0, drow; { \
            int r = (it_), j = 0; while (j < 18 && r >= CONV_JOBS[j].cnt) { r -= CONV_JOBS[j].cnt; ++j; } \
            const ConvJob jb = CONV_JOBS[j]; \
            const int kb = r / jb.nblk, nb = r - kb * jb.nblk, n0l = nb * 64; k0 = kb * 64; n0 = jb.col0 + n0l; \
            drow = jb.mode == 1 ? (256 * (n0l >> 7) + (n0l & 127) + jb.drow0) : (jb.drow0 + n0l); \
            osrc = ap->in[jb.in_idx] + jb.src_off; odst = (bf16_t*)(ws + jb.dst_off); oldw = jb.ldw; oK = jb.mode == 2 ? -jb.K : jb.K; ogn = jb.gain_idx >= 0 ? ap->in[jb.gain_idx] + jb.gain_off + k0 : nullptr; }
#define CONV_RANGE(lo_, hi_, first_, stride_) do { LAS float* scr = (LAS float*)(lds + RING_OFF + wave * 16640); \
        for (int it = (lo_) + (first_); it < (hi_); it += 2 * (stride_)) { f32x4 va[16], vb[16]; const bool hasb = it + (stride_) < (hi_); \
            CONV_DECODE(it, srcA, dstA, ldwA, KA, k0A, n0A, drowA, gnA) tr_load(srcA, ldwA, k0A, n0A, lane, va); \
            CONV_DECODE(hasb ? it + (stride_) : it, srcB, dstB, ldwB, KB, k0B, n0B, drowB, gnB) tr_load(srcB, ldwB, k0B, n0B, lane, vb);   \
            tr_finish(va, k0A, dstA, (size_t)drowA, KA, scr, lane, gnA); if (hasb) tr_finish(vb, k0B, dstB, (size_t)drowB, KB, scr, lane, gnB); } } while (0)
#define CONV_TAIL(nunits_, lo_, hi_) do { const int rounds_ = ((nunits_) + G - 1) / G, first_idle_ = (nunits_) - (rounds_ - 1) * G; \
        if (first_idle_ >= G) CONV_RANGE(lo_, hi_, bx * NWAVES + wave, G * NWAVES);   \
        else if (bx >= first_idle_) CONV_RANGE(lo_, hi_, (bx - first_idle_) * NWAVES + wave, (G - first_idle_) * NWAVES); } while (0)

__device__ __forceinline__ bool ph_in(int k) { KArgs ap = kargs(); return ap->ph_lo <= k && k < ap->ph_hi; }
__global__ void __launch_bounds__(NWAVES * 64, 2) fwd(Args args) {
    extern __shared__ __attribute__((aligned(16))) unsigned char lds_raw[];
    LAS unsigned char* lds = (LAS unsigned char*)lds_raw;
    const int wave = __builtin_amdgcn_readfirstlane((int)threadIdx.x >> 6);
    const int bx = blockIdx.x;
    { const int tid0 = threadIdx.x; for (int u = tid0; u < (LDS_BYTES - LDSCTL_OFF) / 4; u += NWAVES * 64) ((LAS unsigned*)(lds + LDSCTL_OFF))[u] = 0u; }
    __syncthreads();
#if MK_ONE_LAUNCH
    { KArgs ap = kargs(); (void)xcd_barrier_post((unsigned*)(ap->ws + O_CTL) + CW_BAR, (volatile LAS unsigned*)(lds + MISC_OFF) + 8, wave == 0 && lane_id() == 0); }
#define GRID_BAR() do { XcdBarrier bar_; bar_.bar = (unsigned*)(ws + O_CTL) + CW_BAR; bar_.x = xb_xcc_id(); bar_.st = (volatile LAS unsigned*)(lds + MISC_OFF) + 8; xcd_barrier(bar_, wave == 0 && lane_id() == 0); } while (0)
#else
#define GRID_BAR() do { } while (0)
#endif
#define IN(k) ((((PH_MASK) >> (k)) & 1) && ph_in(k))
#define BOTH(k) (IN(k) && IN((k) + 1))
#define PH_ARGS KArgs ap = kargs(); unsigned char* ws = ap->ws; (void)ws; const int G = ap->G; const int lane = lane_id(); const int tid = wave * 64 + lane; (void)tid; \
    const int vcu = (G % 8 == 0) ? (bx % 8) * (G / 8) + bx / 8 : bx; (void)vcu; const int gw = vcu * NWAVES + wave, NGW = G * NWAVES; (void)gw; (void)NGW; \
    const int gtid = vcu * (NWAVES * 64) + tid, NT_ALL = G * NWAVES * 64; (void)gtid; (void)NT_ALL

    if (IN(0)) {
        PH_ARGS;
        CONV_RANGE(0, NIT_A, gw, NGW);
        { const float* w_in = ap->in[2]; bf16_t* W_INE = WSP(bf16_t, O_W_INE);
          for (int idx = gtid; idx < 256 * 4096; idx += NT_ALL) { const int rr = idx >> 12, k = idx & 4095;
            const float v = rr < 48 ? w_in[(size_t)k * IN_EVEN + 5120 + rr] : 0.f;
            W_INE[(size_t)(7168 + rr) * 4096 + k] = (bf16_t)(cvt_pk_bf16(v, 0.f) & 0xffffu); } }
        { float* CB = WSP(float, O_CTL + O_CBIAS);
          for (int o = gw; o < 512; o += NGW) { const int which = o >> 8, h = o & 255; const float* pe = which ? ap->in[4] : ap->in[3]; const float* w1 = which ? ap->in[7] : ap->in[5]; float a = 0.f;
            for (int k = lane; k < 4096; k += 64) a += pe[k] * w1[(size_t)k * 256 + h];
            a = wave_sum(a); if (lane == 0) CB[o] = a; } }
        { const float* gws = ap->in[16]; bf16_t* WM = WSP(bf16_t, O_WM);
          for (int idx = gtid; idx < 16 * 128 * 128; idx += NT_ALL) { const int t = (idx >> 7) & 127, s = idx & 127;
            const float v = s <= t ? gws[idx] : 0.f; WM[idx] = (bf16_t)(cvt_pk_bf16(v, 0.f) & 0xffffu); } }
        { float* ROPE = WSP(float, O_ROPE);
          for (int idx = gtid; idx < 4096 * 16; idx += NT_ALL) { const int t = idx >> 4, i = idx & 15;
            const float ang = (float)t * ROPE_INV_FREQ[i];
            const double xr = (double)ang; const double nrev = __builtin_rint(xr * 0.15915494309189535); const double rr = __builtin_fma(-nrev, 6.283185307179586, xr) - nrev * 2.4492935982947064e-16;
            const double r2 = rr * rr; double ts = 1.0, tc = 1.0, sn = 1.0, cs = 1.0;
#pragma unroll
            for (int k = 1; k <= 15; ++k) { ts *= -r2 / (double)((2 * k) * (2 * k + 1)); sn += ts; tc *= -r2 / (double)((2 * k - 1) * (2 * k)); cs += tc; }
            ROPE[idx] = (float)cs; ROPE[65536 + idx] = (float)(sn * rr); } }
        { const float* x = ap->in[0]; const float* gn = ap->in[1]; bf16_t* HN = WSP(bf16_t, O_HN);
          for (int m = gw; m < M; m += NGW) rms_row_bf16(x + (size_t)m * DM, gn, HN + (size_t)m * DM, lane); }
        if (BOTH(0)) GRID_BAR();
    }

    if (IN(1)) {
        PH_ARGS;
        pg8::Gemm g{WSP(bf16_t, O_HN), WSP(bf16_t, O_W_INE), M, IN_EVEN_P, DM, DM, DM}; pg8::StaticOrder S; S.init(M, IN_EVEN_P, G, bx);
        pg8::EpiInEven E{WSP(bf16_t, O_QH), WSP(bf16_t, O_KV), WSP(bf16_t, O_PIN), WSP(float, O_GATES), WSP(float, O_ROPE)};
        pg8::gemm_phase<pg8::EpiInEven, pg8::StaticOrder, true, true>(lds + RING_OFF, g, S, E, wave, lane);
        CONV_TAIL((M / 256) * (IN_EVEN_P / 256), NIT_P0, NIT_T1);
        if (BOTH(1)) GRID_BAR();
    }
    if (IN(2)) {
        PH_ARGS;
        for (int id = vcu; id < 256; id += G) { const int which = id >> 7, rt = id & 127;
            compress_item(lds + RING_OFF, which, rt, WSP(bf16_t, O_KV) + (size_t)which * KVSZ, WSP(float, O_CTL + O_CBIAS) + 256 * which, which ? WSP(bf16_t, O_W_C1V) : WSP(bf16_t, O_W_C1K),
                          which ? WSP(bf16_t, O_W_C2V) : WSP(bf16_t, O_W_C2K), WSP(bf16_t, O_KCMP), WSP(bf16_t, O_VCMPT), wave, lane); }
        const bf16_t* PIN = WSP(bf16_t, O_PIN); bf16_t* POOLED = WSP(bf16_t, O_POOLED);
        for (int idx = gtid; idx < M * 256; idx += NT_ALL) { const int row = idx >> 8, c8 = (idx & 255) * 8, grp = __builtin_amdgcn_readfirstlane(c8 >> 9);
            if (grp == 0) pool_chunk<2>(PIN, POOLED, row, c8); else if (grp == 1) pool_chunk<4>(PIN, POOLED, row, c8); else if (grp == 2) pool_chunk<8>(PIN, POOLED, row, c8); else pool_chunk<16>(PIN, POOLED, row, c8); }
        if (BOTH(2)) GRID_BAR();
    }
    if (IN(3)) {
        PH_ARGS;
        { const int grp = bx >> 6, loc = bx & 63;
          pg8::Gemm g{WSP(bf16_t, O_POOLED) + 512 * grp, WSP(bf16_t, O_W_POOL) + (size_t)grp * 512 * 512, M, 512, 512, 2048, 512}; pg8::StaticOrder S; S.init(M, 512, 64, loc);
          pg8::EpiScaleBf16 E{WSP(bf16_t, O_CAT) + 2048 + 512 * grp, DM, ap->in[10] + 512 * grp};
          if (grp < 4) pg8::gemm_phase<pg8::EpiScaleBf16, pg8::StaticOrder, false, true>(lds + RING_OFF, g, S, E, wave, lane); }
        __syncthreads();
        for (int id = vcu; id < 1024; id += G) cmp_attn_item(lds + RING_OFF, 2 * (id >> 8) + ((id >> 7) & 1), (id + 32 * (id >> 8)) & 127, WSP(bf16_t, O_QH), WSP(bf16_t, O_KCMP), WSP(bf16_t, O_VCMPT), WSP(float, O_GATES),
                                                             WSP(float, O_OACC), WSP(unsigned long long, O_SEL), wave, lane);
        if (BOTH(3)) GRID_BAR();
    }
    if (IN(4)) {
        PH_ARGS;
        const bool conv_first = ((bx >> 3) & 1) != 0;
        if (conv_first) { CONV_RANGE(NIT_A, NIT_P0, bx * NWAVES + wave, G * NWAVES); VM_WAIT(); __syncthreads(); }
        const swa::Ctx X{WSP(float, O_OACC), WSP(bf16_t, O_CAT), WSP(float, O_GATES), WSP(unsigned long long, O_SEL)};
        swa::swa_phase<1, false>((char*)lds_raw + RING_OFF, WSP(bf16_t, O_QH), WSP(bf16_t, O_KV) + 2 * KVSZ, WSP(bf16_t, O_KV) + 3 * KVSZ, X, 1 << 28, 1 << 28, bx, G, wave, lane);
        if (!conv_first) { __syncthreads(); CONV_RANGE(NIT_A, NIT_P0, bx * NWAVES + wave, G * NWAVES); }
        VM_WAIT(); __syncthreads();
        swa::swa_phase<0, true>((char*)lds_raw + RING_OFF, WSP(bf16_t, O_QH), WSP(bf16_t, O_KV) + 4 * KVSZ, WSP(bf16_t, O_KV) + 5 * KVSZ, X, 512, 1 << 28, bx, G, wave, lane);
        if (BOTH(4)) GRID_BAR();
    }
    if (IN(6)) {
        PH_ARGS;
        pg8::Gemm g{WSP(bf16_t, O_CAT), WSP(bf16_t, O_W_OUTE), M, DM, DM, DM, DM}; pg8::StaticOrder S; S.init(M, DM, G, bx);
        pg8::EpiResid<true> E{ap->in[0], WSP(bf16_t, O_XB), DM, WSP(float, O_SSQP)};
        pg8::gemm_phase<pg8::EpiResid<true>, pg8::StaticOrder, true, true>(lds + RING_OFF, g, S, E, wave, lane);
        if (BOTH(6)) GRID_BAR();
    }
    for (int l = 0; l < 2; ++l) {
        if (l == 1) {
            if (IN(11)) {
                PH_ARGS;
                pg8::Gemm g{WSP(bf16_t, O_XB1), WSP(bf16_t, O_W_INO), M, 2 * GW, DM, DM, DM}; pg8::StaticOrder S; S.init(M, 2 * GW, G, bx);
                pg8::Unit u0; LAS float* tab = (LAS float*)(lds + ROWSC_OFF); int pm0 = -1;
                if (S.next(0, u0)) { pm0 = u0.pm; pg8::build_row_scale(tab, WSP(float, O_SSQP), pm0, tid); }
                LDS_WAIT(); __syncthreads();
                pg8::EpiGeluSplit E{WSP(bf16_t, O_U), WSP(bf16_t, O_V), GW, GW, WSP(float, O_VPART), pg8::RowScale{tab, pm0}};
                pg8::gemm_phase<pg8::EpiGeluSplit, pg8::StaticOrder, true, true>(lds + RING_OFF, g, S, E, wave, lane);
                if (BOTH(11)) GRID_BAR();
            }
            if (IN(12)) { PH_ARGS; const float* part = WSP(float, O_VPART); float* SUMS = WSP(float, O_CTL + O_VSUMS);
                for (int m = gw; m < M; m += NGW) { const f32x2* pr = (const f32x2*)(part + (size_t)m * 384) + lane; const f32x2 a = pr[0], b = pr[64], c = pr[128];
                    const float s1 = wave_sum((a[0] + b[0]) + c[0]), s2 = wave_sum((a[1] + b[1]) + c[1]); if (lane == 0) *(f32x2*)(SUMS + (size_t)m * 2) = (f32x2){s1, s2}; }
                if (BOTH(12)) GRID_BAR(); }
            if (IN(13)) {
                PH_ARGS;
                for (int task = vcu; task < 96 * 8; task += G) { const int pnl = 3 * (task & 31) + ((task >> 5) % 3), bq = (task >> 5) / 3;
                    gate_task(lds + RING_OFF, pnl / 6, pnl % 6, 8 * bq, 8, WSP(bf16_t, O_V), WSP(bf16_t, O_U), WSP(float, O_CTL + O_VSUMS), ap->in[14], ap->in[15], WSP(bf16_t, O_WM), ap->in[17], tid, wave, lane); }
                if (BOTH(13)) GRID_BAR();
            }
            if (IN(14)) {
                PH_ARGS;
                pg8::Gemm g{WSP(bf16_t, O_U), WSP(bf16_t, O_W_OUTO), M, DM, GW, GW, GW}; pg8::StaticOrder S; S.init(M, DM, G, bx);
                pg8::EpiResid<false> E{WSP(bf16_t, O_XB1), WSP(bf16_t, O_XB), DM, WSP(float, O_SSQP)};
                pg8::gemm_phase<pg8::EpiResid<false>, pg8::StaticOrder, true, true>(lds + RING_OFF, g, S, E, wave, lane);
                if (BOTH(14)) GRID_BAR();
            }
        }
        const int pb = 7 + 8 * l;
        if (IN(pb + 1)) {
            PH_ARGS;
            pg8::Gemm g{WSP(bf16_t, O_XB), (const bf16_t*)(ws + (l ? O_W_GU1 : O_W_GU0)), M, 2 * FF, DM, DM, DM}; pg8::StaticOrder S; S.init(M, 2 * FF, G, bx);
            pg8::Unit u0; LAS float* tab = (LAS float*)(lds + ROWSC_OFF); int pm0 = -1;
            if (S.next(0, u0)) { pm0 = u0.pm; pg8::build_row_scale(tab, WSP(float, O_SSQP), pm0, tid); }
            LDS_WAIT(); __syncthreads();
            pg8::EpiSwiGLU E{WSP(bf16_t, O_H), FF, pg8::RowScale{tab, pm0}};
            pg8::gemm_phase<pg8::EpiSwiGLU, pg8::StaticOrder, true, true>(lds + RING_OFF, g, S, E, wave, lane);
            if (l == 0) CONV_TAIL((M / 256) * (2 * FF / 256), NIT_T1, NIT_T8); else CONV_TAIL((M / 256) * (2 * FF / 256), NIT_T8, NITEMS);
            if (BOTH(pb + 1)) GRID_BAR();
        }
        if (IN(pb + 2)) {
            PH_ARGS;
            pg8::Gemm g{WSP(bf16_t, O_H), (const bf16_t*)(ws + (l ? O_W_DN1 : O_W_DN0)), M, DM, FF, FF, FF}; pg8::StaticOrder S; S.init(M, DM, G, bx);
            pg8::EpiResid<false> E{WSP(bf16_t, O_XB), WSP(bf16_t, O_XB1), DM, WSP(float, O_SSQP)};
            pg8::gemm_phase<pg8::EpiResid<false>, pg8::StaticOrder, true, true>(lds + RING_OFF, g, S, E, wave, lane);
            if (BOTH(pb + 2)) GRID_BAR();
        }
    }
    if (IN(18)) { PH_ARGS; const bf16_t* XB = WSP(bf16_t, O_XB1); const float* gn = ap->in[23]; float* out = ap->out; const float* pp = WSP(float, O_SSQP);
        for (int m = gw; m < M; m += NGW) { const float r = 1.0f / sqrtf(wave_sum(pp[(size_t)m * 64 + lane]) * (1.0f / DM) + EPS); const u32x2* xr = (const u32x2*)(XB + (size_t)m * DM) + lane; const f32x4* gr = (const f32x4*)gn + lane; f32x4* o = (f32x4*)(out + (size_t)m * DM) + lane;
#pragma unroll 8
            for (int j = 0; j < 16; ++j) { const u32x2 w = xr[64 * j]; o[64 * j] = (f32x4){bflo(w.x), bfhi(w.x), bflo(w.y), bfhi(w.y)} * r * gr[64 * j]; } } }
#undef IN
#undef BOTH
}

extern "C" void kernel_launch(void* const* d_in, const int* in_sizes, int n_in, void* d_out, int out_size, void* d_ws, size_t ws_size, hipStream_t stream) {
    static int grid = 0;
    if (grid == 0) {
        if (n_in != 24 || in_sizes[0] != M * DM || out_size != M * DM || ws_size < WS_END) {
            fprintf(stderr, "kernel_launch: built for 24 inputs, x/out of %d floats, >= %zu bytes of workspace; got n_in %d, in0 %d, out %d, ws %zu; nothing launched\n", M * DM, (size_t)WS_END, n_in, n_in > 0 ? in_sizes[0] : -1, out_size, ws_size);
            grid = -1; return; }
        int dev = 0, cus = 0;
        if (hipGetDevice(&dev) != hipSuccess || hipDeviceGetAttribute(&cus, hipDeviceAttributeMultiprocessorCount, dev) != hipSuccess) { fprintf(stderr, "kernel_launch: device query failed\n"); grid = -1; return; }
        if (hipFuncSetAttribute((const void*)fwd, hipFuncAttributeMaxDynamicSharedMemorySize, LDS_BYTES) != hipSuccess) { fprintf(stderr, "kernel_launch: hipFuncSetAttribute failed\n"); grid = -1; return; }
        int per_cu = 0;
        if (hipOccupancyMaxActiveBlocksPerMultiprocessor(&per_cu, (const void*)fwd, NWAVES * 64, LDS_BYTES) != hipSuccess || per_cu < 1) fprintf(stderr, "kernel_launch: note: occupancy query reports %d\n", per_cu);
        (void)hipGetLastError();
        if (cus != 256) { fprintf(stderr, "kernel_launch: built for a 256-CU device, found %d CUs; nothing launched\n", cus); grid = -1; return; }
        grid = cus;
    }
    if (grid < 0) return;
    (void)hipMemsetAsync((char*)d_ws + O_CTL, 0, CTL_ZERO_BYTES, stream);
    Args a{};
    for (int i = 0; i < 24; ++i) a.in[i] = (const float*)d_in[i];
    a.out = (float*)d_out; a.ws = (unsigned char*)d_ws; a.G = grid; a.pad = 0;
#if MK_ONE_LAUNCH
    a.ph_lo = 0; a.ph_hi = N_PHASES;
    hipLaunchKernelGGL(fwd, dim3(grid), dim3(NWAVES * 64), LDS_BYTES, stream, a);
#else
    for (int p = 0; p < N_PHASES; ++p) { a.ph_lo = p; a.ph_hi = p + 1; hipLaunchKernelGGL(fwd, dim3(grid), dim3(NWAVES * 64), LDS_BYTES, stream, a); }
#endif
}
```

```cpp
#include <hip/hip_runtime.h>
#include <cstdio>
#include <cstdint>

#ifndef MK_ONE_LAUNCH
#define MK_ONE_LAUNCH 1
#endif

#define LAS __attribute__((address_space(3)))
#define GAS __attribute__((address_space(1)))
typedef unsigned short bf16_t;
typedef short bf16x8 __attribute__((ext_vector_type(8)));
typedef short s16x4 __attribute__((ext_vector_type(4)));
typedef float f32x2 __attribute__((ext_vector_type(2)));
typedef float f32x4 __attribute__((ext_vector_type(4)));
typedef float f32x16 __attribute__((ext_vector_type(16)));
typedef unsigned u32x2 __attribute__((ext_vector_type(2)));
typedef unsigned u32x4 __attribute__((ext_vector_type(4)));

constexpr int NB = 2, T = 4096, DM = 4096, M = NB * T;
constexpr int NH = 16, NG = 4, HD = 128;
constexpr int IN_EVEN = 7216, IN_EVEN_P = 7424;
constexpr int FF = 11008, GW = 12288;
constexpr float EPS = 1e-6f;
constexpr size_t KVSZ = (size_t)NB * NG * T * HD;

constexpr size_t O_CTL = 0, CTL_ZERO_BYTES = 64u << 10;
constexpr size_t O_ROPE = 1u << 20;
constexpr size_t O_WM = O_ROPE + (512u << 10);
constexpr size_t O_STATS = O_WM + (512u << 10);
constexpr size_t O_KCMP = O_STATS + (64u << 10);
constexpr size_t O_VCMPT = O_KCMP + (512u << 10);
constexpr size_t O_SEL = O_VCMPT + (512u << 10);
constexpr size_t O_GATES = O_SEL + (256u << 10);
constexpr size_t O_W = 8u << 20;
constexpr size_t O_W_INE = O_W;
constexpr size_t O_W_OUTE = O_W_INE + (size_t)IN_EVEN_P * DM * 2;
constexpr size_t O_W_GU0 = O_W_OUTE + (size_t)DM * DM * 2;
constexpr size_t O_W_DN0 = O_W_GU0 + (size_t)2 * FF * DM * 2;
constexpr size_t O_W_GU1 = O_W_DN0 + (size_t)DM * FF * 2;
constexpr size_t O_W_DN1 = O_W_GU1 + (size_t)2 * FF * DM * 2;
constexpr size_t O_W_INO = O_W_DN1 + (size_t)DM * FF * 2;
constexpr size_t O_W_OUTO = O_W_INO + (size_t)2 * GW * DM * 2;
constexpr size_t O_W_POOL = O_W_OUTO + (size_t)DM * GW * 2;
constexpr size_t O_W_C1K = O_W_POOL + (size_t)4 * 512 * 512 * 2;
constexpr size_t O_W_C1V = O_W_C1K + (size_t)256 * 4096 * 2;
constexpr size_t O_W_C2K = O_W_C1V + (size_t)256 * 4096 * 2;
constexpr size_t O_W_C2V = O_W_C2K + (size_t)128 * 256 * 2;
constexpr size_t O_XB = O_W_C2V + (size_t)128 * 256 * 2;
constexpr size_t O_XB1 = O_XB + (size_t)M * DM * 2;
constexpr size_t O_HN = O_XB + (size_t)M * DM * 4;
constexpr size_t O_A = O_HN + (size_t)M * DM * 2;
constexpr size_t O_QH = O_A;
constexpr size_t O_KV = O_QH + (size_t)M * 2048 * 2;
constexpr size_t O_PIN = O_KV + 6 * KVSZ * 2;
constexpr size_t O_POOLED = O_PIN + (size_t)M * 2048 * 2;
constexpr size_t O_OACC = O_POOLED + (size_t)M * 2048 * 2;
constexpr size_t O_CAT = O_OACC + (size_t)M * 2048 * 4;
constexpr size_t O_A_END_EVEN = O_CAT + (size_t)M * DM * 2;
constexpr size_t O_H = O_A;
constexpr size_t O_U = O_A;
constexpr size_t O_V = O_U + (size_t)M * GW * 2;
constexpr size_t O_A_END_ODD = O_V + (size_t)M * GW * 2;
constexpr size_t O_VPART = O_A_END_ODD > O_A_END_EVEN ? O_A_END_ODD : O_A_END_EVEN;
constexpr size_t O_SSQP = O_VPART + (size_t)M * 192 * 2 * 4;
constexpr size_t WS_END = O_SSQP + (size_t)M * 64 * 4;
static_assert(O_GATES + (size_t)M * 48 * 4 <= O_W, "small buffers fit below the weights");
static_assert((O_W_OUTE % 256) == 0 && (O_W_GU0 % 256) == 0 && (O_W_DN0 % 256) == 0 && (O_W_INO % 256) == 0 && (O_XB % 256) == 0 && (O_A % 256) == 0 && (O_V % 256) == 0, "alignment");

constexpr int CW_TMO = 0, CW_BAR = 4096;
constexpr size_t O_CBIAS = 384u << 10;
constexpr size_t O_SSQ = 448u << 10;
constexpr size_t O_VSUMS = 256u << 10;

constexpr int RING_OFF = 0, RING_BYTES = 131072;
constexpr int LDS_BYTES = 147456;
constexpr int LDSCTL_OFF = LDS_BYTES - 1024, MISC_OFF = LDSCTL_OFF + 320;
constexpr int ROWSC_OFF = LDSCTL_OFF - 2048;
constexpr int NWAVES = 8;

typedef __bf16 bf16x2_t __attribute__((ext_vector_type(2)));
__device__ __forceinline__ unsigned cvt_pk_bf16(float lo, float hi) { f32x2 v = {lo, hi}; bf16x2_t b = __builtin_convertvector(v, bf16x2_t); return __builtin_bit_cast(unsigned, b); }
__device__ __forceinline__ float bf2f(unsigned short b) { return __uint_as_float(((unsigned)b) << 16); }
__device__ __forceinline__ float bflo(unsigned w) { return __uint_as_float(w << 16); }
__device__ __forceinline__ float bfhi(unsigned w) { return __uint_as_float(w & 0xffff0000u); }
__device__ __forceinline__ float sigmoidf_(float x) { return __builtin_amdgcn_rcpf(1.0f + __builtin_amdgcn_exp2f(-1.4426950408889634f * x)); }
__device__ __forceinline__ float gelu_tanh(float x) {
    const float y = 2.0f * 0.7978845608028654f * x * (1.0f + 0.044715f * x * x);
    return x * sigmoidf_(y);
}
__device__ __forceinline__ int lane_id() { unsigned z = 0u; asm volatile("" : "+s"(z)); return (int)__builtin_amdgcn_mbcnt_hi(~0u, __builtin_amdgcn_mbcnt_lo(~0u, z)); }
#define LDS_WAIT() asm volatile("s_waitcnt lgkmcnt(0)" ::: "memory")
#define VM_WAIT() asm volatile("s_waitcnt vmcnt(0)" ::: "memory")

namespace pg8 {
constexpr int BM = 256, BK = 64, HALF = 128, HTB = HALF * BK * 2, STAGE_BYTES = 8 * HTB, NXCD = 8, WGM = 8;
__host__ __device__ __forceinline__ int lds_byte(int r, int c) { const int st = (r >> 4) * 2 + (c >> 5), rr = r & 15, cc = c & 31, ob = rr * 64 + cc * 2; return st * 1024 + (ob ^ (((ob >> 9) & 1) << 5)); }
__host__ __device__ __forceinline__ void stage_rc(int b, int& R, int& C) { const int st = b / 1024, sb = b % 1024, swz = sb ^ (((sb >> 9) & 1) << 5); R = (st >> 1) * 16 + swz / 64; C = (st & 1) * 32 + (swz % 64) / 2; }
__host__ __device__ __forceinline__ int perm32(int rho) { const int n = rho >> 4, i = rho & 15; return 8 * (i >> 2) + 4 * n + (i & 3); }

struct Unit { int pm, pn; };
struct Gemm { const bf16_t* A; const bf16_t* Bt; int M, N, K, lda, ldb; };

struct StaticOrder {
    int nM, nN, nwg, G, c;
    __host__ __device__ __forceinline__ void init(int M_, int N_, int G_, int c_) { nM = M_ / BM; nN = N_ / BM; nwg = nM * nN; G = G_; c = c_; }
    __host__ __device__ __forceinline__ bool next(int i, Unit& u) const {
        const long L = (long)i * G + c; if (L >= nwg) return false;
        int wgid = (int)L; { const int q = nwg / NXCD, r = nwg % NXCD, xcd = wgid % NXCD, off = wgid / NXCD; wgid = (xcd < r ? xcd * (q + 1) : r * (q + 1) + (xcd - r) * q) + off; }
        const int nig = WGM * nN, gid = wgid / nig, fm = gid * WGM, gsz = (nM - fm) < WGM ? (nM - fm) : WGM;
        u.pm = fm + ((wgid % nig) % gsz); u.pn = (wgid % nig) / gsz; return true;
    }
    __device__ __forceinline__ void a_ready(const Unit&) const {}
    __device__ __forceinline__ void done(const Unit&) const {}
};


struct EpiInEven {
    static constexpr bool PERM = true, AFTER_DRAIN = false;
    bf16_t* QH; bf16_t* KV; bf16_t* PIN; float* GATES; const float* ROPE;
    __device__ __forceinline__ void operator()(const f32x4 (&acc)[2][2][4][2], const Unit& u, int wr, int wc, int fr, int fq) const {
        const int pn = u.pn;
#pragma unroll
        for (int ai = 0; ai < 2; ++ai)
#pragma unroll
            for (int m = 0; m < 4; ++m) {
                const int row = u.pm * BM + ai * HALF + wr * 64 + m * 16 + fr, b = row >> 12, t = row & 4095;
#pragma unroll
                for (int bj = 0; bj < 2; ++bj) {
                    f32x4 v0 = acc[ai][bj][m][0], v1 = acc[ai][bj][m][1];
                    if (pn < 20) {
                        const bool is_q = pn < 8; const int which = (pn - 8) >> 1;
                        if (wc == 0 && (is_q || !(which & 1))) {
                            f32x4 p0, p1;
#pragma unroll
                            for (int e = 0; e < 4; ++e) { p0[e] = __shfl_xor(v0[e], 32); p1[e] = __shfl_xor(v1[e], 32); }
                            const float* cp = ROPE + t * 16 + 8 * (fq & 1);
                            const f32x4 c0 = *(const f32x4*)cp, c1 = *(const f32x4*)(cp + 4), s0 = *(const f32x4*)(cp + 65536), s1 = *(const f32x4*)(cp + 65536 + 4);
                            if (fq < 2) { v0 = v0 * c0 - p0 * s0; v1 = v1 * c1 - p1 * s1; } else { v0 = v0 * c0 + p0 * s0; v1 = v1 * c1 + p1 * s1; }
                        }
                        const int d0 = wc * 32 + 8 * fq;
                        bf16_t* dst = is_q ? QH + ((size_t)((b * 16 + 2 * pn + bj) * 4096 + t)) * 128 + d0
                                           : KV + (size_t)which * KVSZ + ((size_t)((b * 4 + ((pn - 8) & 1) * 2 + bj) * 4096 + t)) * 128 + d0;
                        u32x4 w; w.x = cvt_pk_bf16(v0[0], v0[1]); w.y = cvt_pk_bf16(v0[2], v0[3]); w.z = cvt_pk_bf16(v1[0], v1[1]); w.w = cvt_pk_bf16(v1[2], v1[3]);
                        *(u32x4*)dst = w;
                    } else if (pn < 28) {
                        u32x4 w; w.x = cvt_pk_bf16(v0[0], v0[1]); w.y = cvt_pk_bf16(v0[2], v0[3]); w.z = cvt_pk_bf16(v1[0], v1[1]); w.w = cvt_pk_bf16(v1[2], v1[3]);
                        *(u32x4*)(PIN + (size_t)row * 2048 + (pn - 20) * 256 + bj * HALF + wc * 32 + 8 * fq) = w;
                    } else {
                        const int col0 = wc * 32 + 8 * fq;
                        if (bj == 0 && col0 <= 40) {
                            f32x4 g0, g1;
#pragma unroll
                            for (int e = 0; e < 4; ++e) { g0[e] = sigmoidf_(v0[e]); g1[e] = sigmoidf_(v1[e]); }
                            float* gp = GATES + (size_t)row * 48 + col0; *(f32x4*)gp = g0; *(f32x4*)(gp + 4) = g1;
                        }
                    }
                }
            }
    }
};
struct EpiScaleBf16 {
    static constexpr bool PERM = true, AFTER_DRAIN = false;
    bf16_t* O; int ldc; const float* scale;
    __device__ __forceinline__ void operator()(const f32x4 (&acc)[2][2][4][2], const Unit& u, int wr, int wc, int fr, int fq) const {
        const int row0 = u.pm * BM + wr * 64 + fr, col0 = u.pn * BM + wc * 32 + 8 * fq;
#pragma unroll
        for (int bj = 0; bj < 2; ++bj) {
            const f32x4 sc0 = *(const f32x4*)(scale + col0 + bj * HALF), sc1 = *(const f32x4*)(scale + col0 + bj * HALF + 4);
#pragma unroll
            for (int ai = 0; ai < 2; ++ai)
#pragma unroll
                for (int m = 0; m < 4; ++m) { const f32x4 v0 = acc[ai][bj][m][0] * sc0, v1 = acc[ai][bj][m][1] * sc1;
                    u32x4 w; w.x = cvt_pk_bf16(v0[0], v0[1]); w.y = cvt_pk_bf16(v0[2], v0[3]); w.z = cvt_pk_bf16(v1[0], v1[1]); w.w = cvt_pk_bf16(v1[2], v1[3]);
                    *(u32x4*)(O + (size_t)(row0 + ai * HALF + m * 16) * ldc + col0 + bj * HALF) = w; }
        }
    }
};
template <bool BASE_F32> struct EpiResid {
    static constexpr bool PERM = true, AFTER_DRAIN = false;
    const void* base; bf16_t* out; int ldc; float* ssqp;
    __device__ __forceinline__ void operator()(const f32x4 (&acc)[2][2][4][2], const Unit& u, int wr, int wc, int fr, int fq) const {
        const int row0 = u.pm * BM + wr * 64 + fr, col0 = u.pn * BM + wc * 32 + 8 * fq;
#pragma unroll
        for (int ai = 0; ai < 2; ++ai) { f32x4 b0[4][2], b1[4][2];
#pragma unroll
            for (int m = 0; m < 4; ++m) { const size_t off = (size_t)(row0 + ai * HALF + m * 16) * ldc + col0;
#pragma unroll
                for (int bj = 0; bj < 2; ++bj) {
                    if constexpr (BASE_F32) { const float* bp = (const float*)base + off + bj * HALF; b0[m][bj] = *(const f32x4*)bp; b1[m][bj] = *(const f32x4*)(bp + 4); }
                    else { const u32x4 w = *(const u32x4*)((const bf16_t*)base + off + bj * HALF); b0[m][bj] = (f32x4){bflo(w.x), bfhi(w.x), bflo(w.y), bfhi(w.y)}; b1[m][bj] = (f32x4){bflo(w.z), bfhi(w.z), bflo(w.w), bfhi(w.w)}; } } }
#pragma unroll
            for (int m = 0; m < 4; ++m) { const int row = row0 + ai * HALF + m * 16; const size_t off = (size_t)row * ldc + col0; float sq = 0.f;
#pragma unroll
                for (int bj = 0; bj < 2; ++bj) { const f32x4 o0 = b0[m][bj] + acc[ai][bj][m][0], o1 = b1[m][bj] + acc[ai][bj][m][1];
                    sq += ((o0[0] * o0[0] + o0[1] * o0[1]) + (o0[2] * o0[2] + o0[3] * o0[3])) + ((o1[0] * o1[0] + o1[1] * o1[1]) + (o1[2] * o1[2] + o1[3] * o1[3]));
                    u32x4 w; w.x = cvt_pk_bf16(o0[0], o0[1]); w.y = cvt_pk_bf16(o0[2], o0[3]); w.z = cvt_pk_bf16(o1[0], o1[1]); w.w = cvt_pk_bf16(o1[2], o1[3]);
                    *(u32x4*)(out + off + bj * HALF) = w; }
                sq += __shfl_xor(sq, 16); sq += __shfl_xor(sq, 32);
                if (fq == 0) ssqp[(size_t)row * 64 + u.pn * 4 + wc] = sq; }
            asm volatile("" ::: "memory"); }
    }
};
__device__ __forceinline__ float row_rstd_from_partials(const float* ssqp, int row) { const f32x4* p = (const f32x4*)(ssqp + (size_t)row * 64); float t = 0.f;
#pragma unroll
    for (int i = 0; i < 16; ++i) { const f32x4 v = p[i]; t += (v[0] + v[1]) + (v[2] + v[3]); }
    return 1.0f / sqrtf(t * (1.0f / DM) + EPS); }
struct RowScale { const LAS float* tab; int pm0;
    __device__ __forceinline__ float get(int pm, int r_in_panel) const { return pm == pm0 ? tab[r_in_panel] : __builtin_nanf(""); } };
__device__ __forceinline__ void build_row_scale(LAS float* tab, const float* ssqp, int pm, int tid) {
    const int r = tid >> 1, h = tid & 1; const f32x4* p = (const f32x4*)(ssqp + (size_t)(pm * 256 + r) * 64 + 32 * h); float t = 0.f;
#pragma unroll
    for (int i = 0; i < 8; ++i) { const f32x4 v = p[i]; t += (v[0] + v[1]) + (v[2] + v[3]); }
    const float o = __shfl_xor(t, 1); const float tot = h ? (o + t) : (t + o);
    if (h == 0) tab[r] = 1.0f / sqrtf(tot * (1.0f / DM) + EPS); }
struct EpiSwiGLU {
    static constexpr bool PERM = true, AFTER_DRAIN = false;
    bf16_t* H; int ldc; RowScale rsc;
    __device__ __forceinline__ void operator()(const f32x4 (&acc)[2][2][4][2], const Unit& u, int wr, int wc, int fr, int fq) const {
        const int row0 = u.pm * BM + wr * 64 + fr, col0 = u.pn * HALF + wc * 32 + 8 * fq;
        float rs[2][4];
#pragma unroll
        for (int ai = 0; ai < 2; ++ai)
#pragma unroll
            for (int m = 0; m < 4; ++m) rs[ai][m] = rsc.get(u.pm, ai * HALF + wr * 64 + m * 16 + fr);
#pragma unroll
        for (int ai = 0; ai < 2; ++ai)
#pragma unroll
            for (int m = 0; m < 4; ++m) { f32x4 h0, h1; const float r = rs[ai][m];
#pragma unroll
                for (int e = 0; e < 4; ++e) { const float g0 = acc[ai][0][m][0][e] * r, g1 = acc[ai][0][m][1][e] * r;
                    h0[e] = g0 * sigmoidf_(g0) * (acc[ai][1][m][0][e] * r); h1[e] = g1 * sigmoidf_(g1) * (acc[ai][1][m][1][e] * r); }
                u32x4 w; w.x = cvt_pk_bf16(h0[0], h0[1]); w.y = cvt_pk_bf16(h0[2], h0[3]); w.z = cvt_pk_bf16(h1[0], h1[1]); w.w = cvt_pk_bf16(h1[2], h1[3]);
                *(u32x4*)(H + (size_t)(row0 + ai * HALF + m * 16) * ldc + col0) = w; }
    }
};
struct EpiGeluSplit {
    static constexpr bool PERM = true, AFTER_DRAIN = false;
    bf16_t* O0; bf16_t* O1; int ldc; int split; float* part; RowScale rsc;
    __device__ __forceinline__ void operator()(const f32x4 (&acc)[2][2][4][2], const Unit& u, int wr, int wc, int fr, int fq) const {
        const int row0 = u.pm * BM + wr * 64 + fr; int colt = u.pn * BM; bf16_t* base = O0;
        const bool is_v = colt >= split;
        if (is_v) { base = O1; colt -= split; }
        const int col0 = colt + wc * 32 + 8 * fq;
#pragma unroll
        for (int ai = 0; ai < 2; ++ai)
#pragma unroll
            for (int m = 0; m < 4; ++m) { float s1 = 0.f, s2 = 0.f; const float r = rsc.get(u.pm, ai * HALF + wr * 64 + m * 16 + fr);
#pragma unroll
                for (int bj = 0; bj < 2; ++bj) { f32x4 v0, v1;
#pragma unroll
                    for (int e = 0; e < 4; ++e) { v0[e] = gelu_tanh(acc[ai][bj][m][0][e] * r); v1[e] = gelu_tanh(acc[ai][bj][m][1][e] * r); }
                    u32x4 w; w.x = cvt_pk_bf16(v0[0], v0[1]); w.y = cvt_pk_bf16(v0[2], v0[3]); w.z = cvt_pk_bf16(v1[0], v1[1]); w.w = cvt_pk_bf16(v1[2], v1[3]);
                    *(u32x4*)(base + (size_t)(row0 + ai * HALF + m * 16) * ldc + col0 + bj * HALF) = w;
                    if (is_v) {
                        const float r0 = bflo(w.x), r1 = bfhi(w.x), r2 = bflo(w.y), r3 = bfhi(w.y), r4 = bflo(w.z), r5 = bfhi(w.z), r6 = bflo(w.w), r7 = bfhi(w.w);
                        s1 += ((r0 + r1) + (r2 + r3)) + ((r4 + r5) + (r6 + r7)); s2 += ((r0 * r0 + r1 * r1) + (r2 * r2 + r3 * r3)) + ((r4 * r4 + r5 * r5) + (r6 * r6 + r7 * r7)); } }
                if (is_v) {
                    s1 += __shfl_xor(s1, 16); s1 += __shfl_xor(s1, 32); s2 += __shfl_xor(s2, 16); s2 += __shfl_xor(s2, 32);
                    if (fq == 0) { float* sp = part + ((size_t)(row0 + ai * HALF + m * 16) * 192 + (size_t)(u.pn - split / BM) * 4 + wc) * 2; *(f32x2*)sp = (f32x2){s1, s2}; } } }
    }
};

template <class Epi, class Sched, bool ALIGN_EPI = false, bool SP2 = false>
__device__ __forceinline__ void gemm_phase(LAS unsigned char* lds, const Gemm g, const Sched& S, const Epi& E, int wid, int lane) {
    const int tid = wid * 64 + lane, wr = wid >> 2, wc = wid & 3, fr = lane & 15, fq = lane >> 4;
    const int K = g.K, nt = K / BK;
    unsigned voffA[2], voffB[2];
#pragma unroll
    for (int i = 0; i < 2; ++i) { int R, C; stage_rc(tid * 16 + i * 8192, R, C); const int Rb = Epi::PERM ? ((R & ~31) + perm32(R & 31)) : R;
        voffA[i] = (unsigned)(R * g.lda + C) * 2u; voffB[i] = (unsigned)(Rb * g.ldb + C) * 2u; }
    const size_t kstep = (size_t)(BK * 2);
    const size_t hsA = (size_t)HALF * g.lda * 2, hsB = (size_t)HALF * g.ldb * 2;
    const size_t tsA = 2 * hsA, tsB = 2 * hsB;
    const unsigned ldsw = (unsigned)wid * 1024u;
    const int aoff = lds_byte(wr * 64 + fr, fq * 8), boff = lds_byte(wc * 32 + fr, fq * 8);
#define PG8_SA(b, h) (((b) * 2 + (h)) * HTB)
#define PG8_SB(b, h) ((4 + (b) * 2 + (h)) * HTB)
#define PG8_STAGE(bufoff, gbase, voff) do { _Pragma("unroll") for (int _i = 0; _i < 2; ++_i) \
        __builtin_amdgcn_global_load_lds((const unsigned*)((const char*)(gbase) + (voff)[_i]), (LAS unsigned*)(lds + (bufoff) + ldsw + _i * 8192), 16, 0, 0); } while (0)
#define PG8_LDA(dst, b, h) do { _Pragma("unroll") for (int m = 0; m < 4; ++m) _Pragma("unroll") for (int k = 0; k < 2; ++k) dst[m][k] = *(const LAS bf16x8*)(lds + PG8_SA(b, h) + aoff + m * 2048 + k * 1024); } while (0)
#define PG8_LDB(dst, b, h) do { _Pragma("unroll") for (int n = 0; n < 2; ++n) _Pragma("unroll") for (int k = 0; k < 2; ++k) dst[n][k] = *(const LAS bf16x8*)(lds + PG8_SB(b, h) + boff + n * 2048 + k * 1024); } while (0)
#define PG8_MMA(ai, bj, At, Bt) do { __builtin_amdgcn_s_setprio(1); _Pragma("unroll") for (int m = 0; m < 4; ++m) _Pragma("unroll") for (int n = 0; n < 2; ++n) _Pragma("unroll") for (int k = 0; k < 2; ++k) \
        acc[ai][bj][m][n] = __builtin_amdgcn_mfma_f32_16x16x32_bf16(Bt[n][k], At[m][k], acc[ai][bj][m][n], 0, 0, 0); __builtin_amdgcn_s_setprio(0); } while (0)
#define PG8_WAIT_V(n) asm volatile("s_waitcnt vmcnt(" #n ")" ::: "memory")
#define PG8_WAIT_L(n) asm volatile("s_waitcnt lgkmcnt(" #n ")" ::: "memory")
#define PG8_BAR __builtin_amdgcn_s_barrier()
#define PG8_SCHED __builtin_amdgcn_sched_barrier(0)
    Unit cur, nxt; int ui = 0;
    if (!S.next(0, cur)) return;
    f32x4 acc[2][2][4][2];
#pragma unroll
    for (int a = 0; a < 2; ++a)
#pragma unroll
        for (int b = 0; b < 2; ++b)
#pragma unroll
            for (int m = 0; m < 4; ++m)
#pragma unroll
                for (int n = 0; n < 2; ++n) acc[a][b][m][n] = (f32x4){0.f, 0.f, 0.f, 0.f};
    bf16x8 At[4][2], B0[2][2], B1[2][2];
    const char* cA = (const char*)g.A + (size_t)cur.pm * tsA; const char* cB = (const char*)g.Bt + (size_t)cur.pn * tsB;
    S.a_ready(cur);
    if constexpr (SP2) {
        PG8_STAGE(PG8_SB(0, 0), cB, voffB); PG8_STAGE(PG8_SB(0, 1), cB + hsB, voffB); PG8_STAGE(PG8_SA(0, 0), cA, voffA); PG8_STAGE(PG8_SA(0, 1), cA + hsA, voffA);
        if (wr == 1) PG8_BAR;
        PG8_WAIT_V(2); PG8_BAR;
        PG8_STAGE(PG8_SB(1, 0), cB + kstep, voffB); PG8_STAGE(PG8_SA(1, 0), cA + kstep, voffA); PG8_STAGE(PG8_SB(1, 1), cB + hsB + kstep, voffB);
        PG8_WAIT_V(6); PG8_BAR;
    } else {
        PG8_STAGE(PG8_SB(0, 0), cB, voffB); PG8_STAGE(PG8_SA(0, 0), cA, voffA); PG8_STAGE(PG8_SB(0, 1), cB + hsB, voffB); PG8_STAGE(PG8_SA(0, 1), cA + hsA, voffA);
        if (wr == 1) PG8_BAR;
        PG8_WAIT_V(4); PG8_BAR;
        PG8_STAGE(PG8_SB(1, 0), cB + kstep, voffB); PG8_STAGE(PG8_SA(1, 0), cA + kstep, voffA); PG8_STAGE(PG8_SB(1, 1), cB + hsB + kstep, voffB);
        PG8_WAIT_V(6); PG8_BAR;
    }
    for (;;) {
        const bool has_next = S.next(ui + 1, nxt);
        const char* nA = has_next ? (const char*)g.A + (size_t)nxt.pm * tsA : cA; const char* nB = has_next ? (const char*)g.Bt + (size_t)nxt.pn * tsB : cB;
        for (int t = 0; t < nt; t += 2) {
            const bool last = (t == nt - 2);
            const char* a1 = cA + (size_t)(t + 1) * kstep;
            const char* a2 = last ? nA : cA + (size_t)(t + 2) * kstep; const char* b2 = last ? nB : cB + (size_t)(t + 2) * kstep;
            const char* a3 = a2 + kstep; const char* b3 = b2 + kstep;
            if (last && has_next) S.a_ready(nxt);
            if constexpr (SP2) {
            PG8_LDB(B0, 0, 0); PG8_LDB(B1, 0, 1); PG8_SCHED; PG8_LDA(At, 0, 0); PG8_STAGE(PG8_SA(1, 1), a1 + hsA, voffA);
            PG8_WAIT_V(8); PG8_WAIT_L(0); PG8_BAR; PG8_MMA(0, 0, At, B0); PG8_MMA(0, 1, At, B1); PG8_BAR; PG8_SCHED;
            PG8_LDA(At, 0, 1); PG8_STAGE(PG8_SB(0, 0), b2, voffB); PG8_STAGE(PG8_SB(0, 1), b2 + hsB, voffB); PG8_STAGE(PG8_SA(0, 0), a2, voffA);
            PG8_WAIT_V(8); PG8_WAIT_L(0); PG8_BAR; PG8_MMA(1, 0, At, B0); PG8_MMA(1, 1, At, B1); PG8_BAR; PG8_SCHED;
            PG8_LDB(B0, 1, 0); PG8_LDB(B1, 1, 1); PG8_SCHED; PG8_LDA(At, 1, 0); PG8_STAGE(PG8_SA(0, 1), a2 + hsA, voffA);
            PG8_WAIT_V(8); PG8_WAIT_L(0); PG8_BAR; PG8_MMA(0, 0, At, B0); PG8_MMA(0, 1, At, B1); PG8_BAR; PG8_SCHED;
            PG8_LDA(At, 1, 1); PG8_STAGE(PG8_SB(1, 0), b3, voffB); PG8_STAGE(PG8_SB(1, 1), b3 + hsB, voffB); PG8_STAGE(PG8_SA(1, 0), a3, voffA);
            PG8_WAIT_V(8); PG8_WAIT_L(0); PG8_BAR; PG8_MMA(1, 0, At, B0); PG8_MMA(1, 1, At, B1); PG8_BAR; PG8_SCHED;
            } else {
            PG8_LDB(B0, 0, 0); PG8_SCHED; PG8_LDA(At, 0, 0); PG8_STAGE(PG8_SA(1, 1), a1 + hsA, voffA);
            PG8_WAIT_L(8); PG8_BAR; PG8_WAIT_L(0); PG8_MMA(0, 0, At, B0); PG8_BAR; PG8_SCHED;
            PG8_LDB(B1, 0, 1); PG8_STAGE(PG8_SB(0, 0), b2, voffB);
            PG8_BAR; PG8_WAIT_L(0); PG8_MMA(0, 1, At, B1); PG8_BAR;
            PG8_LDA(At, 0, 1); PG8_STAGE(PG8_SA(0, 0), a2, voffA);
            PG8_BAR; PG8_WAIT_L(0); PG8_MMA(1, 0, At, B0); PG8_BAR; PG8_SCHED;
            PG8_STAGE(PG8_SB(0, 1), b2 + hsB, voffB);
            PG8_WAIT_V(6); PG8_BAR; PG8_MMA(1, 1, At, B1); PG8_BAR;
            PG8_LDB(B0, 1, 0); PG8_SCHED; PG8_LDA(At, 1, 0); PG8_STAGE(PG8_SA(0, 1), a2 + hsA, voffA);
            PG8_WAIT_L(8); PG8_BAR; PG8_WAIT_L(0); PG8_MMA(0, 0, At, B0); PG8_BAR; PG8_SCHED;
            PG8_LDB(B1, 1, 1); PG8_STAGE(PG8_SB(1, 0), b3, voffB);
            PG8_BAR; PG8_WAIT_L(0); PG8_MMA(0, 1, At, B1); PG8_BAR;
            PG8_LDA(At, 1, 1); PG8_STAGE(PG8_SA(1, 0), a3, voffA);
            PG8_BAR; PG8_WAIT_L(0); PG8_MMA(1, 0, At, B0); PG8_BAR; PG8_SCHED;
            PG8_STAGE(PG8_SB(1, 1), b3 + hsB, voffB);
            PG8_WAIT_V(6); PG8_BAR; PG8_MMA(1, 1, At, B1); PG8_BAR;
            }
        }
        if constexpr (ALIGN_EPI) { if (wr == 0) PG8_BAR; }
        if constexpr (!Epi::AFTER_DRAIN) { E(acc, cur, wr, wc, fr, fq); S.done(cur); }
        if (!has_next) break;
#pragma unroll
        for (int a = 0; a < 2; ++a)
#pragma unroll
            for (int b = 0; b < 2; ++b)
#pragma unroll
                for (int m = 0; m < 4; ++m)
#pragma unroll
                    for (int n = 0; n < 2; ++n) acc[a][b][m][n] = (f32x4){0.f, 0.f, 0.f, 0.f};
        cur = nxt; cA = nA; cB = nB; ++ui;
        if constexpr (ALIGN_EPI) { if (wr == 1) PG8_BAR; }
    }
    PG8_WAIT_V(0);
    if constexpr (!ALIGN_EPI) { if (wr == 0) PG8_BAR; }
    PG8_BAR;
#undef PG8_SA
#undef PG8_SB
#undef PG8_STAGE
#undef PG8_LDA
#undef PG8_LDB
#undef PG8_MMA
#undef PG8_WAIT_V
#undef PG8_WAIT_L
#undef PG8_BAR
#undef PG8_SCHED
}
}

namespace swa {
constexpr int D = 128;
constexpr float SCALE = 0.08838834764831845f;
constexpr float THR = 8.f;
constexpr int NW = 8, QBLK = 32, KVBLK = 64, QB = NW * QBLK;
constexpr int SHM_V = KVBLK * D * 2, SHM_K = KVBLK * D * 2;
constexpr int LDS_BYTES_ATT = 2 * SHM_V + 2 * SHM_K + NW * 64 * 4;
#define KSWZ(row, colB) ((row) * 256 + ((colB) ^ (((row) & 7) << 4)))
#define SBAR() __builtin_amdgcn_sched_barrier(0)
__device__ __forceinline__ int v_st(int k, int c) { const int kk = (k & ~0xC) | ((k & 4) << 1) | ((k & 8) >> 1); return ((kk >> 3) * 4 + (c >> 5)) * 512 + ((kk & 7) * 32 + (c & 31)) * 2; }
__device__ __forceinline__ int v_rd_base(int lane) { return ((lane & 3) << 3) | (((lane >> 2) & 3) << 6) | (((lane >> 4) & 1) << 5) | (((lane >> 5) & 1) << 8); }
constexpr int v_rd_off(int d0, int ks, int half) { return d0 * 512 + ks * 4096 + half * 2048; }
__device__ __forceinline__ int crow(int r, int hi) { return (r & 3) + 8 * (r >> 2) + 4 * hi; }
__device__ __forceinline__ bf16x8 load8(const bf16_t* p) { return *reinterpret_cast<const bf16x8*>(p); }
__device__ __forceinline__ void mask_tile(f32x16& p0, f32x16& p1, int dq, unsigned W) {
    const float NEG = -__builtin_inff();
#pragma unroll
    for (int r = 0; r < 16; ++r) {
        const int c = (r & 3) + 8 * (r >> 2);
        if ((unsigned)(dq - c) >= W) p0[r] = NEG;
        if ((unsigned)(dq - c - 32) >= W) p1[r] = NEG;
    }
}
__device__ __forceinline__ void partialSM(f32x16& p0, f32x16& p1, float& m_reg, float& mn, float& alpha) {
    float pmax = p0[0];
#pragma unroll
    for (int r = 1; r < 16; ++r) pmax = fmaxf(pmax, p0[r]);
#pragma unroll
    for (int r = 0; r < 16; ++r) pmax = fmaxf(pmax, p1[r]);
    { auto rr = __builtin_amdgcn_permlane32_swap(__float_as_uint(pmax), __float_as_uint(pmax), false, false);
      pmax = fmaxf(__uint_as_float(rr[0]), __uint_as_float(rr[1])); }
    constexpr float C2 = 1.4426950408889634f * SCALE;
    if (__builtin_expect(__all((pmax - m_reg) * SCALE <= THR), 1)) { mn = m_reg; alpha = 1.f; }
    else { mn = fmaxf(m_reg, pmax); alpha = __builtin_amdgcn_exp2f((m_reg - mn) * C2); m_reg = mn; }
    const float mnL = -mn * C2;
#pragma unroll
    for (int r = 0; r < 16; ++r) p0[r] = fmaf(p0[r], C2, mnL);
#pragma unroll
    for (int r = 0; r < 16; ++r) p1[r] = fmaf(p1[r], C2, mnL);
#pragma unroll
    for (int r = 0; r < 16; ++r) p0[r] = __builtin_amdgcn_exp2f(p0[r]);
}
__device__ __forceinline__ void finishSM(f32x16& p0, f32x16& p1, float alpha, float& l_reg, bf16x8& pa0, bf16x8& pa1, bf16x8& pa2, bf16x8& pa3) {
#pragma unroll
    for (int r = 0; r < 16; ++r) p1[r] = __builtin_amdgcn_exp2f(p1[r]);
    float ps = 0;
#pragma unroll
    for (int r = 0; r < 16; ++r) ps += p0[r];
#pragma unroll
    for (int r = 0; r < 16; ++r) ps += p1[r];
    { auto rr = __builtin_amdgcn_permlane32_swap(__float_as_uint(ps), __float_as_uint(ps), false, false);
      ps = __uint_as_float(rr[0]) + __uint_as_float(rr[1]); }
    l_reg = l_reg * alpha + ps;
#define PK4(P, B_, OUT) do { unsigned a0 = cvt_pk_bf16(P[B_+0], P[B_+1]), a1 = cvt_pk_bf16(P[B_+2], P[B_+3]);                          \
        unsigned b0 = cvt_pk_bf16(P[B_+4], P[B_+5]), b1 = cvt_pk_bf16(P[B_+6], P[B_+7]);                                             \
        auto r0 = __builtin_amdgcn_permlane32_swap(a0, b0, false, false); auto r1 = __builtin_amdgcn_permlane32_swap(a1, b1, false, false); \
        u32x4 w = {r0[0], r1[0], r0[1], r1[1]}; OUT = *reinterpret_cast<bf16x8*>(&w); } while (0)
    PK4(p0, 0, pa0); PK4(p0, 8, pa1); PK4(p1, 0, pa2); PK4(p1, 8, pa3);
#undef PK4
}
template <int KB, bool SK>
__device__ __forceinline__ void qkt(f32x16& p0, f32x16& p1, const char* K_lds, int r32, int hi, const bf16x8* qr, bool act) {
    if (SK && !act) { const float NEG = -__builtin_inff();
#pragma unroll
        for (int r = 0; r < 16; ++r) { p0[r] = NEG; p1[r] = NEG; } return; }
    p0 = f32x16{}; p1 = f32x16{};
    const char* kb[4];
#pragma unroll
    for (int dd = 0; dd < 4; ++dd) kb[dd] = K_lds + KB * SHM_K + KSWZ(r32, (dd * 16 + hi * 8) * 2);
#pragma unroll
    for (int d0 = 0; d0 < 8; ++d0) { const char* a = kb[d0 & 3] + (d0 >> 2) * 128;
        bf16x8 b0 = *reinterpret_cast<const bf16x8*>(a);
        bf16x8 b1 = *reinterpret_cast<const bf16x8*>(a + 32 * 256);
        p0 = __builtin_amdgcn_mfma_f32_32x32x16_bf16(b0, qr[d0], p0, 0, 0, 0);
        p1 = __builtin_amdgcn_mfma_f32_32x32x16_bf16(b1, qr[d0], p1, 0, 0, 0); }
}
template <int VB, bool SK>
__device__ __forceinline__ void pv_tile(f32x16* o, int vb0, bf16x8 pa0, bf16x8 pa1, bf16x8 pa2, bf16x8 pa3, bool act) {
    if (SK && !act) return;
#define TRRD(dst, off) asm volatile("ds_read_b64_tr_b16 %0, %1 offset:%2" : "=&v"(dst) : "v"(vb0), "i"(off) : "memory")
#define PV_D0(d0) do { s16x4 l0, l1, l2, l3, h0, h1, h2, h3; constexpr int b_ = VB * SHM_V + v_rd_off(d0, 0, 0); \
        TRRD(l0, b_); TRRD(h0, b_ + 2048); TRRD(l1, b_ + 4096); TRRD(h1, b_ + 6144); TRRD(l2, b_ + 8192); TRRD(h2, b_ + 10240); TRRD(l3, b_ + 12288); TRRD(h3, b_ + 14336); \
        asm volatile("s_waitcnt lgkmcnt(0)" ::: "memory"); SBAR();   \
        o[d0] = __builtin_amdgcn_mfma_f32_32x32x16_bf16(pa0, (bf16x8){l0[0], l0[1], l0[2], l0[3], h0[0], h0[1], h0[2], h0[3]}, o[d0], 0, 0, 0);   \
        o[d0] = __builtin_amdgcn_mfma_f32_32x32x16_bf16(pa1, (bf16x8){l1[0], l1[1], l1[2], l1[3], h1[0], h1[1], h1[2], h1[3]}, o[d0], 0, 0, 0);   \
        o[d0] = __builtin_amdgcn_mfma_f32_32x32x16_bf16(pa2, (bf16x8){l2[0], l2[1], l2[2], l2[3], h2[0], h2[1], h2[2], h2[3]}, o[d0], 0, 0, 0);   \
        o[d0] = __builtin_amdgcn_mfma_f32_32x32x16_bf16(pa3, (bf16x8){l3[0], l3[1], l3[2], l3[3], h3[0], h3[1], h3[2], h3[3]}, o[d0], 0, 0, 0); } while (0)
    PV_D0(0); PV_D0(1); PV_D0(2); PV_D0(3);
#undef PV_D0
#undef TRRD
}
struct BlockRef { const bf16_t* Q; const bf16_t* K; const bf16_t* V; int P0; int b, h; };
struct Seam { bf16x8 qr[8]; bf16x8 st_v0, st_v1, st_k0, st_k1; };
struct Ctx { float* OACC; bf16_t* CAT; const float* GATES; const unsigned long long* SEL; };
__device__ __forceinline__ int swa_jlo(int P0, int W) { const int lowk = P0 - W + 1; return lowk > 0 ? lowk / KVBLK : 0; }
#define ROWU(p, k0, h) ((p) + (size_t)((k0) + 32 * (h)) * D + loff)
#define VMW() asm volatile("s_waitcnt vmcnt(0)" ::: "memory")
#define VMWN(n) asm volatile("s_waitcnt vmcnt(%0)" :: "i"(n) : "memory")
#define SLOAD_H(Kp, Vp, k0) do { S.st_v0 = load8(ROWU(Vp, k0, 0)); S.st_v1 = load8(ROWU(Vp, k0, 1));              \
                         S.st_k0 = load8(ROWU(Kp, k0, 0)); S.st_k1 = load8(ROWU(Kp, k0, 1)); } while (0)
#define SWRITE_HK(bf) do { *(bf16x8*)(K_lds + (bf) * SHM_K + kws) = S.st_k0; *(bf16x8*)(K_lds + (bf) * SHM_K + kws + 32 * 256) = S.st_k1; } while (0)
#define SWRITE_HV(bf) do { *(bf16x8*)(V_lds + (bf) * SHM_V + vst0) = S.st_v0; *(bf16x8*)(V_lds + (bf) * SHM_V + vst1) = S.st_v1; } while (0)
#define SWRITE_H(bf) do { SWRITE_HV(bf); SWRITE_HK(bf); } while (0)
__device__ __forceinline__ void swa_prime(const BlockRef& cur, int W, char* lds, Seam& S, int wid, int lane) {
    const int tid = wid * 64 + lane, r32 = lane & 31, hi = lane >> 5;
    const int sr = tid >> 4, sc = (tid & 15) * 8, kws = KSWZ(sr, sc * 2); char* K_lds = lds + 2 * SHM_V;
    const unsigned loff = (unsigned)(sr * D + sc), qoff = (unsigned)(r32 * D + hi * 8);
    const int kb0 = swa_jlo(cur.P0, W) * KVBLK;
#pragma unroll
    for (int d0 = 0; d0 < 8; ++d0) S.qr[d0] = load8(cur.Q + (size_t)(wid * QBLK) * D + d0 * 16 + qoff);
    SLOAD_H(cur.K, cur.V, kb0); VMW(); SWRITE_HK(0);
    __syncthreads();
}
template <int MODE, bool SK>
__device__ __forceinline__ void swa_block(const BlockRef& cur, const BlockRef& nxt, int W, int Wn, char* lds, Seam& S, const Ctx& X, int wid, int lane) {
    constexpr int skv = 4096;
    const int tid = wid * 64 + lane, r32 = lane & 31, hi = lane >> 5;
    const int j_lo = swa_jlo(cur.P0, W);
    int j_hi = (cur.P0 + QB - 1) / KVBLK + 1; if (j_hi > skv / KVBLK) j_hi = skv / KVBLK;
    const int NT = j_hi - j_lo;
    const int kbn = swa_jlo(nxt.P0, Wn) * KVBLK;
    const int qlo = cur.P0 + wid * QBLK, qm = qlo + r32 - 4 * hi;
    char* V_lds = lds; char* K_lds = lds + 2 * SHM_V;
    float* ws = (float*)(lds + 2 * SHM_V + 2 * SHM_K) + wid * 64; float* li_l = ws, * al_l = ws + 32;
    float m_reg = -1e30f, l_reg = 0; f32x16 o[4] = {};
    const int sr = tid >> 4, sc = (tid & 15) * 8, vst0 = v_st(sr, sc), vst1 = v_st(32 + sr, sc), kws = KSWZ(sr, sc * 2);
    const unsigned loff = (unsigned)(sr * D + sc), qoff = (unsigned)(r32 * D + hi * 8);
    const int vb0 = (int)(uintptr_t)V_lds + v_rd_base(lane);
    const bf16_t* Kh = cur.K; const bf16_t* Vh = cur.V;
    unsigned long long sel_ = ~0ull;
    if constexpr (MODE == 1) sel_ = X.SEL[(size_t)(cur.b * NG + (cur.h >> 2)) * T + qlo + r32];
#define RESC(a) do { if (__any((a) < 1.f)) { if (hi == 0) al_l[r32] = (a); asm volatile("s_waitcnt lgkmcnt(0)" ::: "memory");              \
                     for (int d_ = 0; d_ < 4; ++d_) for (int r = 0; r < 16; ++r) o[d_][r] *= al_l[crow(r, hi)]; } } while (0)
#define KBASE(t) ((j_lo + (t)) * KVBLK)
#define ACT(t) (KBASE(t) <= qlo + QBLK - 1 && KBASE(t) + KVBLK - 1 >= qlo - W + 1)
#define MASKT(P0_, P1_, t) do { const int kb_ = KBASE(t); if ((!SK || ACT(t)) && (kb_ + KVBLK - 1 > qlo || kb_ <= qlo + QBLK - 1 - W)) mask_tile(P0_, P1_, qm - kb_, (unsigned)W); \
        if constexpr (MODE == 1) { if (!((sel_ >> (j_lo + (t))) & 1ull)) { const float NEG_ = -__builtin_inff(); _Pragma("unroll") for (int r_ = 0; r_ < 16; ++r_) { P0_[r_] = NEG_; P1_[r_] = NEG_; } } } } while (0)
    constexpr int NQL = 8;
#define SEAM_K0() do { VMWN(NQL); SWRITE_HK(0); SBAR(); } while (0)
    f32x16 pA0, pA1, pB0, pB1; float mnA, mnB, alA, alB; bf16x8 pa0, pa1, pa2, pa3;
    SWRITE_HV(0); SBAR();
    if (NT > 1) { SLOAD_H(Kh, Vh, KBASE(1)); }
    SBAR(); qkt<0, SK>(pA0, pA1, K_lds, r32, hi, S.qr, ACT(0));
    MASKT(pA0, pA1, 0); partialSM(pA0, pA1, m_reg, mnA, alA);
    if (NT > 1) { VMW(); SWRITE_H(1); }
    __syncthreads();
#define HALF_STEP(PX0, PX1, mnX, alX, PY0, PY1, alY, t, KB, VB, SB) do {                                                      \
        SBAR(); qkt<KB, SK>(PX0, PX1, K_lds, r32, hi, S.qr, ACT(t));                                             \
        finishSM(PY0, PY1, alY, l_reg, pa0, pa1, pa2, pa3); SBAR();                                                           \
        if ((t) + 1 < NT) { SLOAD_H(Kh, Vh, KBASE((t) + 1)); SBAR(); }                                               \
        pv_tile<VB, SK>(o, vb0, pa0, pa1, pa2, pa3, ACT((t) - 1)); MASKT(PX0, PX1, (t)); partialSM(PX0, PX1, m_reg, mnX, alX);                                        \
        __syncthreads();                                                                                                      \
        if ((t) + 1 < NT) { VMW(); SWRITE_H(SB); }                                                                          \
        RESC(alX); __syncthreads(); } while (0)
    for (int t = 1; t + 1 < NT; t += 2) {
        HALF_STEP(pB0, pB1, mnB, alB, pA0, pA1, alA, t, 1, 0, 0);
        HALF_STEP(pA0, pA1, mnA, alA, pB0, pB1, alB, t + 1, 0, 1, 1);
    }
    const bool even = (NT & 1) == 0;
    if (even) { SBAR(); qkt<1, SK>(pB0, pB1, K_lds, r32, hi, S.qr, ACT(NT - 1)); SBAR(); }
    SLOAD_H(nxt.K, nxt.V, kbn); SBAR();
#pragma unroll
    for (int d0 = 0; d0 < 8; ++d0) S.qr[d0] = load8(nxt.Q + (size_t)(wid * QBLK) * D + d0 * 16 + qoff);
    SBAR();
    finishSM(pA0, pA1, alA, l_reg, pa0, pa1, pa2, pa3); SBAR();
    pv_tile<0, SK>(o, vb0, pa0, pa1, pa2, pa3, ACT(even ? NT - 2 : NT - 1));
    if (even) { MASKT(pB0, pB1, NT - 1); partialSM(pB0, pB1, m_reg, mnB, alB); __syncthreads(); RESC(alB);
        finishSM(pB0, pB1, alB, l_reg, pa0, pa1, pa2, pa3); SBAR(); pv_tile<1, SK>(o, vb0, pa0, pa1, pa2, pa3, ACT(NT - 1)); }
    SBAR(); SEAM_K0();
    if (hi == 0) li_l[r32] = __builtin_amdgcn_rcpf(l_reg) * X.GATES[(size_t)(cur.b * T + qlo + r32) * 48 + 3 * cur.h + (MODE == 1 ? 1 : 2)];
    asm volatile("s_waitcnt lgkmcnt(0)" ::: "memory");
    float rli[16];
#pragma unroll
    for (int r = 0; r < 16; ++r) rli[r] = li_l[crow(r, hi)];
    int hie = hi; asm volatile("" : "+v"(hie));
    const unsigned eo = (unsigned)(4 * hie * D + r32), ec = (unsigned)(4 * hie * DM + r32);
    float* Ob = X.OACC + ((size_t)(cur.b * NH + cur.h) * T + qlo) * D;
    bf16_t* Cb = X.CAT + (size_t)(cur.b * T + qlo) * DM + cur.h * HD;
#pragma unroll
    for (int r = 0; r < 16; ++r) { const int cr = (r & 3) + 8 * (r >> 2);
        float* op = Ob + (size_t)cr * D + eo;
        float ov[4];
#pragma unroll
        for (int d0 = 0; d0 < 4; ++d0) ov[d0] = op[d0 * 32];
#pragma unroll
        for (int d0 = 0; d0 < 4; ++d0) { const float v = ov[d0] + o[d0][r] * rli[r];
            if constexpr (MODE == 1) { op[d0 * 32] = v; }
            else { const float vn = __shfl_xor(v, 1);
                   if ((r32 & 1) == 0) *(unsigned*)(Cb + (size_t)cr * DM + d0 * 32 + ec) = cvt_pk_bf16(v, vn); } }
        asm volatile("" ::: "memory"); }
    __syncthreads();
#undef RESC
#undef KBASE
#undef ACT
#undef MASKT
#undef SEAM_K0
#undef HALF_STEP
}
#undef ROWU
#undef VMW
#undef VMWN
#undef SLOAD_H
#undef SWRITE_HK
#undef SWRITE_HV
#undef SWRITE_H

__host__ __device__ inline int swa_nramp(int nqb, int W) { const int t = W - 1; const int n = t < 0 ? 0 : t / QB + 1; return n > nqb ? nqb : n; }
struct SwaItem { int bh, qb0, qb1; };
__device__ __forceinline__ SwaItem swa_decode(int L, int nqb, int nx, int nramp) {
    SwaItem it; const int xcd = L & 7, k = L >> 3; it.bh = xcd * 4 + k / nx; const int x = k % nx;
    const int ns = nqb - nramp;
    if (x < ns) { it.qb0 = it.qb1 = nqb - 1 - x; } else { it.qb0 = x - ns; it.qb1 = nramp - 1 - it.qb0; }
    return it;
}
template <int MODE>
__device__ __forceinline__ BlockRef swa_ref(const SwaItem& it, int pass, const bf16_t* Q, const bf16_t* K, const bf16_t* V) {
    const int qb = pass ? it.qb1 : it.qb0, kvh = it.bh >> 2;
    BlockRef r; r.Q = Q + ((size_t)it.bh * T + (size_t)qb * QB) * D; r.K = K + (size_t)kvh * T * D; r.V = V + (size_t)kvh * T * D; r.P0 = qb * QB; r.b = it.bh >> 4; r.h = it.bh & 15;
    return r;
}
template <int MODE, bool SK>
__device__ __forceinline__ void swa_phase(char* lds, const bf16_t* Q, const bf16_t* K, const bf16_t* V, const Ctx& X, int W, int Wdeal, int c, int G, int wid, int lane) {
    constexpr int nqb = T / QB;
    const int nramp = swa_nramp(nqb, Wdeal),
               nx = (nramp + 1) / 2 + (nqb - nramp), total = nx * NB * NH;
    int L = c; if (L >= total) return;
    SwaItem it = swa_decode(L, nqb, nx, nramp); int pass = 0;
    BlockRef cur = swa_ref<MODE>(it, 0, Q, K, V);
    Seam S;
    swa_prime(cur, W, lds, S, wid, lane);
    for (;;) {
        const bool more_pass = pass == 0 && it.qb1 != it.qb0, more_item = L + G < total, last = !more_pass && !more_item;
        SwaItem itn = it; int passn = pass + 1, Ln = L;
        if (!more_pass) { passn = 0; Ln = more_item ? L + G : L; itn = swa_decode(Ln, nqb, nx, nramp); }
        const BlockRef nxt = last ? cur : swa_ref<MODE>(itn, passn, Q, K, V);
        swa_block<MODE, SK>(cur, nxt, W, W, lds, S, X, wid, lane);
        if (last) break;
        cur = nxt; it = itn; pass = passn; L = Ln;
    }
}
}

#define XB_TMO      128
#define XB_XCNT(j)  (256  + 64 * (j))
#define XB_XSUB(j)  (1280 + 64 * (j))
#define XB_XGEN(j)  (2304 + 64 * (j))
#define XB_TOP      3328
#define XB_TOPGEN   3392
#define XCD_BAR_WORDS 3456
#define XB_SPIN_CAP (1u << 18)
__device__ __forceinline__ unsigned xb_ld(unsigned* p)              { return __hip_atomic_load(p, __ATOMIC_RELAXED, __HIP_MEMORY_SCOPE_AGENT); }
__device__ __forceinline__ unsigned xb_add(unsigned* p, unsigned v) { return __hip_atomic_fetch_add(p, v, __ATOMIC_RELAXED, __HIP_MEMORY_SCOPE_AGENT); }
__device__ __forceinline__ unsigned xb_xcc_id() { return (unsigned)__builtin_amdgcn_s_getreg((3 << 11) | 20) & 0xFu; }
#define XB_SPIN(cond, bar) do { unsigned _sp = 0; while (cond) { __builtin_amdgcn_s_sleep(1); \
    if ((++_sp & 255u) == 0u) { if (xb_ld(&(bar)[XB_TMO])) break; if (_sp > XB_SPIN_CAP) { atomicAdd(&(bar)[XB_TMO], 1u); break; } } } } while (0)
struct XcdBarrier { unsigned* bar; unsigned x; volatile LAS unsigned* st; };
__device__ __forceinline__ XcdBarrier xcd_barrier_post(unsigned* bar, volatile LAS unsigned* st, bool t0) {
    XcdBarrier b; b.bar = bar; b.x = xb_xcc_id(); b.st = st;
    if (t0) (void)xb_add(&bar[XB_XCNT(b.x)], 1u);
    return b;
}
__device__ __forceinline__ void xcd_barrier_complete(unsigned* bar, unsigned x, unsigned& nloc, unsigned& nx) {
    const unsigned G = gridDim.x * gridDim.y * gridDim.z;
    unsigned sum, cnt, mine, sp = 0u;
    for (;;) {
        sum = 0u; cnt = 0u; mine = 0u;
#pragma unroll
        for (unsigned j = 0; j < 16; ++j) { const unsigned c = xb_ld(&bar[XB_XCNT(j)]); sum += c; cnt += (c > 0u) ? 1u : 0u; mine = (j == x) ? c : mine; }
        if (sum == G) break;
        __builtin_amdgcn_s_sleep(1);
        if ((++sp & 255u) == 0u) { if (xb_ld(&bar[XB_TMO])) break; if (sp > XB_SPIN_CAP) { atomicAdd(&bar[XB_TMO], 1u); break; } }
    }
    nloc = mine > 0u ? mine : 1u; nx = cnt > 0u ? cnt : 1u;
}
__device__ __forceinline__ void xcd_barrier(const XcdBarrier& b, bool t0) {
    asm volatile("s_waitcnt vmcnt(0)" ::: "memory");
    __syncthreads();
    if (t0) {
        unsigned* bar = b.bar;
        __builtin_amdgcn_s_waitcnt(0);
        unsigned nloc = b.st[0], nx = b.st[1];
        if (nloc == 0u) { xcd_barrier_complete(bar, b.x, nloc, nx); b.st[0] = nloc; b.st[1] = nx; }
        const unsigned old = xb_add(&bar[XB_XSUB(b.x)], 1u);
        const unsigned gen = old / nloc;
        if (old + 1u == (gen + 1u) * nloc) {
            __builtin_amdgcn_fence(__ATOMIC_RELEASE, "agent");
            asm volatile("s_waitcnt vmcnt(0)" ::: "memory");
            const unsigned og = xb_add(&bar[XB_TOP], 1u);
            const unsigned tg = og / nx;
            if (og + 1u == (tg + 1u) * nx) xb_add(&bar[XB_TOPGEN], 1u);
            else XB_SPIN(xb_ld(&bar[XB_TOPGEN]) == tg, bar);
            __builtin_amdgcn_fence(__ATOMIC_ACQUIRE, "agent");
            xb_add(&bar[XB_XGEN(b.x)], 1u);
            asm volatile("s_waitcnt vmcnt(0)" ::: "memory");
        } else {
            XB_SPIN(xb_ld(&bar[XB_XGEN(b.x)]) == gen, bar);
            __builtin_amdgcn_fence(__ATOMIC_ACQUIRE, "agent");
            asm volatile("s_waitcnt vmcnt(0)" ::: "memory");
        }
    }
    __syncthreads();
}

struct Args {
    const float* in[24]; float* out; unsigned char* ws; int ph_lo, ph_hi, G, pad;
};
__device__ __forceinline__ float wave_sum(float v) {
#pragma unroll
    for (int o = 1; o < 64; o <<= 1) v += __shfl_xor(v, o);
    return v;
}
__device__ __forceinline__ f32x4 mfma16(bf16x8 a, bf16x8 b, f32x4 c) { return __builtin_amdgcn_mfma_f32_16x16x32_bf16(a, b, c, 0, 0, 0); }

__device__ __forceinline__ void tr_load(const float* W, int ldw, int k0, int n0, int lane, f32x4 (&v)[16]) {
    const float* src = W + (size_t)(k0 + (lane >> 4)) * ldw + n0 + 4 * (lane & 15);
#pragma unroll
    for (int i = 0; i < 16; ++i) v[i] = __builtin_nontemporal_load((const f32x4*)(src + (size_t)(4 * i) * ldw));
}
__device__ __forceinline__ void tr_finish(const f32x4 (&v)[16], int k0, bf16_t* WT, size_t drow0, int ldt, LAS float* scr, int lane, const float* gn  ) {
#pragma unroll
    for (int i = 0; i < 16; ++i) { LAS float* s = scr + ((lane >> 4) + 4 * i) * 65 + 4 * (lane & 15); s[0] = v[i][0]; s[1] = v[i][1]; s[2] = v[i][2]; s[3] = v[i][3]; }
    LDS_WAIT();
    const int c = lane & 7;
    f32x4 g0 = {1.f, 1.f, 1.f, 1.f}, g1 = {1.f, 1.f, 1.f, 1.f};
    if (gn) { g0 = *(const f32x4*)(gn + 8 * c); g1 = *(const f32x4*)(gn + 8 * c + 4); }
#pragma unroll
    for (int j = 0; j < 8; ++j) { const int n = (lane >> 3) + 8 * j; const LAS float* s = scr + (8 * c) * 65 + n;
        u32x4 o; o.x = cvt_pk_bf16(s[0 * 65] * g0[0], s[1 * 65] * g0[1]); o.y = cvt_pk_bf16(s[2 * 65] * g0[2], s[3 * 65] * g0[3]); o.z = cvt_pk_bf16(s[4 * 65] * g1[0], s[5 * 65] * g1[1]); o.w = cvt_pk_bf16(s[6 * 65] * g1[2], s[7 * 65] * g1[3]);
        if (ldt > 0) *(u32x4*)(WT + (drow0 + n) * (size_t)ldt + k0 + 8 * c) = o;
        else { const int row = (int)drow0 + n, k = k0 + 8 * c;
               *(u32x4*)(WT + ((size_t)((row >> 4) * ((-ldt) >> 5) + (k >> 5)) * 64 + ((k >> 3) & 3) * 16 + (row & 15)) * 8) = o; } }
    LDS_WAIT();
}
__device__ __forceinline__ void rms_row_bf16(const float* xrow, const float* gain, bf16_t* orow, int lane) {
    const f32x4* xr = (const f32x4*)xrow + lane; const f32x4* gr = (const f32x4*)gain + lane;
    f32x4 v[16]; float s = 0.f;
#pragma unroll
    for (int j = 0; j < 16; ++j) { v[j] = xr[64 * j]; s += (v[j][0] * v[j][0] + v[j][1] * v[j][1]) + (v[j][2] * v[j][2] + v[j][3] * v[j][3]); }
    const float r = 1.0f / sqrtf(wave_sum(s) * (1.0f / DM) + EPS);
    u32x2* o8 = (u32x2*)orow + lane;
#pragma unroll
    for (int j = 0; j < 16; ++j) { const f32x4 g = gr[64 * j]; u32x2 w; w.x = cvt_pk_bf16(v[j][0] * r * g[0], v[j][1] * r * g[1]); w.y = cvt_pk_bf16(v[j][2] * r * g[2], v[j][3] * r * g[3]); o8[64 * j] = w; }
}
__device__ __forceinline__ void rms_row_f32(const float* xrow, const float* gain, float* orow, int lane) {
    const f32x4* xr = (const f32x4*)xrow + lane; const f32x4* gr = (const f32x4*)gain + lane;
    f32x4 v[16]; float s = 0.f;
#pragma unroll
    for (int j = 0; j < 16; ++j) { v[j] = xr[64 * j]; s += (v[j][0] * v[j][0] + v[j][1] * v[j][1]) + (v[j][2] * v[j][2] + v[j][3] * v[j][3]); }
    const float r = 1.0f / sqrtf(wave_sum(s) * (1.0f / DM) + EPS);
    f32x4* o = (f32x4*)orow + lane;
#pragma unroll
    for (int j = 0; j < 16; ++j) { const f32x4 g = gr[64 * j]; o[64 * j] = v[j] * r * g; }
}

__device__ const float ROPE_INV_FREQ[16] = {1.0f, 0.44036659598350525f, 0.1939227432012558f, 0.08539710193872452f, 0.03760603070259094f, 0.01656043902039528f, 0.007292664609849453f,
    0.0032114458736032248f, 0.0014142135623842478f, 0.000622772378847003f, 0.00027424818836152554f, 0.00012076973507646471f, 5.318296098266728e-05f, 2.34199997066753e-05f,
    1.0313386155758053e-05f, 4.541670477919979e-06f};

__device__ __forceinline__ void compress_item(LAS unsigned char* lds, int which, int rt, const bf16_t* X0, const float* cb, const bf16_t* W1, const bf16_t* W2,
                                              bf16_t* KCMP, bf16_t* VCMPT, int wave, int lane) {
    const int fr = lane & 15, q4 = lane >> 4;
    const int bgi = (rt * 16) >> 8, n = ((rt * 16) & 255) + (lane >> 2), psrc = (fr << 2) | q4;
    const bf16_t* X = X0 + (size_t)bgi * T * HD + 8 * (lane & 3);
    f32x4 acc0 = {0.f, 0.f, 0.f, 0.f}, acc1 = {0.f, 0.f, 0.f, 0.f};
    const bf16_t* w1p = W1 + ((size_t)(2 * wave) * 128 * 64 + lane) * 8;
#define CMP_LOADG(gq, A, B0, B1) do { _Pragma("unroll") for (int j = 0; j < 8; ++j) { const int ks = 8 * (gq) + j; int tok = 16 * n + 2 * (gq) + (j >> 2); tok = tok > (T - 1) ? (T - 1) : tok; \
        A[j] = *(const bf16x8*)(X + (size_t)tok * HD + 32 * (j & 3)); B0[j] = *(const bf16x8*)(w1p + (size_t)ks * 512); B1[j] = *(const bf16x8*)(w1p + (size_t)(128 + ks) * 512); } } while (0)
#define CMP_COMPG(A, B0, B1) do { _Pragma("unroll") for (int j = 0; j < 8; ++j) { u32x4 t_ = __builtin_bit_cast(u32x4, A[j]); \
        t_.x = (unsigned)__shfl((int)t_.x, psrc); t_.y = (unsigned)__shfl((int)t_.y, psrc); t_.z = (unsigned)__shfl((int)t_.z, psrc); t_.w = (unsigned)__shfl((int)t_.w, psrc); \
        const bf16x8 a_ = __builtin_bit_cast(bf16x8, t_); acc0 = mfma16(a_, B0[j], acc0); acc1 = mfma16(a_, B1[j], acc1); } } while (0)
    bf16x8 a_0[8], b0_0[8], b1_0[8], a_1[8], b0_1[8], b1_1[8];
    CMP_LOADG(0, a_0, b0_0, b1_0);
    for (int gq = 0; gq < 16; gq += 2) {
        CMP_LOADG(gq + 1, a_1, b0_1, b1_1);
        CMP_COMPG(a_0, b0_0, b1_0);
        if (gq + 2 < 16) CMP_LOADG(gq + 2, a_0, b0_0, b1_0);
        CMP_COMPG(a_1, b0_1, b1_1);
    }
#undef CMP_LOADG
#undef CMP_COMPG
    const float cb0 = cb[32 * wave + fr], cb1 = cb[32 * wave + 16 + fr];
    LAS unsigned short* hid = (LAS unsigned short*)lds;
#pragma unroll
    for (int i = 0; i < 4; ++i) {
        hid[(4 * q4 + i) * 264 + 32 * wave + fr] = (unsigned short)(cvt_pk_bf16(gelu_tanh(acc0[i] + cb0), 0.f) & 0xffffu);
        hid[(4 * q4 + i) * 264 + 32 * wave + 16 + fr] = (unsigned short)(cvt_pk_bf16(gelu_tanh(acc1[i] + cb1), 0.f) & 0xffffu);
    }
    LDS_WAIT(); __syncthreads();
    f32x4 o = {0.f, 0.f, 0.f, 0.f};
    const bf16_t* w2p = W2 + (size_t)(16 * wave + fr) * 256 + 8 * q4;
#pragma unroll
    for (int ks = 0; ks < 8; ++ks) { const bf16x8 a2 = *(const LAS bf16x8*)(hid + fr * 264 + 32 * ks + 8 * q4); const bf16x8 b2 = *(const bf16x8*)(w2p + 32 * ks); o = mfma16(a2, b2, o); }
    const int nn = ((rt * 16) & 255) + 4 * q4, dcol = 16 * wave + fr;
    if (which == 0) {
#pragma unroll
        for (int i = 0; i < 4; ++i) { const int n_ = nn + i;
            KCMP[((size_t)((bgi * 16 + (n_ >> 4)) * 4 + (dcol >> 5)) * 64 + ((dcol >> 3) & 3) * 16 + (n_ & 15)) * 8 + (dcol & 7)] = (bf16_t)(cvt_pk_bf16(o[i], 0.f) & 0xffffu); }
    } else {
        u32x2 w; w.x = cvt_pk_bf16(o[0], o[1]); w.y = cvt_pk_bf16(o[2], o[3]);
        *(u32x2*)(VCMPT + ((size_t)((bgi * 8 + (dcol >> 4)) * 8 + (nn >> 5)) * 64 + ((nn >> 3) & 3) * 16 + (dcol & 15)) * 8 + (nn & 7)) = w;
    }
    __syncthreads();
}

__device__ __forceinline__ void cmp_attn_item(LAS unsigned char* lds, int bg, int tt, const bf16_t* QH, const bf16_t* KCMP, const bf16_t* VCMPT, const float* GATES,
                                              float* OACC, unsigned long long* SEL, int wave, int lane) {
    const int fr = lane & 15, q4 = lane >> 4, b = bg >> 2, g = bg & 3;
    const int t0w = tt * 32 + wave * 4;
    LAS unsigned short* pL = (LAS unsigned short*)(lds + wave * 8448);
    LAS float* impL = (LAS float*)(lds + 8 * 8448 + wave * 4160);
    LAS float* scL = (LAS float*)(lds + 8 * 8448 + 8 * 4160 + wave * 1024);
    const bf16_t* qrow = QH + ((size_t)((b * NH + g * 4 + (fr & 3)) * T + t0w + (fr >> 2))) * HD + 8 * q4;
    bf16x8 aq[4];
#pragma unroll
    for (int ks = 0; ks < 4; ++ks) aq[ks] = *(const bf16x8*)(qrow + 32 * ks);
    const bf16_t* kb = KCMP + ((size_t)bg * 16 * 4 * 64 + lane) * 8;
    const int nlast = (t0w + 3 >= 31) ? ((t0w + 3 - 31) >> 4) : -1, Tmax = nlast >> 4, Kmax = nlast >> 5;
    f32x4 s[16];
#pragma unroll
    for (int Tt = 0; Tt < 16; ++Tt) { f32x4 a = {0.f, 0.f, 0.f, 0.f};
        if (Tt <= Tmax) {
#pragma unroll
            for (int ks = 0; ks < 4; ++ks) { const bf16x8 bk = *(const bf16x8*)(kb + (size_t)(Tt * 4 + ks) * 512); a = mfma16(aq[ks], bk, a); } }
        s[Tt] = a; }
    const int t = t0w + q4;
    const int nmax = (t >= 31) ? ((t - 31) >> 4) : -1;
    const float NEGI = -__builtin_inff();
    float mx[4] = {NEGI, NEGI, NEGI, NEGI};
#pragma unroll
    for (int Tt = 0; Tt < 16; ++Tt) { const bool valid = (16 * Tt + fr) <= nmax;
#pragma unroll
        for (int i = 0; i < 4; ++i) mx[i] = valid ? fmaxf(mx[i], s[Tt][i]) : mx[i]; }
#pragma unroll
    for (int i = 0; i < 4; ++i) {
#pragma unroll
        for (int o = 1; o < 16; o <<= 1) mx[i] = fmaxf(mx[i], __shfl_xor(mx[i], o)); }
    constexpr float C2 = 1.4426950408889634f * 0.08838834764831845f;
    float sum[4] = {0.f, 0.f, 0.f, 0.f};
#pragma unroll
    for (int Tt = 0; Tt < 16; ++Tt) { const bool valid = (16 * Tt + fr) <= nmax;
#pragma unroll
        for (int i = 0; i < 4; ++i) { const float p = valid ? __builtin_amdgcn_exp2f((s[Tt][i] - mx[i]) * C2) : 0.f; s[Tt][i] = p; sum[i] += p; } }
#pragma unroll
    for (int i = 0; i < 4; ++i) {
#pragma unroll
        for (int o = 1; o < 16; o <<= 1) sum[i] += __shfl_xor(sum[i], o);
        sum[i] = sum[i] > 0.f ? 1.0f / sum[i] : 0.f; }
#pragma unroll
    for (int Tt = 0; Tt < 16; ++Tt) {
#pragma unroll
        for (int i = 0; i < 4; ++i) s[Tt][i] *= sum[i];
        impL[q4 * 260 + 16 * Tt + fr] = ((s[Tt][0] + s[Tt][1]) + s[Tt][2]) + s[Tt][3];
#pragma unroll
        for (int i = 0; i < 4; ++i) pL[(4 * q4 + i) * 264 + 16 * Tt + fr] = (unsigned short)(cvt_pk_bf16(s[Tt][i], 0.f) & 0xffffu);
    }
    LDS_WAIT();
    bf16x8 pf[8];
#pragma unroll
    for (int ks = 0; ks < 8; ++ks) pf[ks] = *(const LAS bf16x8*)(pL + fr * 264 + 32 * ks + 8 * q4);
    const bf16_t* vb = VCMPT + ((size_t)bg * 8 * 8 * 64 + lane) * 8;
    float gt[4];
#pragma unroll
    for (int i = 0; i < 4; ++i) gt[i] = GATES[(size_t)(b * T + t) * 48 + 3 * (g * 4 + i) + 0];
#pragma unroll
    for (int Dt = 0; Dt < 8; ++Dt) { f32x4 o = {0.f, 0.f, 0.f, 0.f};
#pragma unroll
        for (int ks = 0; ks < 8; ++ks) if (ks <= Kmax) { const bf16x8 bv = *(const bf16x8*)(vb + (size_t)(Dt * 8 + ks) * 512); o = mfma16(pf[ks], bv, o); }
#pragma unroll
        for (int i = 0; i < 4; ++i) OACC[((size_t)((b * NH + g * 4 + i) * T + t)) * HD + 16 * Dt + fr] = o[i] * gt[i]; }
    const LAS float* im = impL + q4 * 260;
    const int cur = t >> 6;
    float myv[4];
#pragma unroll
    for (int k = 0; k < 4; ++k) { const int jj = fr + 16 * k;
        const float m0 = jj > 0 ? im[4 * jj - 1] : 0.f, m1 = im[4 * jj], m2 = im[4 * jj + 1], m3 = im[4 * jj + 2], nx = im[4 * jj + 3];
        float sc = (((m0 + m1) + m2) + m3) - 0.5f * m0 + 0.5f * nx;
        sc = (jj == cur || jj == 0) ? 1e30f : (jj > cur ? -1e30f : sc);
        myv[k] = sc; scL[q4 * 64 + jj] = sc; }
    LDS_WAIT();
    int rank[4] = {0, 0, 0, 0};
#pragma unroll 8
    for (int i = 0; i < 64; ++i) { const float si = scL[q4 * 64 + i];
#pragma unroll
        for (int k = 0; k < 4; ++k) rank[k] += ((si > myv[k]) || (si == myv[k] && i < fr + 16 * k)) ? 1 : 0; }
    unsigned long long msk = 0ull;
#pragma unroll
    for (int k = 0; k < 4; ++k) { const unsigned long long bal = __ballot(rank[k] < 16); msk |= ((bal >> (16 * q4)) & 0xffffull) << (16 * k); }
    if (fr == 0) SEL[(size_t)bg * T + t] = msk;
    LDS_WAIT();
}

__device__ __forceinline__ void gate_task(LAS unsigned char* lds, int g, int dq, int bc0, int nbc, const bf16_t* V, bf16_t* U, const float* SUMS, const float* ln_g, const float* ln_b,
                                          const bf16_t* WM, const float* bs, int tid, int wave, int lane) {
    const int fr = lane & 15, q4 = lane >> 4;
    const int col0 = g * 768 + dq * 128;
    const int cc = tid & 15, s0 = tid >> 4;
    const f32x4 lg0 = *(const f32x4*)(ln_g + col0 + 8 * cc), lg1 = *(const f32x4*)(ln_g + col0 + 8 * cc + 4), lb0 = *(const f32x4*)(ln_b + col0 + 8 * cc), lb1 = *(const f32x4*)(ln_b + col0 + 8 * cc + 4);
    bf16x8 wf[4];
    const bf16_t* wp = WM + ((size_t)g * 128 + 16 * wave + fr) * 128 + 8 * q4;
#pragma unroll
    for (int ks = 0; ks < 4; ++ks) wf[ks] = *(const bf16x8*)(wp + 32 * ks);
    const int tt = 16 * wave + fr, kmax = wave >> 1;
    const float bias = bs[g * 128 + tt];
    const unsigned kf = (unsigned)((fr >> 3) ^ ((fr & 7) << 1)), rdl = ((unsigned)q4 ^ kf) << 4;
    u32x4 vraw[4]; f32x2 st[4];
    const bf16_t* vp = V + (size_t)(bc0 * 128 + s0) * GW + col0 + 8 * cc;
    const float* sp = SUMS + (size_t)(bc0 * 128 + s0) * 2;
#pragma unroll
    for (int j = 0; j < 4; ++j) { vraw[j] = *(const u32x4*)(vp + (size_t)(32 * j) * GW); st[j] = *(const f32x2*)(sp + 64 * j); }
    for (int i = 0; i < nbc; ++i) {
        const int row0 = (bc0 + i) * 128;
#pragma unroll
        for (int j = 0; j < 4; ++j) { const int sidx = s0 + 32 * j;
            const float mean = st[j][0] * (1.0f / GW); float var = st[j][1] * (1.0f / GW) - mean * mean; var = var > 0.f ? var : 0.f; const float rstd = 1.0f / sqrtf(var + EPS);
            const float x[8] = {bflo(vraw[j].x), bfhi(vraw[j].x), bflo(vraw[j].y), bfhi(vraw[j].y), bflo(vraw[j].z), bfhi(vraw[j].z), bflo(vraw[j].w), bfhi(vraw[j].w)};
#pragma unroll
            for (int e = 0; e < 8; ++e) { const float gg = e < 4 ? lg0[e & 3] : lg1[e & 3], bb = e < 4 ? lb0[e & 3] : lb1[e & 3];
                const float y = (x[e] - mean) * rstd * gg + bb;
                const unsigned off = (unsigned)(8 * cc + e) * 256u + ((((unsigned)(sidx >> 3)) ^ ((unsigned)cc ^ (unsigned)(2 * e))) & 15u) * 16u + (unsigned)(sidx & 7) * 2u;
                *(LAS unsigned short*)(lds + off) = (unsigned short)(cvt_pk_bf16(y, 0.f) & 0xffffu); } }
        if (i + 1 < nbc) {
            const bf16_t* vn = V + (size_t)(row0 + 128 + s0) * GW + col0 + 8 * cc; const float* sn = SUMS + (size_t)(row0 + 128 + s0) * 2;
#pragma unroll
            for (int j = 0; j < 4; ++j) { vraw[j] = *(const u32x4*)(vn + (size_t)(32 * j) * GW); st[j] = *(const f32x2*)(sn + 64 * j); } }
        bf16_t* up = U + (size_t)(row0 + tt) * GW + col0 + 4 * q4;
        u32x2 u4[8];
#pragma unroll
        for (int nt = 0; nt < 8; ++nt) u4[nt] = *(const u32x2*)(up + 16 * nt);
        LDS_WAIT(); __syncthreads();
#pragma unroll
        for (int nt = 0; nt < 8; ++nt) { f32x4 acc = {0.f, 0.f, 0.f, 0.f};
#pragma unroll
            for (int ks = 0; ks < 4; ++ks) if (ks <= kmax) { const bf16x8 af = *(const LAS bf16x8*)(lds + (unsigned)(16 * nt + fr) * 256u + ((unsigned)(((4 * ks) ^ (2 * nt)) << 4) ^ rdl)); acc = mfma16(af, wf[ks], acc); }
            u32x2 w; w.x = cvt_pk_bf16(bflo(u4[nt].x) * (acc[0] + bias), bfhi(u4[nt].x) * (acc[1] + bias)); w.y = cvt_pk_bf16(bflo(u4[nt].y) * (acc[2] + bias), bfhi(u4[nt].y) * (acc[3] + bias));
            *(u32x2*)(up + 16 * nt) = w; }
        __syncthreads();
    }
}

template <int W> __device__ __forceinline__ void pool_chunk(const bf16_t* PIN, bf16_t* POOLED, int row, int c8) {
    const int t = row & (T - 1), cnt = (t + 1) < W ? (t + 1) : W;
    u32x4 v[W];
#pragma unroll
    for (int i = 0; i < W; ++i) { const int ri = (i <= t) ? row - i : row; v[i] = *(const u32x4*)(PIN + (size_t)ri * 2048 + c8); }
    float sm[8] = {0.f, 0.f, 0.f, 0.f, 0.f, 0.f, 0.f, 0.f};
#pragma unroll
    for (int i = 0; i < W; ++i) { const float k = (i <= t) ? 1.f : 0.f;
        sm[0] += k * bflo(v[i].x); sm[1] += k * bfhi(v[i].x); sm[2] += k * bflo(v[i].y); sm[3] += k * bfhi(v[i].y); sm[4] += k * bflo(v[i].z); sm[5] += k * bfhi(v[i].z); sm[6] += k * bflo(v[i].w); sm[7] += k * bfhi(v[i].w); }
    const float fc = (float)cnt; const u32x4 cur = v[0];
    u32x4 w; w.x = cvt_pk_bf16(sm[0] / fc - bflo(cur.x), sm[1] / fc - bfhi(cur.x)); w.y = cvt_pk_bf16(sm[2] / fc - bflo(cur.y), sm[3] / fc - bfhi(cur.y));
    w.z = cvt_pk_bf16(sm[4] / fc - bflo(cur.z), sm[5] / fc - bfhi(cur.z)); w.w = cvt_pk_bf16(sm[6] / fc - bflo(cur.w), sm[7] / fc - bfhi(cur.w));
    *(u32x4*)(POOLED + (size_t)row * 2048 + c8) = w;
}

constexpr int N_PHASES = 19;
constexpr int I_INE1 = 64 * 80, I_INE2 = 64 * 32, I_OUTE = 64 * 64, I_G = 64 * 172, I_DN = 172 * 64, I_INO = 64 * 384, I_OUTO = 192 * 64, I_POOL = 8 * 8, I_C1 = 64 * 4, I_C2 = 4 * 2;
constexpr int NIT_A = I_INE1 + I_INE2 + 4 * I_POOL + 2 * I_C1 + 2 * I_C2;
constexpr int NIT_P0 = NIT_A + 4 * I_G + I_INO;
constexpr int NIT_T1 = NIT_P0 + I_DN + I_OUTE;
constexpr int NIT_T8 = NIT_T1 + I_OUTO;
constexpr int NITEMS = NIT_T8 + I_DN;
#ifndef PH_MASK
#define PH_MASK 0x7FFFF
#endif
typedef const __attribute__((address_space(4))) Args* KArgs;
__device__ __forceinline__ KArgs kargs() { unsigned long long v = (unsigned long long)__builtin_amdgcn_kernarg_segment_ptr(); asm volatile("" : "+s"(v)); return (KArgs)v; }
#define WSP(type, off) ((type*)(ws + (off)))

struct ConvJob { int cnt, in_idx; unsigned src_off; unsigned long long dst_off; int ldw, K, nblk, col0, drow0, mode, gain_idx, gain_off; };
__device__ const ConvJob CONV_JOBS[19] = {
    {I_INE1, 2, 0u, O_W_INE, IN_EVEN, 4096, 80, 0, 0, 0, -1, 0},
    {I_INE2, 2, 0u, O_W_INE, IN_EVEN, 4096, 32, 5168, 5120, 0, -1, 0},
    {I_POOL, 9, 0u, O_W_POOL, 512, 512, 8, 0, 0, 0, -1, 0},
    {I_POOL, 9, 1u * 512 * 512, O_W_POOL + 1ull * 512 * 512 * 2, 512, 512, 8, 0, 0, 0, -1, 0},
    {I_POOL, 9, 2u * 512 * 512, O_W_POOL + 2ull * 512 * 512 * 2, 512, 512, 8, 0, 0, 0, -1, 0},
    {I_POOL, 9, 3u * 512 * 512, O_W_POOL + 3ull * 512 * 512 * 2, 512, 512, 8, 0, 0, 0, -1, 0},
    {I_C1, 5, 0u, O_W_C1K, 256, 4096, 4, 0, 0, 2, -1, 0},
    {I_C1, 7, 0u, O_W_C1V, 256, 4096, 4, 0, 0, 2, -1, 0},
    {I_C2, 6, 0u, O_W_C2K, 128, 256, 2, 0, 0, 0, -1, 0},
    {I_C2, 8, 0u, O_W_C2V, 128, 256, 2, 0, 0, 0, -1, 0},
    {I_G, 20, 0u, O_W_GU0, FF, 4096, 172, 0, 0, 1, 19, 0},
    {I_G, 21, 0u, O_W_GU0, FF, 4096, 172, 0, 128, 1, 19, 0},
    {I_G, 20, (unsigned)(DM * FF), O_W_GU1, FF, 4096, 172, 0, 0, 1, 19, DM},
    {I_G, 21, (unsigned)(DM * FF), O_W_GU1, FF, 4096, 172, 0, 128, 1, 19, DM},
    {I_INO, 13, 0u, O_W_INO, 2 * GW, 4096, 384, 0, 0, 0, 12, 0},
    {I_DN, 22, 0u, O_W_DN0, 4096, FF, 64, 0, 0, 0, -1, 0},
    {I_OUTE, 11, 0u, O_W_OUTE, 4096, 4096, 64, 0, 0, 0, -1, 0},
    {I_OUTO, 18, 0u, O_W_OUTO, 4096, GW, 64, 0, 0, 0, -1, 0},
    {I_DN, 22, (unsigned)(DM * FF), O_W_DN1, 4096, FF, 64, 0, 0, 0, -1, 0}};
#define CONV_DECODE(it_, osrc, odst, oldw, oK, k0, n0, drow, ogn) const float* osrc; bf16_t* odst; const float* ogn; int oldw, oK, k0, n0, drow; { \
            int r = (it_), j = 0; while (j < 18 && r >= CONV_JOBS[j].cnt) { r -= CONV_JOBS[j].cnt; ++j; } \
            const ConvJob jb = CONV_JOBS[j]; \
            const int kb = r / jb.nblk, nb = r - kb * jb.nblk, n0l = nb * 64; k0 = kb * 64; n0 = jb.col0 + n0l; \
            drow = jb.mode == 1 ? (256 * (n0l >> 7) + (n0l & 127) + jb.drow0) : (jb.drow0 + n0l); \
            osrc = ap->in[jb.in_idx] + jb.src_off; odst = (bf16_t*)(ws + jb.dst_off); oldw = jb.ldw; oK = jb.mode == 2 ? -jb.K : jb.K; ogn = jb.gain_idx >= 0 ? ap->in[jb.gain_idx] + jb.gain_off + k0 : nullptr; }
#define CONV_RANGE(lo_, hi_, first_, stride_) do { LAS float* scr = (LAS float*)(lds + RING_OFF + wave * 16640); \
        for (int it = (lo_) + (first_); it < (hi_); it += 2 * (stride_)) { f32x4 va[16], vb[16]; const bool hasb = it + (stride_) < (hi_); \
            CONV_DECODE(it, srcA, dstA, ldwA, KA, k0A, n0A, drowA, gnA) tr_load(srcA, ldwA, k0A, n0A, lane, va); \
            CONV_DECODE(hasb ? it + (stride_) : it, srcB, dstB, ldwB, KB, k0B, n0B, drowB, gnB) tr_load(srcB, ldwB, k0B, n0B, lane, vb);   \
            tr_finish(va, k0A, dstA, (size_t)drowA, KA, scr, lane, gnA); if (hasb) tr_finish(vb, k0B, dstB, (size_t)drowB, KB, scr, lane, gnB); } } while (0)
#define CONV_TAIL(nunits_, lo_, hi_) do { const int rounds_ = ((nunits_) + G - 1) / G, first_idle_ = (nunits_) - (rounds_ - 1) * G; \
        if (first_idle_ >= G) CONV_RANGE(lo_, hi_, bx * NWAVES + wave, G * NWAVES);   \
        else if (bx >= first_idle_) CONV_RANGE(lo_, hi_, (bx - first_idle_) * NWAVES + wave, (G - first_idle_) * NWAVES); } while (0)

__device__ __forceinline__ bool ph_in(int k) { KArgs ap = kargs(); return ap->ph_lo <= k && k < ap->ph_hi; }
__global__ void __launch_bounds__(NWAVES * 64, 2) fwd(Args args) {
    extern __shared__ __attribute__((aligned(16))) unsigned char lds_raw[];
    LAS unsigned char* lds = (LAS unsigned char*)lds_raw;
    const int wave = __builtin_amdgcn_readfirstlane((int)threadIdx.x >> 6);
    const int bx = blockIdx.x;
    { const int tid0 = threadIdx.x; for (int u = tid0; u < (LDS_BYTES - LDSCTL_OFF) / 4; u += NWAVES * 64) ((LAS unsigned*)(lds + LDSCTL_OFF))[u] = 0u; }
    __syncthreads();
#if MK_ONE_LAUNCH
    { KArgs ap = kargs(); (void)xcd_barrier_post((unsigned*)(ap->ws + O_CTL) + CW_BAR, (volatile LAS unsigned*)(lds + MISC_OFF) + 8, wave == 0 && lane_id() == 0); }
#define GRID_BAR() do { XcdBarrier bar_; bar_.bar = (unsigned*)(ws + O_CTL) + CW_BAR; bar_.x = xb_xcc_id(); bar_.st = (volatile LAS unsigned*)(lds + MISC_OFF) + 8; xcd_barrier(bar_, wave == 0 && lane_id() == 0); } while (0)
#else
#define GRID_BAR() do { } while (0)
#endif
#define IN(k) ((((PH_MASK) >> (k)) & 1) && ph_in(k))
#define BOTH(k) (IN(k) && IN((k) + 1))
#define PH_ARGS KArgs ap = kargs(); unsigned char* ws = ap->ws; (void)ws; const int G = ap->G; const int lane = lane_id(); const int tid = wave * 64 + lane; (void)tid; \
    const int vcu = (G % 8 == 0) ? (bx % 8) * (G / 8) + bx / 8 : bx; (void)vcu; const int gw = vcu * NWAVES + wave, NGW = G * NWAVES; (void)gw; (void)NGW; \
    const int gtid = vcu * (NWAVES * 64) + tid, NT_ALL = G * NWAVES * 64; (void)gtid; (void)NT_ALL

    if (IN(0)) {
        PH_ARGS;
        CONV_RANGE(0, NIT_A, gw, NGW);
        { const float* w_in = ap->in[2]; bf16_t* W_INE = WSP(bf16_t, O_W_INE);
          for (int idx = gtid; idx < 256 * 4096; idx += NT_ALL) { const int rr = idx >> 12, k = idx & 4095;
            const float v = rr < 48 ? w_in[(size_t)k * IN_EVEN + 5120 + rr] : 0.f;
            W_INE[(size_t)(7168 + rr) * 4096 + k] = (bf16_t)(cvt_pk_bf16(v, 0.f) & 0xffffu); } }
        { float* CB = WSP(float, O_CTL + O_CBIAS);
          for (int o = gw; o < 512; o += NGW) { const int which = o >> 8, h = o & 255; const float* pe = which ? ap->in[4] : ap->in[3]; const float* w1 = which ? ap->in[7] : ap->in[5]; float a = 0.f;
            for (int k = lane; k < 4096; k += 64) a += pe[k] * w1[(size_t)k * 256 + h];
            a = wave_sum(a); if (lane == 0) CB[o] = a; } }
        { const float* gws = ap->in[16]; bf16_t* WM = WSP(bf16_t, O_WM);
          for (int idx = gtid; idx < 16 * 128 * 128; idx += NT_ALL) { const int t = (idx >> 7) & 127, s = idx & 127;
            const float v = s <= t ? gws[idx] : 0.f; WM[idx] = (bf16_t)(cvt_pk_bf16(v, 0.f) & 0xffffu); } }
        { float* ROPE = WSP(float, O_ROPE);
          for (int idx = gtid; idx < 4096 * 16; idx += NT_ALL) { const int t = idx >> 4, i = idx & 15;
            const float ang = (float)t * ROPE_INV_FREQ[i];
            const double xr = (double)ang; const double nrev = __builtin_rint(xr * 0.15915494309189535); const double rr = __builtin_fma(-nrev, 6.283185307179586, xr) - nrev * 2.4492935982947064e-16;
            const double r2 = rr * rr; double ts = 1.0, tc = 1.0, sn = 1.0, cs = 1.0;
#pragma unroll
            for (int k = 1; k <= 15; ++k) { ts *= -r2 / (double)((2 * k) * (2 * k + 1)); sn += ts; tc *= -r2 / (double)((2 * k - 1) * (2 * k)); cs += tc; }
            ROPE[idx] = (float)cs; ROPE[65536 + idx] = (float)(sn * rr); } }
        { const float* x = ap->in[0]; const float* gn = ap->in[1]; bf16_t* HN = WSP(bf16_t, O_HN);
          for (int m = gw; m < M; m += NGW) rms_row_bf16(x + (size_t)m * DM, gn, HN + (size_t)m * DM, lane); }
        if (BOTH(0)) GRID_BAR();
    }

    if (IN(1)) {
        PH_ARGS;
        pg8::Gemm g{WSP(bf16_t, O_HN), WSP(bf16_t, O_W_INE), M, IN_EVEN_P, DM, DM, DM}; pg8::StaticOrder S; S.init(M, IN_EVEN_P, G, bx);
        pg8::EpiInEven E{WSP(bf16_t, O_QH), WSP(bf16_t, O_KV), WSP(bf16_t, O_PIN), WSP(float, O_GATES), WSP(float, O_ROPE)};
        pg8::gemm_phase<pg8::EpiInEven, pg8::StaticOrder, true, true>(lds + RING_OFF, g, S, E, wave, lane);
        CONV_TAIL((M / 256) * (IN_EVEN_P / 256), NIT_P0, NIT_T1);
        if (BOTH(1)) GRID_BAR();
    }
    if (IN(2)) {
        PH_ARGS;
        for (int id = vcu; id < 256; id += G) { const int which = id >> 7, rt = id & 127;
            compress_item(lds + RING_OFF, which, rt, WSP(bf16_t, O_KV) + (size_t)which * KVSZ, WSP(float, O_CTL + O_CBIAS) + 256 * which, which ? WSP(bf16_t, O_W_C1V) : WSP(bf16_t, O_W_C1K),
                          which ? WSP(bf16_t, O_W_C2V) : WSP(bf16_t, O_W_C2K), WSP(bf16_t, O_KCMP), WSP(bf16_t, O_VCMPT), wave, lane); }
        const bf16_t* PIN = WSP(bf16_t, O_PIN); bf16_t* POOLED = WSP(bf16_t, O_POOLED);
        for (int idx = gtid; idx < M * 256; idx += NT_ALL) { const int row = idx >> 8, c8 = (idx & 255) * 8, grp = __builtin_amdgcn_readfirstlane(c8 >> 9);
            if (grp == 0) pool_chunk<2>(PIN, POOLED, row, c8); else if (grp == 1) pool_chunk<4>(PIN, POOLED, row, c8); else if (grp == 2) pool_chunk<8>(PIN, POOLED, row, c8); else pool_chunk<16>(PIN, POOLED, row, c8); }
        if (BOTH(2)) GRID_BAR();
    }
    if (IN(3)) {
        PH_ARGS;
        { const int grp = bx >> 6, loc = bx & 63;
          pg8::Gemm g{WSP(bf16_t, O_POOLED) + 512 * grp, WSP(bf16_t, O_W_POOL) + (size_t)grp * 512 * 512, M, 512, 512, 2048, 512}; pg8::StaticOrder S; S.init(M, 512, 64, loc);
          pg8::EpiScaleBf16 E{WSP(bf16_t, O_CAT) + 2048 + 512 * grp, DM, ap->in[10] + 512 * grp};
          if (grp < 4) pg8::gemm_phase<pg8::EpiScaleBf16, pg8::StaticOrder, false, true>(lds + RING_OFF, g, S, E, wave, lane); }
        __syncthreads();
        for (int id = vcu; id < 1024; id += G) cmp_attn_item(lds + RING_OFF, 2 * (id >> 8) + ((id >> 7) & 1), (id + 32 * (id >> 8)) & 127, WSP(bf16_t, O_QH), WSP(bf16_t, O_KCMP), WSP(bf16_t, O_VCMPT), WSP(float, O_GATES),
                                                             WSP(float, O_OACC), WSP(unsigned long long, O_SEL), wave, lane);
        if (BOTH(3)) GRID_BAR();
    }
    if (IN(4)) {
        PH_ARGS;
        const bool conv_first = ((bx >> 3) & 1) != 0;
        if (conv_first) { CONV_RANGE(NIT_A, NIT_P0, bx * NWAVES + wave, G * NWAVES); VM_WAIT(); __syncthreads(); }
        const swa::Ctx X{WSP(float, O_OACC), WSP(bf16_t, O_CAT), WSP(float, O_GATES), WSP(unsigned long long, O_SEL)};
        swa::swa_phase<1, false>((char*)lds_raw + RING_OFF, WSP(bf16_t, O_QH), WSP(bf16_t, O_KV) + 2 * KVSZ, WSP(bf16_t, O_KV) + 3 * KVSZ, X, 1 << 28, 1 << 28, bx, G, wave, lane);
        if (!conv_first) { __syncthreads(); CONV_RANGE(NIT_A, NIT_P0, bx * NWAVES + wave, G * NWAVES); }
        VM_WAIT(); __syncthreads();
        swa::swa_phase<0, true>((char*)lds_raw + RING_OFF, WSP(bf16_t, O_QH), WSP(bf16_t, O_KV) + 4 * KVSZ, WSP(bf16_t, O_KV) + 5 * KVSZ, X, 512, 1 << 28, bx, G, wave, lane);
        if (BOTH(4)) GRID_BAR();
    }
    if (IN(6)) {
        PH_ARGS;
        pg8::Gemm g{WSP(bf16_t, O_CAT), WSP(bf16_t, O_W_OUTE), M, DM, DM, DM, DM}; pg8::StaticOrder S; S.init(M, DM, G, bx);
        pg8::EpiResid<true> E{ap->in[0], WSP(bf16_t, O_XB), DM, WSP(float, O_SSQP)};
        pg8::gemm_phase<pg8::EpiResid<true>, pg8::StaticOrder, true, true>(lds + RING_OFF, g, S, E, wave, lane);
        if (BOTH(6)) GRID_BAR();
    }
    for (int l = 0; l < 2; ++l) {
        if (l == 1) {
            if (IN(11)) {
                PH_ARGS;
                pg8::Gemm g{WSP(bf16_t, O_XB1), WSP(bf16_t, O_W_INO), M, 2 * GW, DM, DM, DM}; pg8::StaticOrder S; S.init(M, 2 * GW, G, bx);
                pg8::Unit u0; LAS float* tab = (LAS float*)(lds + ROWSC_OFF); int pm0 = -1;
                if (S.next(0, u0)) { pm0 = u0.pm; pg8::build_row_scale(tab, WSP(float, O_SSQP), pm0, tid); }
                LDS_WAIT(); __syncthreads();
                pg8::EpiGeluSplit E{WSP(bf16_t, O_U), WSP(bf16_t, O_V), GW, GW, WSP(float, O_VPART), pg8::RowScale{tab, pm0}};
                pg8::gemm_phase<pg8::EpiGeluSplit, pg8::StaticOrder, true, true>(lds + RING_OFF, g, S, E, wave, lane);
                if (BOTH(11)) GRID_BAR();
            }
            if (IN(12)) { PH_ARGS; const float* part = WSP(float, O_VPART); float* SUMS = WSP(float, O_CTL + O_VSUMS);
                for (int m = gw; m < M; m += NGW) { const f32x2* pr = (const f32x2*)(part + (size_t)m * 384) + lane; const f32x2 a = pr[0], b = pr[64], c = pr[128];
                    const float s1 = wave_sum((a[0] + b[0]) + c[0]), s2 = wave_sum((a[1] + b[1]) + c[1]); if (lane == 0) *(f32x2*)(SUMS + (size_t)m * 2) = (f32x2){s1, s2}; }
                if (BOTH(12)) GRID_BAR(); }
            if (IN(13)) {
                PH_ARGS;
                for (int task = vcu; task < 96 * 8; task += G) { const int pnl = 3 * (task & 31) + ((task >> 5) % 3), bq = (task >> 5) / 3;
                    gate_task(lds + RING_OFF, pnl / 6, pnl % 6, 8 * bq, 8, WSP(bf16_t, O_V), WSP(bf16_t, O_U), WSP(float, O_CTL + O_VSUMS), ap->in[14], ap->in[15], WSP(bf16_t, O_WM), ap->in[17], tid, wave, lane); }
                if (BOTH(13)) GRID_BAR();
            }
            if (IN(14)) {
                PH_ARGS;
                pg8::Gemm g{WSP(bf16_t, O_U), WSP(bf16_t, O_W_OUTO), M, DM, GW, GW, GW}; pg8::StaticOrder S; S.init(M, DM, G, bx);
                pg8::EpiResid<false> E{WSP(bf16_t, O_XB1), WSP(bf16_t, O_XB), DM, WSP(float, O_SSQP)};
                pg8::gemm_phase<pg8::EpiResid<false>, pg8::StaticOrder, true, true>(lds + RING_OFF, g, S, E, wave, lane);
                if (BOTH(14)) GRID_BAR();
            }
        }
        const int pb = 7 + 8 * l;
        if (IN(pb + 1)) {
            PH_ARGS;
            pg8::Gemm g{WSP(bf16_t, O_XB), (const bf16_t*)(ws + (l ? O_W_GU1 : O_W_GU0)), M, 2 * FF, DM, DM, DM}; pg8::StaticOrder S; S.init(M, 2 * FF, G, bx);
            pg8::Unit u0; LAS float* tab = (LAS float*)(lds + ROWSC_OFF); int pm0 = -1;
            if (S.next(0, u0)) { pm0 = u0.pm; pg8::build_row_scale(tab, WSP(float, O_SSQP), pm0, tid); }
            LDS_WAIT(); __syncthreads();
            pg8::EpiSwiGLU E{WSP(bf16_t, O_H), FF, pg8::RowScale{tab, pm0}};
            pg8::gemm_phase<pg8::EpiSwiGLU, pg8::StaticOrder, true, true>(lds + RING_OFF, g, S, E, wave, lane);
            if (l == 0) CONV_TAIL((M / 256) * (2 * FF / 256), NIT_T1, NIT_T8); else CONV_TAIL((M / 256) * (2 * FF / 256), NIT_T8, NITEMS);
            if (BOTH(pb + 1)) GRID_BAR();
        }
        if (IN(pb + 2)) {
            PH_ARGS;
            pg8::Gemm g{WSP(bf16_t, O_H), (const bf16_t*)(ws + (l ? O_W_DN1 : O_W_DN0)), M, DM, FF, FF, FF}; pg8::StaticOrder S; S.init(M, DM, G, bx);
            pg8::EpiResid<false> E{WSP(bf16_t, O_XB), WSP(bf16_t, O_XB1), DM, WSP(float, O_SSQP)};
            pg8::gemm_phase<pg8::EpiResid<false>, pg8::StaticOrder, true, true>(lds + RING_OFF, g, S, E, wave, lane);
            if (BOTH(pb + 2)) GRID_BAR();
        }
    }
    if (IN(18)) { PH_ARGS; const bf16_t* XB = WSP(bf16_t, O_XB1); const float* gn = ap->in[23]; float* out = ap->out; const float* pp = WSP(float, O_SSQP);
        for (int m = gw; m < M; m += NGW) { const float r = 1.0f / sqrtf(wave_sum(pp[(size_t)m * 64 + lane]) * (1.0f / DM) + EPS); const u32x2* xr = (const u32x2*)(XB + (size_t)m * DM) + lane; const f32x4* gr = (const f32x4*)gn + lane; f32x4* o = (f32x4*)(out + (size_t)m * DM) + lane;
#pragma unroll 8
            for (int j = 0; j < 16; ++j) { const u32x2 w = xr[64 * j]; o[64 * j] = (f32x4){bflo(w.x), bfhi(w.x), bflo(w.y), bfhi(w.y)} * r * gr[64 * j]; } } }
#undef IN
#undef BOTH
}

extern "C" void kernel_launch(void* const* d_in, const int* in_sizes, int n_in, void* d_out, int out_size, void* d_ws, size_t ws_size, hipStream_t stream) {
    static int grid = 0;
    if (grid == 0) {
        if (n_in != 24 || in_sizes[0] != M * DM || out_size != M * DM || ws_size < WS_END) {
            fprintf(stderr, "kernel_launch: built for 24 inputs, x/out of %d floats, >= %zu bytes of workspace; got n_in %d, in0 %d, out %d, ws %zu; nothing launched\n", M * DM, (size_t)WS_END, n_in, n_in > 0 ? in_sizes[0] : -1, out_size, ws_size);
            grid = -1; return; }
        int dev = 0, cus = 0;
        if (hipGetDevice(&dev) != hipSuccess || hipDeviceGetAttribute(&cus, hipDeviceAttributeMultiprocessorCount, dev) != hipSuccess) { fprintf(stderr, "kernel_launch: device query failed\n"); grid = -1; return; }
        if (hipFuncSetAttribute((const void*)fwd, hipFuncAttributeMaxDynamicSharedMemorySize, LDS_BYTES) != hipSuccess) { fprintf(stderr, "kernel_launch: hipFuncSetAttribute failed\n"); grid = -1; return; }
        int per_cu = 0;
        if (hipOccupancyMaxActiveBlocksPerMultiprocessor(&per_cu, (const void*)fwd, NWAVES * 64, LDS_BYTES) != hipSuccess || per_cu < 1) fprintf(stderr, "kernel_launch: note: occupancy query reports %d\n", per_cu);
        (void)hipGetLastError();
        if (cus != 256) { fprintf(stderr, "kernel_launch: built for a 256-CU device, found %d CUs; nothing launched\n", cus); grid = -1; return; }
        grid = cus;
    }
    if (grid < 0) return;
    (void)hipMemsetAsync((char*)d_ws + O_CTL, 0, CTL_ZERO_BYTES, stream);
    Args a{};
    for (int i = 0; i < 24; ++i) a.in[i] = (const float*)d_in[i];
    a.out = (float*)d_out; a.ws = (unsigned char*)d_ws; a.G = grid; a.pad = 0;
#if MK_ONE_LAUNCH
    a.ph_lo = 0; a.ph_hi = N_PHASES;
    hipLaunchKernelGGL(fwd, dim3(grid), dim3(NWAVES * 64), LDS_BYTES, stream, a);
#else
    for (int p = 0; p < N_PHASES; ++p) { a.ph_lo = p; a.ph_hi = p + 1; hipLaunchKernelGGL(fwd, dim3(grid), dim3(NWAVES * 64), LDS_BYTES, stream, a); }
#endif
}
```

```cpp
#include <hip/hip_runtime.h>
#include <cstdio>
#include <cstdint>

#ifndef MK_ONE_LAUNCH
#define MK_ONE_LAUNCH 1
#endif

#define LAS __attribute__((address_space(3)))
#define GAS __attribute__((address_space(1)))
typedef unsigned short bf16_t;
typedef short bf16x8 __attribute__((ext_vector_type(8)));
typedef short s16x4 __attribute__((ext_vector_type(4)));
typedef float f32x2 __attribute__((ext_vector_type(2)));
typedef float f32x4 __attribute__((ext_vector_type(4)));
typedef float f32x16 __attribute__((ext_vector_type(16)));
typedef unsigned u32x2 __attribute__((ext_vector_type(2)));
typedef unsigned u32x4 __attribute__((ext_vector_type(4)));

constexpr int NB = 2, T = 4096, DM = 4096, M = NB * T;
constexpr int NH = 16, NG = 4, HD = 128;
constexpr int IN_EVEN = 7216, IN_EVEN_P = 7424;
constexpr int FF = 11008, GW = 12288;
constexpr float EPS = 1e-6f;
constexpr size_t KVSZ = (size_t)NB * NG * T * HD;

constexpr size_t O_CTL = 0, CTL_ZERO_BYTES = 64u << 10;
constexpr size_t O_ROPE = 1u << 20;
constexpr size_t O_WM = O_ROPE + (512u << 10);
constexpr size_t O_STATS = O_WM + (512u << 10);
constexpr size_t O_KCMP = O_STATS + (64u << 10);
constexpr size_t O_VCMPT = O_KCMP + (512u << 10);
constexpr size_t O_SEL = O_VCMPT + (512u << 10);
constexpr size_t O_GATES = O_SEL + (256u << 10);
constexpr size_t O_W = 8u << 20;
constexpr size_t O_W_INE = O_W;
constexpr size_t O_W_OUTE = O_W_INE + (size_t)IN_EVEN_P * DM * 2;
constexpr size_t O_W_GU0 = O_W_OUTE + (size_t)DM * DM * 2;
constexpr size_t O_W_DN0 = O_W_GU0 + (size_t)2 * FF * DM * 2;
constexpr size_t O_W_GU1 = O_W_DN0 + (size_t)DM * FF * 2;
constexpr size_t O_W_DN1 = O_W_GU1 + (size_t)2 * FF * DM * 2;
constexpr size_t O_W_INO = O_W_DN1 + (size_t)DM * FF * 2;
constexpr size_t O_W_OUTO = O_W_INO + (size_t)2 * GW * DM * 2;
constexpr size_t O_W_POOL = O_W_OUTO + (size_t)DM * GW * 2;
constexpr size_t O_W_C1K = O_W_POOL + (size_t)4 * 512 * 512 * 2;
constexpr size_t O_W_C1V = O_W_C1K + (size_t)256 * 4096 * 2;
constexpr size_t O_W_C2K = O_W_C1V + (size_t)256 * 4096 * 2;
constexpr size_t O_W_C2V = O_W_C2K + (size_t)128 * 256 * 2;
constexpr size_t O_XB = O_W_C2V + (size_t)128 * 256 * 2;
constexpr size_t O_XB1 = O_XB + (size_t)M * DM * 2;
constexpr size_t O_HN = O_XB + (size_t)M * DM * 4;
constexpr size_t O_A = O_HN + (size_t)M * DM * 2;
constexpr size_t O_QH = O_A;
constexpr size_t O_KV = O_QH + (size_t)M * 2048 * 2;
constexpr size_t O_PIN = O_KV + 6 * KVSZ * 2;
constexpr size_t O_POOLED = O_PIN + (size_t)M * 2048 * 2;
constexpr size_t O_OACC = O_POOLED + (size_t)M * 2048 * 2;
constexpr size_t O_CAT = O_OACC + (size_t)M * 2048 * 4;
constexpr size_t O_A_END_EVEN = O_CAT + (size_t)M * DM * 2;
constexpr size_t O_H = O_A;
constexpr size_t O_U = O_A;
constexpr size_t O_V = O_U + (size_t)M * GW * 2;
constexpr size_t O_A_END_ODD = O_V + (size_t)M * GW * 2;
constexpr size_t O_VPART = O_A_END_ODD > O_A_END_EVEN ? O_A_END_ODD : O_A_END_EVEN;
constexpr size_t O_SSQP = O_VPART + (size_t)M * 192 * 2 * 4;
constexpr size_t WS_END = O_SSQP + (size_t)M * 64 * 4;
static_assert(O_GATES + (size_t)M * 48 * 4 <= O_W, "small buffers fit below the weights");
static_assert((O_W_OUTE % 256) == 0 && (O_W_GU0 % 256) == 0 && (O_W_DN0 % 256) == 0 && (O_W_INO % 256) == 0 && (O_XB % 256) == 0 && (O_A % 256) == 0 && (O_V % 256) == 0, "alignment");

constexpr int CW_TMO = 0, CW_BAR = 4096;
constexpr size_t O_CBIAS = 384u << 10;
constexpr size_t O_SSQ = 448u << 10;
constexpr size_t O_VSUMS = 256u << 10;

constexpr int RING_OFF = 0, RING_BYTES = 131072;
constexpr int LDS_BYTES = 147456;
constexpr int LDSCTL_OFF = LDS_BYTES - 1024, MISC_OFF = LDSCTL_OFF + 320;
constexpr int ROWSC_OFF = LDSCTL_OFF - 2048;
constexpr int NWAVES = 8;

typedef __bf16 bf16x2_t __attribute__((ext_vector_type(2)));
__device__ __forceinline__ unsigned cvt_pk_bf16(float lo, float hi) { f32x2 v = {lo, hi}; bf16x2_t b = __builtin_convertvector(v, bf16x2_t); return __builtin_bit_cast(unsigned, b); }
__device__ __forceinline__ float bf2f(unsigned short b) { return __uint_as_float(((unsigned)b) << 16); }
__device__ __forceinline__ float bflo(unsigned w) { return __uint_as_float(w << 16); }
__device__ __forceinline__ float bfhi(unsigned w) { return __uint_as_float(w & 0xffff0000u); }
__device__ __forceinline__ float sigmoidf_(float x) { return __builtin_amdgcn_rcpf(1.0f + __builtin_amdgcn_exp2f(-1.4426950408889634f * x)); }
__device__ __forceinline__ float gelu_tanh(float x) {
    const float y = 2.0f * 0.7978845608028654f * x * (1.0f + 0.044715f * x * x);
    return x * sigmoidf_(y);
}
__device__ __forceinline__ int lane_id() { unsigned z = 0u; asm volatile("" : "+s"(z)); return (int)__builtin_amdgcn_mbcnt_hi(~0u, __builtin_amdgcn_mbcnt_lo(~0u, z)); }
#define LDS_WAIT() asm volatile("s_waitcnt lgkmcnt(0)" ::: "memory")
#define VM_WAIT() asm volatile("s_waitcnt vmcnt(0)" ::: "memory")

namespace pg8 {
constexpr int BM = 256, BK = 64, HALF = 128, HTB = HALF * BK * 2, STAGE_BYTES = 8 * HTB, NXCD = 8, WGM = 8;
__host__ __device__ __forceinline__ int lds_byte(int r, int c) { const int st = (r >> 4) * 2 + (c >> 5), rr = r & 15, cc = c & 31, ob = rr * 64 + cc * 2; return st * 1024 + (ob ^ (((ob >> 9) & 1) << 5)); }
__host__ __device__ __forceinline__ void stage_rc(int b, int& R, int& C) { const int st = b / 1024, sb = b % 1024, swz = sb ^ (((sb >> 9) & 1) << 5); R = (st >> 1) * 16 + swz / 64; C = (st & 1) * 32 + (swz % 64) / 2; }
__host__ __device__ __forceinline__ int perm32(int rho) { const int n = rho >> 4, i = rho & 15; return 8 * (i >> 2) + 4 * n + (i & 3); }

struct Unit { int pm, pn; };
struct Gemm { const bf16_t* A; const bf16_t* Bt; int M, N, K, lda, ldb; };

struct StaticOrder {
    int nM, nN, nwg, G, c;
    __host__ __device__ __forceinline__ void init(int M_, int N_, int G_, int c_) { nM = M_ / BM; nN = N_ / BM; nwg = nM * nN; G = G_; c = c_; }
    __host__ __device__ __forceinline__ bool next(int i, Unit& u) const {
        const long L = (long)i * G + c; if (L >= nwg) return false;
        int wgid = (int)L; { const int q = nwg / NXCD, r = nwg % NXCD, xcd = wgid % NXCD, off = wgid / NXCD; wgid = (xcd < r ? xcd * (q + 1) : r * (q + 1) + (xcd - r) * q) + off; }
        const int nig = WGM * nN, gid = wgid / nig, fm = gid * WGM, gsz = (nM - fm) < WGM ? (nM - fm) : WGM;
        u.pm = fm + ((wgid % nig) % gsz); u.pn = (wgid % nig) / gsz; return true;
    }
    __device__ __forceinline__ void a_ready(const Unit&) const {}
    __device__ __forceinline__ void done(const Unit&) const {}
};


struct EpiInEven {
    static constexpr bool PERM = true, AFTER_DRAIN = false;
    bf16_t* QH; bf16_t* KV; bf16_t* PIN; float* GATES; const float* ROPE;
    __device__ __forceinline__ void operator()(const f32x4 (&acc)[2][2][4][2], const Unit& u, int wr, int wc, int fr, int fq) const {
        const int pn = u.pn;
#pragma unroll
        for (int ai = 0; ai < 2; ++ai)
#pragma unroll
            for (int m = 0; m < 4; ++m) {
                const int row = u.pm * BM + ai * HALF + wr * 64 + m * 16 + fr, b = row >> 12, t = row & 4095;
#pragma unroll
                for (int bj = 0; bj < 2; ++bj) {
                    f32x4 v0 = acc[ai][bj][m][0], v1 = acc[ai][bj][m][1];
                    if (pn < 20) {
                        const bool is_q = pn < 8; const int which = (pn - 8) >> 1;
                        if (wc == 0 && (is_q || !(which & 1))) {
                            f32x4 p0, p1;
#pragma unroll
                            for (int e = 0; e < 4; ++e) { p0[e] = __shfl_xor(v0[e], 32); p1[e] = __shfl_xor(v1[e], 32); }
                            const float* cp = ROPE + t * 16 + 8 * (fq & 1);
                            const f32x4 c0 = *(const f32x4*)cp, c1 = *(const f32x4*)(cp + 4), s0 = *(const f32x4*)(cp + 65536), s1 = *(const f32x4*)(cp + 65536 + 4);
                            if (fq < 2) { v0 = v0 * c0 - p0 * s0; v1 = v1 * c1 - p1 * s1; } else { v0 = v0 * c0 + p0 * s0; v1 = v1 * c1 + p1 * s1; }
                        }
                        const int d0 = wc * 32 + 8 * fq;
                        bf16_t* dst = is_q ? QH + ((size_t)((b * 16 + 2 * pn + bj) * 4096 + t)) * 128 + d0
                                           : KV + (size_t)which * KVSZ + ((size_t)((b * 4 + ((pn - 8) & 1) * 2 + bj) * 4096 + t)) * 128 + d0;
                        u32x4 w; w.x = cvt_pk_bf16(v0[0], v0[1]); w.y = cvt_pk_bf16(v0[2], v0[3]); w.z = cvt_pk_bf16(v1[0], v1[1]); w.w = cvt_pk_bf16(v1[2], v1[3]);
                        *(u32x4*)dst = w;
                    } else if (pn < 28) {
                        u32x4 w; w.x = cvt_pk_bf16(v0[0], v0[1]); w.y = cvt_pk_bf16(v0[2], v0[3]); w.z = cvt_pk_bf16(v1[0], v1[1]); w.w = cvt_pk_bf16(v1[2], v1[3]);
                        *(u32x4*)(PIN + (size_t)row * 2048 + (pn - 20) * 256 + bj * HALF + wc * 32 + 8 * fq) = w;
                    } else {
                        const int col0 = wc * 32 + 8 * fq;
                        if (bj == 0 && col0 <= 40) {
                            f32x4 g0, g1;
#pragma unroll
                            for (int e = 0; e < 4; ++e) { g0[e] = sigmoidf_(v0[e]); g1[e] = sigmoidf_(v1[e]); }
                            float* gp = GATES + (size_t)row * 48 + col0; *(f32x4*)gp = g0; *(f32x4*)(gp + 4) = g1;
                        }
                    }
                }
            }
    }
};
struct EpiScaleBf16 {
    static constexpr bool PERM = true, AFTER_DRAIN = false;
    bf16_t* O; int ldc; const float* scale;
    __device__ __forceinline__ void operator()(const f32x4 (&acc)[2][2][4][2], const Unit& u, int wr, int wc, int fr, int fq) const {
        const int row0 = u.pm * BM + wr * 64 + fr, col0 = u.pn * BM + wc * 32 + 8 * fq;
#pragma unroll
        for (int bj = 0; bj < 2; ++bj) {
            const f32x4 sc0 = *(const f32x4*)(scale + col0 + bj * HALF), sc1 = *(const f32x4*)(scale + col0 + bj * HALF + 4);
#pragma unroll
            for (int ai = 0; ai < 2; ++ai)
#pragma unroll
                for (int m = 0; m < 4; ++m) { const f32x4 v0 = acc[ai][bj][m][0] * sc0, v1 = acc[ai][bj][m][1] * sc1;
                    u32x4 w; w.x = cvt_pk_bf16(v0[0], v0[1]); w.y = cvt_pk_bf16(v0[2], v0[3]); w.z = cvt_pk_bf16(v1[0], v1[1]); w.w = cvt_pk_bf16(v1[2], v1[3]);
                    *(u32x4*)(O + (size_t)(row0 + ai * HALF + m * 16) * ldc + col0 + bj * HALF) = w; }
        }
    }
};
template <bool BASE_F32> struct EpiResid {
    static constexpr bool PERM = true, AFTER_DRAIN = false;
    const void* base; bf16_t* out; int ldc; float* ssqp;
    __device__ __forceinline__ void operator()(const f32x4 (&acc)[2][2][4][2], const Unit& u, int wr, int wc, int fr, int fq) const {
        const int row0 = u.pm * BM + wr * 64 + fr, col0 = u.pn * BM + wc * 32 + 8 * fq;
#pragma unroll
        for (int ai = 0; ai < 2; ++ai) { f32x4 b0[4][2], b1[4][2];
#pragma unroll
            for (int m = 0; m < 4; ++m) { const size_t off = (size_t)(row0 + ai * HALF + m * 16) * ldc + col0;
#pragma unroll
                for (int bj = 0; bj < 2; ++bj) {
                    if constexpr (BASE_F32) { const float* bp = (const float*)base + off + bj * HALF; b0[m][bj] = *(const f32x4*)bp; b1[m][bj] = *(const f32x4*)(bp + 4); }
                    else { const u32x4 w = *(const u32x4*)((const bf16_t*)base + off + bj * HALF); b0[m][bj] = (f32x4){bflo(w.x), bfhi(w.x), bflo(w.y), bfhi(w.y)}; b1[m][bj] = (f32x4){bflo(w.z), bfhi(w.z), bflo(w.w), bfhi(w.w)}; } } }
#pragma unroll
            for (int m = 0; m < 4; ++m) { const int row = row0 + ai * HALF + m * 16; const size_t off = (size_t)row * ldc + col0; float sq = 0.f;
#pragma unroll
                for (int bj = 0; bj < 2; ++bj) { const f32x4 o0 = b0[m][bj] + acc[ai][bj][m][0], o1 = b1[m][bj] + acc[ai][bj][m][1];
                    sq += ((o0[0] * o0[0] + o0[1] * o0[1]) + (o0[2] * o0[2] + o0[3] * o0[3])) + ((o1[0] * o1[0] + o1[1] * o1[1]) + (o1[2] * o1[2] + o1[3] * o1[3]));
                    u32x4 w; w.x = cvt_pk_bf16(o0[0], o0[1]); w.y = cvt_pk_bf16(o0[2], o0[3]); w.z = cvt_pk_bf16(o1[0], o1[1]); w.w = cvt_pk_bf16(o1[2], o1[3]);
                    *(u32x4*)(out + off + bj * HALF) = w; }
                sq += __shfl_xor(sq, 16); sq += __shfl_xor(sq, 32);
                if (fq == 0) ssqp[(size_t)row * 64 + u.pn * 4 + wc] = sq; }
            asm volatile("" ::: "memory"); }
    }
};
__device__ __forceinline__ float row_rstd_from_partials(const float* ssqp, int row) { const f32x4* p = (const f32x4*)(ssqp + (size_t)row * 64); float t = 0.f;
#pragma unroll
    for (int i = 0; i < 16; ++i) { const f32x4 v = p[i]; t += (v[0] + v[1]) + (v[2] + v[3]); }
    return 1.0f / sqrtf(t * (1.0f / DM) + EPS); }
struct RowScale { const LAS float* tab; int pm0;
    __device__ __forceinline__ float get(int pm, int r_in_panel) const { return pm == pm0 ? tab[r_in_panel] : __builtin_nanf(""); } };
__device__ __forceinline__ void build_row_scale(LAS float* tab, const float* ssqp, int pm, int tid) {
    const int r = tid >> 1, h = tid & 1; const f32x4* p = (const f32x4*)(ssqp + (size_t)(pm * 256 + r) * 64 + 32 * h); float t = 0.f;
#pragma unroll
    for (int i = 0; i < 8; ++i) { const f32x4 v = p[i]; t += (v[0] + v[1]) + (v[2] + v[3]); }
    const float o = __shfl_xor(t, 1); const float tot = h ? (o + t) : (t + o);
    if (h == 0) tab[r] = 1.0f / sqrtf(tot * (1.0f / DM) + EPS); }
struct EpiSwiGLU {
    static constexpr bool PERM = true, AFTER_DRAIN = false;
    bf16_t* H; int ldc; RowScale rsc;
    __device__ __forceinline__ void operator()(const f32x4 (&acc)[2][2][4][2], const Unit& u, int wr, int wc, int fr, int fq) const {
        const int row0 = u.pm * BM + wr * 64 + fr, col0 = u.pn * HALF + wc * 32 + 8 * fq;
        float rs[2][4];
#pragma unroll
        for (int ai = 0; ai < 2; ++ai)
#pragma unroll
            for (int m = 0; m < 4; ++m) rs[ai][m] = rsc.get(u.pm, ai * HALF + wr * 64 + m * 16 + fr);
#pragma unroll
        for (int ai = 0; ai < 2; ++ai)
#pragma unroll
            for (int m = 0; m < 4; ++m) { f32x4 h0, h1; const float r = rs[ai][m];
#pragma unroll
                for (int e = 0; e < 4; ++e) { const float g0 = acc[ai][0][m][0][e] * r, g1 = acc[ai][0][m][1][e] * r;
                    h0[e] = g0 * sigmoidf_(g0) * (acc[ai][1][m][0][e] * r); h1[e] = g1 * sigmoidf_(g1) * (acc[ai][1][m][1][e] * r); }
                u32x4 w; w.x = cvt_pk_bf16(h0[0], h0[1]); w.y = cvt_pk_bf16(h0[2], h0[3]); w.z = cvt_pk_bf16(h1[0], h1[1]); w.w = cvt_pk_bf16(h1[2], h1[3]);
                *(u32x4*)(H + (size_t)(row0 + ai * HALF + m * 16) * ldc + col0) = w; }
    }
};
struct EpiGeluSplit {
    static constexpr bool PERM = true, AFTER_DRAIN = false;
    bf16_t* O0; bf16_t* O1; int ldc; int split; float* part; RowScale rsc;
    __device__ __forceinline__ void operator()(const f32x4 (&acc)[2][2][4][2], const Unit& u, int wr, int wc, int fr, int fq) const {
        const int row0 = u.pm * BM + wr * 64 + fr; int colt = u.pn * BM; bf16_t* base = O0;
        const bool is_v = colt >= split;
        if (is_v) { base = O1; colt -= split; }
        const int col0 = colt + wc * 32 + 8 * fq;
#pragma unroll
        for (int ai = 0; ai < 2; ++ai)
#pragma unroll
            for (int m = 0; m < 4; ++m) { float s1 = 0.f, s2 = 0.f; const float r = rsc.get(u.pm, ai * HALF + wr * 64 + m * 16 + fr);
#pragma unroll
                for (int bj = 0; bj < 2; ++bj) { f32x4 v0, v1;
#pragma unroll
                    for (int e = 0; e < 4; ++e) { v0[e] = gelu_tanh(acc[ai][bj][m][0][e] * r); v1[e] = gelu_tanh(acc[ai][bj][m][1][e] * r); }
                    u32x4 w; w.x = cvt_pk_bf16(v0[0], v0[1]); w.y = cvt_pk_bf16(v0[2], v0[3]); w.z = cvt_pk_bf16(v1[0], v1[1]); w.w = cvt_pk_bf16(v1[2], v1[3]);
                    *(u32x4*)(base + (size_t)(row0 + ai * HALF + m * 16) * ldc + col0 + bj * HALF) = w;
                    if (is_v) {
                        const float r0 = bflo(w.x), r1 = bfhi(w.x), r2 = bflo(w.y), r3 = bfhi(w.y), r4 = bflo(w.z), r5 = bfhi(w.z), r6 = bflo(w.w), r7 = bfhi(w.w);
                        s1 += ((r0 + r1) + (r2 + r3)) + ((r4 + r5) + (r6 + r7)); s2 += ((r0 * r0 + r1 * r1) + (r2 * r2 + r3 * r3)) + ((r4 * r4 + r5 * r5) + (r6 * r6 + r7 * r7)); } }
                if (is_v) {
                    s1 += __shfl_xor(s1, 16); s1 += __shfl_xor(s1, 32); s2 += __shfl_xor(s2, 16); s2 += __shfl_xor(s2, 32);
                    if (fq == 0) { float* sp = part + ((size_t)(row0 + ai * HALF + m * 16) * 192 + (size_t)(u.pn - split / BM) * 4 + wc) * 2; *(f32x2*)sp = (f32x2){s1, s2}; } } }
    }
};

template <class Epi, class Sched, bool ALIGN_EPI = false, bool SP2 = false>
__device__ __forceinline__ void gemm_phase(LAS unsigned char* lds, const Gemm g, const Sched& S, const Epi& E, int wid, int lane) {
    const int tid = wid * 64 + lane, wr = wid >> 2, wc = wid & 3, fr = lane & 15, fq = lane >> 4;
    const int K = g.K, nt = K / BK;
    unsigned voffA[2], voffB[2];
#pragma unroll
    for (int i = 0; i < 2; ++i) { int R, C; stage_rc(tid * 16 + i * 8192, R, C); const int Rb = Epi::PERM ? ((R & ~31) + perm32(R & 31)) : R;
        voffA[i] = (unsigned)(R * g.lda + C) * 2u; voffB[i] = (unsigned)(Rb * g.ldb + C) * 2u; }
    const size_t kstep = (size_t)(BK * 2);
    const size_t hsA = (size_t)HALF * g.lda * 2, hsB = (size_t)HALF * g.ldb * 2;
    const size_t tsA = 2 * hsA, tsB = 2 * hsB;
    const unsigned ldsw = (unsigned)wid * 1024u;
    const int aoff = lds_byte(wr * 64 + fr, fq * 8), boff = lds_byte(wc * 32 + fr, fq * 8);
#define PG8_SA(b, h) (((b) * 2 + (h)) * HTB)
#define PG8_SB(b, h) ((4 + (b) * 2 + (h)) * HTB)
#define PG8_STAGE(bufoff, gbase, voff) do { _Pragma("unroll") for (int _i = 0; _i < 2; ++_i) \
        __builtin_amdgcn_global_load_lds((const unsigned*)((const char*)(gbase) + (voff)[_i]), (LAS unsigned*)(lds + (bufoff) + ldsw + _i * 8192), 16, 0, 0); } while (0)
#define PG8_LDA(dst, b, h) do { _Pragma("unroll") for (int m = 0; m < 4; ++m) _Pragma("unroll") for (int k = 0; k < 2; ++k) dst[m][k] = *(const LAS bf16x8*)(lds + PG8_SA(b, h) + aoff + m * 2048 + k * 1024); } while (0)
#define PG8_LDB(dst, b, h) do { _Pragma("unroll") for (int n = 0; n < 2; ++n) _Pragma("unroll") for (int k = 0; k < 2; ++k) dst[n][k] = *(const LAS bf16x8*)(lds + PG8_SB(b, h) + boff + n * 2048 + k * 1024); } while (0)
#define PG8_MMA(ai, bj, At, Bt) do { __builtin_amdgcn_s_setprio(1); _Pragma("unroll") for (int m = 0; m < 4; ++m) _Pragma("unroll") for (int n = 0; n < 2; ++n) _Pragma("unroll") for (int k = 0; k < 2; ++k) \
        acc[ai][bj][m][n] = __builtin_amdgcn_mfma_f32_16x16x32_bf16(Bt[n][k], At[m][k], acc[ai][bj][m][n], 0, 0, 0); __builtin_amdgcn_s_setprio(0); } while (0)
#define PG8_WAIT_V(n) asm volatile("s_waitcnt vmcnt(" #n ")" ::: "memory")
#define PG8_WAIT_L(n) asm volatile("s_waitcnt lgkmcnt(" #n ")" ::: "memory")
#define PG8_BAR __builtin_amdgcn_s_barrier()
#define PG8_SCHED __builtin_amdgcn_sched_barrier(0)
    Unit cur, nxt; int ui = 0;
    if (!S.next(0, cur)) return;
    f32x4 acc[2][2][4][2];
#pragma unroll
    for (int a = 0; a < 2; ++a)
#pragma unroll
        for (int b = 0; b < 2; ++b)
#pragma unroll
            for (int m = 0; m < 4; ++m)
#pragma unroll
                for (int n = 0; n < 2; ++n) acc[a][b][m][n] = (f32x4){0.f, 0.f, 0.f, 0.f};
    bf16x8 At[4][2], B0[2][2], B1[2][2];
    const char* cA = (const char*)g.A + (size_t)cur.pm * tsA; const char* cB = (const char*)g.Bt + (size_t)cur.pn * tsB;
    S.a_ready(cur);
    if constexpr (SP2) {
        PG8_STAGE(PG8_SB(0, 0), cB, voffB); PG8_STAGE(PG8_SB(0, 1), cB + hsB, voffB); PG8_STAGE(PG8_SA(0, 0), cA, voffA); PG8_STAGE(PG8_SA(0, 1), cA + hsA, voffA);
        if (wr == 1) PG8_BAR;
        PG8_WAIT_V(2); PG8_BAR;
        PG8_STAGE(PG8_SB(1, 0), cB + kstep, voffB); PG8_STAGE(PG8_SA(1, 0), cA + kstep, voffA); PG8_STAGE(PG8_SB(1, 1), cB + hsB + kstep, voffB);
        PG8_WAIT_V(6); PG8_BAR;
    } else {
        PG8_STAGE(PG8_SB(0, 0), cB, voffB); PG8_STAGE(PG8_SA(0, 0), cA, voffA); PG8_STAGE(PG8_SB(0, 1), cB + hsB, voffB); PG8_STAGE(PG8_SA(0, 1), cA + hsA, voffA);
        if (wr == 1) PG8_BAR;
        PG8_WAIT_V(4); PG8_BAR;
        PG8_STAGE(PG8_SB(1, 0), cB + kstep, voffB); PG8_STAGE(PG8_SA(1, 0), cA + kstep, voffA); PG8_STAGE(PG8_SB(1, 1), cB + hsB + kstep, voffB);
        PG8_WAIT_V(6); PG8_BAR;
    }
    for (;;) {
        const bool has_next = S.next(ui + 1, nxt);
        const char* nA = has_next ? (const char*)g.A + (size_t)nxt.pm * tsA : cA; const char* nB = has_next ? (const char*)g.Bt + (size_t)nxt.pn * tsB : cB;
        for (int t = 0; t < nt; t += 2) {
            const bool last = (t == nt - 2);
            const char* a1 = cA + (size_t)(t + 1) * kstep;
            const char* a2 = last ? nA : cA + (size_t)(t + 2) * kstep; const char* b2 = last ? nB : cB + (size_t)(t + 2) * kstep;
            const char* a3 = a2 + kstep; const char* b3 = b2 + kstep;
            if (last && has_next) S.a_ready(nxt);
            if constexpr (SP2) {
            PG8_LDB(B0, 0, 0); PG8_LDB(B1, 0, 1); PG8_SCHED; PG8_LDA(At, 0, 0); PG8_STAGE(PG8_SA(1, 1), a1 + hsA, voffA);
            PG8_WAIT_V(8); PG8_WAIT_L(0); PG8_BAR; PG8_MMA(0, 0, At, B0); PG8_MMA(0, 1, At, B1); PG8_BAR; PG8_SCHED;
            PG8_LDA(At, 0, 1); PG8_STAGE(PG8_SB(0, 0), b2, voffB); PG8_STAGE(PG8_SB(0, 1), b2 + hsB, voffB); PG8_STAGE(PG8_SA(0, 0), a2, voffA);
            PG8_WAIT_V(8); PG8_WAIT_L(0); PG8_BAR; PG8_MMA(1, 0, At, B0); PG8_MMA(1, 1, At, B1); PG8_BAR; PG8_SCHED;
            PG8_LDB(B0, 1, 0); PG8_LDB(B1, 1, 1); PG8_SCHED; PG8_LDA(At, 1, 0); PG8_STAGE(PG8_SA(0, 1), a2 + hsA, voffA);
            PG8_WAIT_V(8); PG8_WAIT_L(0); PG8_BAR; PG8_MMA(0, 0, At, B0); PG8_MMA(0, 1, At, B1); PG8_BAR; PG8_SCHED;
            PG8_LDA(At, 1, 1); PG8_STAGE(PG8_SB(1, 0), b3, voffB); PG8_STAGE(PG8_SB(1, 1), b3 + hsB, voffB); PG8_STAGE(PG8_SA(1, 0), a3, voffA);
            PG8_WAIT_V(8); PG8_WAIT_L(0); PG8_BAR; PG8_MMA(1, 0, At, B0); PG8_MMA(1, 1, At, B1); PG8_BAR; PG8_SCHED;
            } else {
            PG8_LDB(B0, 0, 0); PG8_SCHED; PG8_LDA(At, 0, 0); PG8_STAGE(PG8_SA(1, 1), a1 + hsA, voffA);
            PG8_WAIT_L(8); PG8_BAR; PG8_WAIT_L(0); PG8_MMA(0, 0, At, B0); PG8_BAR; PG8_SCHED;
            PG8_LDB(B1, 0, 1); PG8_STAGE(PG8_SB(0, 0), b2, voffB);
            PG8_BAR; PG8_WAIT_L(0); PG8_MMA(0, 1, At, B1); PG8_BAR;
            PG8_LDA(At, 0, 1); PG8_STAGE(PG8_SA(0, 0), a2, voffA);
            PG8_BAR; PG8_WAIT_L(0); PG8_MMA(1, 0, At, B0); PG8_BAR; PG8_SCHED;
            PG8_STAGE(PG8_SB(0, 1), b2 + hsB, voffB);
            PG8_WAIT_V(6); PG8_BAR; PG8_MMA(1, 1, At, B1); PG8_BAR;
            PG8_LDB(B0, 1, 0); PG8_SCHED; PG8_LDA(At, 1, 0); PG8_STAGE(PG8_SA(0, 1), a2 + hsA, voffA);
            PG8_WAIT_L(8); PG8_BAR; PG8_WAIT_L(0); PG8_MMA(0, 0, At, B0); PG8_BAR; PG8_SCHED;
            PG8_LDB(B1, 1, 1); PG8_STAGE(PG8_SB(1, 0), b3, voffB);
            PG8_BAR; PG8_WAIT_L(0); PG8_MMA(0, 1, At, B1); PG8_BAR;
            PG8_LDA(At, 1, 1); PG8_STAGE(PG8_SA(1, 0), a3, voffA);
            PG8_BAR; PG8_WAIT_L(0); PG8_MMA(1, 0, At, B0); PG8_BAR; PG8_SCHED;
            PG8_STAGE(PG8_SB(1, 1), b3 + hsB, voffB);
            PG8_WAIT_V(6); PG8_BAR; PG8_MMA(1, 1, At, B1); PG8_BAR;
            }
        }
        if constexpr (ALIGN_EPI) { if (wr == 0) PG8_BAR; }
        if constexpr (!Epi::AFTER_DRAIN) { E(acc, cur, wr, wc, fr, fq); S.done(cur); }
        if (!has_next) break;
#pragma unroll
        for (int a = 0; a < 2; ++a)
#pragma unroll
            for (int b = 0; b < 2; ++b)
#pragma unroll
                for (int m = 0; m < 4; ++m)
#pragma unroll
                    for (int n = 0; n < 2; ++n) acc[a][b][m][n] = (f32x4){0.f, 0.f, 0.f, 0.f};
        cur = nxt; cA = nA; cB = nB; ++ui;
        if constexpr (ALIGN_EPI) { if (wr == 1) PG8_BAR; }
    }
    PG8_WAIT_V(0);
    if constexpr (!ALIGN_EPI) { if (wr == 0) PG8_BAR; }
    PG8_BAR;
#undef PG8_SA
#undef PG8_SB
#undef PG8_STAGE
#undef PG8_LDA
#undef PG8_LDB
#undef PG8_MMA
#undef PG8_WAIT_V
#undef PG8_WAIT_L
#undef PG8_BAR
#undef PG8_SCHED
}
}

namespace swa {
constexpr int D = 128;
constexpr float SCALE = 0.08838834764831845f;
constexpr float THR = 8.f;
constexpr int NW = 8, QBLK = 32, KVBLK = 64, QB = NW * QBLK;
constexpr int SHM_V = KVBLK * D * 2, SHM_K = KVBLK * D * 2;
constexpr int LDS_BYTES_ATT = 2 * SHM_V + 2 * SHM_K + NW * 64 * 4;
#define KSWZ(row, colB) ((row) * 256 + ((colB) ^ (((row) & 7) << 4)))
#define SBAR() __builtin_amdgcn_sched_barrier(0)
__device__ __forceinline__ int v_st(int k, int c) { const int kk = (k & ~0xC) | ((k & 4) << 1) | ((k & 8) >> 1); return ((kk >> 3) * 4 + (c >> 5)) * 512 + ((kk & 7) * 32 + (c & 31)) * 2; }
__device__ __forceinline__ int v_rd_base(int lane) { return ((lane & 3) << 3) | (((lane >> 2) & 3) << 6) | (((lane >> 4) & 1) << 5) | (((lane >> 5) & 1) << 8); }
constexpr int v_rd_off(int d0, int ks, int half) { return d0 * 512 + ks * 4096 + half * 2048; }
__device__ __forceinline__ int crow(int r, int hi) { return (r & 3) + 8 * (r >> 2) + 4 * hi; }
__device__ __forceinline__ bf16x8 load8(const bf16_t* p) { return *reinterpret_cast<const bf16x8*>(p); }
__device__ __forceinline__ void mask_tile(f32x16& p0, f32x16& p1, int dq, unsigned W) {
    const float NEG = -__builtin_inff();
#pragma unroll
    for (int r = 0; r < 16; ++r) {
        const int c = (r & 3) + 8 * (r >> 2);
        if ((unsigned)(dq - c) >= W) p0[r] = NEG;
        if ((unsigned)(dq - c - 32) >= W) p1[r] = NEG;
    }
}
__device__ __forceinline__ void partialSM(f32x16& p0, f32x16& p1, float& m_reg, float& mn, float& alpha) {
    float pmax = p0[0];
#pragma unroll
    for (int r = 1; r < 16; ++r) pmax = fmaxf(pmax, p0[r]);
#pragma unroll
    for (int r = 0; r < 16; ++r) pmax = fmaxf(pmax, p1[r]);
    { auto rr = __builtin_amdgcn_permlane32_swap(__float_as_uint(pmax), __float_as_uint(pmax), false, false);
      pmax = fmaxf(__uint_as_float(rr[0]), __uint_as_float(rr[1])); }
    constexpr float C2 = 1.4426950408889634f * SCALE;
    if (__builtin_expect(__all((pmax - m_reg) * SCALE <= THR), 1)) { mn = m_reg; alpha = 1.f; }
    else { mn = fmaxf(m_reg, pmax); alpha = __builtin_amdgcn_exp2f((m_reg - mn) * C2); m_reg = mn; }
    const float mnL = -mn * C2;
#pragma unroll
    for (int r = 0; r < 16; ++r) p0[r] = fmaf(p0[r], C2, mnL);
#pragma unroll
    for (int r = 0; r < 16; ++r) p1[r] = fmaf(p1[r], C2, mnL);
#pragma unroll
    for (int r = 0; r < 16; ++r) p0[r] = __builtin_amdgcn_exp2f(p0[r]);
}
__device__ __forceinline__ void finishSM(f32x16& p0, f32x16& p1, float alpha, float& l_reg, bf16x8& pa0, bf16x8& pa1, bf16x8& pa2, bf16x8& pa3) {
#pragma unroll
    for (int r = 0; r < 16; ++r) p1[r] = __builtin_amdgcn_exp2f(p1[r]);
    float ps = 0;
#pragma unroll
    for (int r = 0; r < 16; ++r) ps += p0[r];
#pragma unroll
    for (int r = 0; r < 16; ++r) ps += p1[r];
    { auto rr = __builtin_amdgcn_permlane32_swap(__float_as_uint(ps), __float_as_uint(ps), false, false);
      ps = __uint_as_float(rr[0]) + __uint_as_float(rr[1]); }
    l_reg = l_reg * alpha + ps;
#define PK4(P, B_, OUT) do { unsigned a0 = cvt_pk_bf16(P[B_+0], P[B_+1]), a1 = cvt_pk_bf16(P[B_+2], P[B_+3]);                          \
        unsigned b0 = cvt_pk_bf16(P[B_+4], P[B_+5]), b1 = cvt_pk_bf16(P[B_+6], P[B_+7]);                                             \
        auto r0 = __builtin_amdgcn_permlane32_swap(a0, b0, false, false); auto r1 = __builtin_amdgcn_permlane32_swap(a1, b1, false, false); \
        u32x4 w = {r0[0], r1[0], r0[1], r1[1]}; OUT = *reinterpret_cast<bf16x8*>(&w); } while (0)
    PK4(p0, 0, pa0); PK4(p0, 8, pa1); PK4(p1, 0, pa2); PK4(p1, 8, pa3);
#undef PK4
}
template <int KB, bool SK>
__device__ __forceinline__ void qkt(f32x16& p0, f32x16& p1, const char* K_lds, int r32, int hi, const bf16x8* qr, bool act) {
    if (SK && !act) { const float NEG = -__builtin_inff();
#pragma unroll
        for (int r = 0; r < 16; ++r) { p0[r] = NEG; p1[r] = NEG; } return; }
    p0 = f32x16{}; p1 = f32x16{};
    const char* kb[4];
#pragma unroll
    for (int dd = 0; dd < 4; ++dd) kb[dd] = K_lds + KB * SHM_K + KSWZ(r32, (dd * 16 + hi * 8) * 2);
#pragma unroll
    for (int d0 = 0; d0 < 8; ++d0) { const char* a = kb[d0 & 3] + (d0 >> 2) * 128;
        bf16x8 b0 = *reinterpret_cast<const bf16x8*>(a);
        bf16x8 b1 = *reinterpret_cast<const bf16x8*>(a + 32 * 256);
        p0 = __builtin_amdgcn_mfma_f32_32x32x16_bf16(b0, qr[d0], p0, 0, 0, 0);
        p1 = __builtin_amdgcn_mfma_f32_32x32x16_bf16(b1, qr[d0], p1, 0, 0, 0); }
}
template <int VB, bool SK>
__device__ __forceinline__ void pv_tile(f32x16* o, int vb0, bf16x8 pa0, bf16x8 pa1, bf16x8 pa2, bf16x8 pa3, bool act) {
    if (SK && !act) return;
#define TRRD(dst, off) asm volatile("ds_read_b64_tr_b16 %0, %1 offset:%2" : "=&v"(dst) : "v"(vb0), "i"(off) : "memory")
#define PV_D0(d0) do { s16x4 l0, l1, l2, l3, h0, h1, h2, h3; constexpr int b_ = VB * SHM_V + v_rd_off(d0, 0, 0); \
        TRRD(l0, b_); TRRD(h0, b_ + 2048); TRRD(l1, b_ + 4096); TRRD(h1, b_ + 6144); TRRD(l2, b_ + 8192); TRRD(h2, b_ + 10240); TRRD(l3, b_ + 12288); TRRD(h3, b_ + 14336); \
        asm volatile("s_waitcnt lgkmcnt(0)" ::: "memory"); SBAR();   \
        o[d0] = __builtin_amdgcn_mfma_f32_32x32x16_bf16(pa0, (bf16x8){l0[0], l0[1], l0[2], l0[3], h0[0], h0[1], h0[2], h0[3]}, o[d0], 0, 0, 0);   \
        o[d0] = __builtin_amdgcn_mfma_f32_32x32x16_bf16(pa1, (bf16x8){l1[0], l1[1], l1[2], l1[3], h1[0], h1[1], h1[2], h1[3]}, o[d0], 0, 0, 0);   \
        o[d0] = __builtin_amdgcn_mfma_f32_32x32x16_bf16(pa2, (bf16x8){l2[0], l2[1], l2[2], l2[3], h2[0], h2[1], h2[2], h2[3]}, o[d0], 0, 0, 0);   \
        o[d0] = __builtin_amdgcn_mfma_f32_32x32x16_bf16(pa3, (bf16x8){l3[0], l3[1], l3[2], l3[3], h3[0], h3[1], h3[2], h3[3]}, o[d0], 0, 0, 0); } while (0)
    PV_D0(0); PV_D0(1); PV_D0(2); PV_D0(3);
#undef PV_D0
#undef TRRD
}
struct BlockRef { const bf16_t* Q; const bf16_t* K; const bf16_t* V; int P0; int b, h; };
struct Seam { bf16x8 qr[8]; bf16x8 st_v0, st_v1, st_k0, st_k1; };
struct Ctx { float* OACC; bf16_t* CAT; const float* GATES; const unsigned long long* SEL; };
__device__ __forceinline__ int swa_jlo(int P0, int W) { const int lowk = P0 - W + 1; return lowk > 0 ? lowk / KVBLK : 0; }
#define ROWU(p, k0, h) ((p) + (size_t)((k0) + 32 * (h)) * D + loff)
#define VMW() asm volatile("s_waitcnt vmcnt(0)" ::: "memory")
#define VMWN(n) asm volatile("s_waitcnt vmcnt(%0)" :: "i"(n) : "memory")
#define SLOAD_H(Kp, Vp, k0) do { S.st_v0 = load8(ROWU(Vp, k0, 0)); S.st_v1 = load8(ROWU(Vp, k0, 1));              \
                         S.st_k0 = load8(ROWU(Kp, k0, 0)); S.st_k1 = load8(ROWU(Kp, k0, 1)); } while (0)
#define SWRITE_HK(bf) do { *(bf16x8*)(K_lds + (bf) * SHM_K + kws) = S.st_k0; *(bf16x8*)(K_lds + (bf) * SHM_K + kws + 32 * 256) = S.st_k1; } while (0)
#define SWRITE_HV(bf) do { *(bf16x8*)(V_lds + (bf) * SHM_V + vst0) = S.st_v0; *(bf16x8*)(V_lds + (bf) * SHM_V + vst1) = S.st_v1; } while (0)
#define SWRITE_H(bf) do { SWRITE_HV(bf); SWRITE_HK(bf); } while (0)
__device__ __forceinline__ void swa_prime(const BlockRef& cur, int W, char* lds, Seam& S, int wid, int lane) {
    const int tid = wid * 64 + lane, r32 = lane & 31, hi = lane >> 5;
    const int sr = tid >> 4, sc = (tid & 15) * 8, kws = KSWZ(sr, sc * 2); char* K_lds = lds + 2 * SHM_V;
    const unsigned loff = (unsigned)(sr * D + sc), qoff = (unsigned)(r32 * D + hi * 8);
    const int kb0 = swa_jlo(cur.P0, W) * KVBLK;
#pragma unroll
    for (int d0 = 0; d0 < 8; ++d0) S.qr[d0] = load8(cur.Q + (size_t)(wid * QBLK) * D + d0 * 16 + qoff);
    SLOAD_H(cur.K, cur.V, kb0); VMW(); SWRITE_HK(0);
    __syncthreads();
}
template <int MODE, bool SK>
__device__ __forceinline__ void swa_block(const BlockRef& cur, const BlockRef& nxt, int W, int Wn, char* lds, Seam& S, const Ctx& X, int wid, int lane) {
    constexpr int skv = 4096;
    const int tid = wid * 64 + lane, r32 = lane & 31, hi = lane >> 5;
    const int j_lo = swa_jlo(cur.P0, W);
    int j_hi = (cur.P0 + QB - 1) / KVBLK + 1; if (j_hi > skv / KVBLK) j_hi = skv / KVBLK;
    const int NT = j_hi - j_lo;
    const int kbn = swa_jlo(nxt.P0, Wn) * KVBLK;
    const int qlo = cur.P0 + wid * QBLK, qm = qlo + r32 - 4 * hi;
    char* V_lds = lds; char* K_lds = lds + 2 * SHM_V;
    float* ws = (float*)(lds + 2 * SHM_V + 2 * SHM_K) + wid * 64; float* li_l = ws, * al_l = ws + 32;
    float m_reg = -1e30f, l_reg = 0; f32x16 o[4] = {};
    const int sr = tid >> 4, sc = (tid & 15) * 8, vst0 = v_st(sr, sc), vst1 = v_st(32 + sr, sc), kws = KSWZ(sr, sc * 2);
    const unsigned loff = (unsigned)(sr * D + sc), qoff = (unsigned)(r32 * D + hi * 8);
    const int vb0 = (int)(uintptr_t)V_lds + v_rd_base(lane);
    const bf16_t* Kh = cur.K; const bf16_t* Vh = cur.V;
    unsigned long long sel_ = ~0ull;
    if constexpr (MODE == 1) sel_ = X.SEL[(size_t)(cur.b * NG + (cur.h >> 2)) * T + qlo + r32];
#define RESC(a) do { if (__any((a) < 1.f)) { if (hi == 0) al_l[r32] = (a); asm volatile("s_waitcnt lgkmcnt(0)" ::: "memory");              \
                     for (int d_ = 0; d_ < 4; ++d_) for (int r = 0; r < 16; ++r) o[d_][r] *= al_l[crow(r, hi)]; } } while (0)
#define KBASE(t) ((j_lo + (t)) * KVBLK)
#define ACT(t) (KBASE(t) <= qlo + QBLK - 1 && KBASE(t) + KVBLK - 1 >= qlo - W + 1)
#define MASKT(P0_, P1_, t) do { const int kb_ = KBASE(t); if ((!SK || ACT(t)) && (kb_ + KVBLK - 1 > qlo || kb_ <= qlo + QBLK - 1 - W)) mask_tile(P0_, P1_, qm - kb_, (unsigned)W); \
        if constexpr (MODE == 1) { if (!((sel_ >> (j_lo + (t))) & 1ull)) { const float NEG_ = -__builtin_inff(); _Pragma("unroll") for (int r_ = 0; r_ < 16; ++r_) { P0_[r_] = NEG_; P1_[r_] = NEG_; } } } } while (0)
    constexpr int NQL = 8;
#define SEAM_K0() do { VMWN(NQL); SWRITE_HK(0); SBAR(); } while (0)
    f32x16 pA0, pA1, pB0, pB1; float mnA, mnB, alA, alB; bf16x8 pa0, pa1, pa2, pa3;
    SWRITE_HV(0); SBAR();
    if (NT > 1) { SLOAD_H(Kh, Vh, KBASE(1)); }
    SBAR(); qkt<0, SK>(pA0, pA1, K_lds, r32, hi, S.qr, ACT(0));
    MASKT(pA0, pA1, 0); partialSM(pA0, pA1, m_reg, mnA, alA);
    if (NT > 1) { VMW(); SWRITE_H(1); }
    __syncthreads();
#define HALF_STEP(PX0, PX1, mnX, alX, PY0, PY1, alY, t, KB, VB, SB) do {                                                      \
        SBAR(); qkt<KB, SK>(PX0, PX1, K_lds, r32, hi, S.qr, ACT(t));                                             \
        finishSM(PY0, PY1, alY, l_reg, pa0, pa1, pa2, pa3); SBAR();                                                           \
        if ((t) + 1 < NT) { SLOAD_H(Kh, Vh, KBASE((t) + 1)); SBAR(); }                                               \
        pv_tile<VB, SK>(o, vb0, pa0, pa1, pa2, pa3, ACT((t) - 1)); MASKT(PX0, PX1, (t)); partialSM(PX0, PX1, m_reg, mnX, alX);                                        \
        __syncthreads();                                                                                                      \
        if ((t) + 1 < NT) { VMW(); SWRITE_H(SB); }                                                                          \
        RESC(alX); __syncthreads(); } while (0)
    for (int t = 1; t + 1 < NT; t += 2) {
        HALF_STEP(pB0, pB1, mnB, alB, pA0, pA1, alA, t, 1, 0, 0);
        HALF_STEP(pA0, pA1, mnA, alA, pB0, pB1, alB, t + 1, 0, 1, 1);
    }
    const bool even = (NT & 1) == 0;
    if (even) { SBAR(); qkt<1, SK>(pB0, pB1, K_lds, r32, hi, S.qr, ACT(NT - 1)); SBAR(); }
    SLOAD_H(nxt.K, nxt.V, kbn); SBAR();
#pragma unroll
    for (int d0 = 0; d0 < 8; ++d0) S.qr[d0] = load8(nxt.Q + (size_t)(wid * QBLK) * D + d0 * 16 + qoff);
    SBAR();
    finishSM(pA0, pA1, alA, l_reg, pa0, pa1, pa2, pa3); SBAR();
    pv_tile<0, SK>(o, vb0, pa0, pa1, pa2, pa3, ACT(even ? NT - 2 : NT - 1));
    if (even) { MASKT(pB0, pB1, NT - 1); partialSM(pB0, pB1, m_reg, mnB, alB); __syncthreads(); RESC(alB);
        finishSM(pB0, pB1, alB, l_reg, pa0, pa1, pa2, pa3); SBAR(); pv_tile<1, SK>(o, vb0, pa0, pa1, pa2, pa3, ACT(NT - 1)); }
    SBAR(); SEAM_K0();
    if (hi == 0) li_l[r32] = __builtin_amdgcn_rcpf(l_reg) * X.GATES[(size_t)(cur.b * T + qlo + r32) * 48 + 3 * cur.h + (MODE == 1 ? 1 : 2)];
    asm volatile("s_waitcnt lgkmcnt(0)" ::: "memory");
    float rli[16];
#pragma unroll
    for (int r = 0; r < 16; ++r) rli[r] = li_l[crow(r, hi)];
    int hie = hi; asm volatile("" : "+v"(hie));
    const unsigned eo = (unsigned)(4 * hie * D + r32), ec = (unsigned)(4 * hie * DM + r32);
    float* Ob = X.OACC + ((size_t)(cur.b * NH + cur.h) * T + qlo) * D;
    bf16_t* Cb = X.CAT + (size_t)(cur.b * T + qlo) * DM + cur.h * HD;
#pragma unroll
    for (int r = 0; r < 16; ++r) { const int cr = (r & 3) + 8 * (r >> 2);
        float* op = Ob + (size_t)cr * D + eo;
        float ov[4];
#pragma unroll
        for (int d0 = 0; d0 < 4; ++d0) ov[d0] = op[d0 * 32];
#pragma unroll
        for (int d0 = 0; d0 < 4; ++d0) { const float v = ov[d0] + o[d0][r] * rli[r];
            if constexpr (MODE == 1) { op[d0 * 32] = v; }
            else { const float vn = __shfl_xor(v, 1);
                   if ((r32 & 1) == 0) *(unsigned*)(Cb + (size_t)cr * DM + d0 * 32 + ec) = cvt_pk_bf16(v, vn); } }
        asm volatile("" ::: "memory"); }
    __syncthreads();
#undef RESC
#undef KBASE
#undef ACT
#undef MASKT
#undef SEAM_K0
#undef HALF_STEP
}
#undef ROWU
#undef VMW
#undef VMWN
#undef SLOAD_H
#undef SWRITE_HK
#undef SWRITE_HV
#undef SWRITE_H

__host__ __device__ inline int swa_nramp(int nqb, int W) { const int t = W - 1; const int n = t < 0 ? 0 : t / QB + 1; return n > nqb ? nqb : n; }
struct SwaItem { int bh, qb0, qb1; };
__device__ __forceinline__ SwaItem swa_decode(int L, int nqb, int nx, int nramp) {
    SwaItem it; const int xcd = L & 7, k = L >> 3; it.bh = xcd * 4 + k / nx; const int x = k % nx;
    const int ns = nqb - nramp;
    if (x < ns) { it.qb0 = it.qb1 = nqb - 1 - x; } else { it.qb0 = x - ns; it.qb1 = nramp - 1 - it.qb0; }
    return it;
}
template <int MODE>
__device__ __forceinline__ BlockRef swa_ref(const SwaItem& it, int pass, const bf16_t* Q, const bf16_t* K, const bf16_t* V) {
    const int qb = pass ? it.qb1 : it.qb0, kvh = it.bh >> 2;
    BlockRef r; r.Q = Q + ((size_t)it.bh * T + (size_t)qb * QB) * D; r.K = K + (size_t)kvh * T * D; r.V = V + (size_t)kvh * T * D; r.P0 = qb * QB; r.b = it.bh >> 4; r.h = it.bh & 15;
    return r;
}
template <int MODE, bool SK>
__device__ __forceinline__ void swa_phase(char* lds, const bf16_t* Q, const bf16_t* K, const bf16_t* V, const Ctx& X, int W, int Wdeal, int c, int G, int wid, int lane) {
    constexpr int nqb = T / QB;
    const int nramp = swa_nramp(nqb, Wdeal),
               nx = (nramp + 1) / 2 + (nqb - nramp), total = nx * NB * NH;
    int L = c; if (L >= total) return;
    SwaItem it = swa_decode(L, nqb, nx, nramp); int pass = 0;
    BlockRef cur = swa_ref<MODE>(it, 0, Q, K, V);
    Seam S;
    swa_prime(cur, W, lds, S, wid, lane);
    for (;;) {
        const bool more_pass = pass == 0 && it.qb1 != it.qb0, more_item = L + G < total, last = !more_pass && !more_item;
        SwaItem itn = it; int passn = pass + 1, Ln = L;
        if (!more_pass) { passn = 0; Ln = more_item ? L + G : L; itn = swa_decode(Ln, nqb, nx, nramp); }
        const BlockRef nxt = last ? cur : swa_ref<MODE>(itn, passn, Q, K, V);
        swa_block<MODE, SK>(cur, nxt, W, W, lds, S, X, wid, lane);
        if (last) break;
        cur = nxt; it = itn; pass = passn; L = Ln;
    }
}
}

#define XB_TMO      128
#define XB_XCNT(j)  (256  + 64 * (j))
#define XB_XSUB(j)  (1280 + 64 * (j))
#define XB_XGEN(j)  (2304 + 64 * (j))
#define XB_TOP      3328
#define XB_TOPGEN   3392
#define XCD_BAR_WORDS 3456
#define XB_SPIN_CAP (1u << 18)
__device__ __forceinline__ unsigned xb_ld(unsigned* p)              { return __hip_atomic_load(p, __ATOMIC_RELAXED, __HIP_MEMORY_SCOPE_AGENT); }
__device__ __forceinline__ unsigned xb_add(unsigned* p, unsigned v) { return __hip_atomic_fetch_add(p, v, __ATOMIC_RELAXED, __HIP_MEMORY_SCOPE_AGENT); }
__device__ __forceinline__ unsigned xb_xcc_id() { return (unsigned)__builtin_amdgcn_s_getreg((3 << 11) | 20) & 0xFu; }
#define XB_SPIN(cond, bar) do { unsigned _sp = 0; while (cond) { __builtin_amdgcn_s_sleep(1); \
    if ((++_sp & 255u) == 0u) { if (xb_ld(&(bar)[XB_TMO])) break; if (_sp > XB_SPIN_CAP) { atomicAdd(&(bar)[XB_TMO], 1u); break; } } } } while (0)
struct XcdBarrier { unsigned* bar; unsigned x; volatile LAS unsigned* st; };
__device__ __forceinline__ XcdBarrier xcd_barrier_post(unsigned* bar, volatile LAS unsigned* st, bool t0) {
    XcdBarrier b; b.bar = bar; b.x = xb_xcc_id(); b.st = st;
    if (t0) (void)xb_add(&bar[XB_XCNT(b.x)], 1u);
    return b;
}
__device__ __forceinline__ void xcd_barrier_complete(unsigned* bar, unsigned x, unsigned& nloc, unsigned& nx) {
    const unsigned G = gridDim.x * gridDim.y * gridDim.z;
    unsigned sum, cnt, mine, sp = 0u;
    for (;;) {
        sum = 0u; cnt = 0u; mine = 0u;
#pragma unroll
        for (unsigned j = 0; j < 16; ++j) { const unsigned c = xb_ld(&bar[XB_XCNT(j)]); sum += c; cnt += (c > 0u) ? 1u : 0u; mine = (j == x) ? c : mine; }
        if (sum == G) break;
        __builtin_amdgcn_s_sleep(1);
        if ((++sp & 255u) == 0u) { if (xb_ld(&bar[XB_TMO])) break; if (sp > XB_SPIN_CAP) { atomicAdd(&bar[XB_TMO], 1u); break; } }
    }
    nloc = mine > 0u ? mine : 1u; nx = cnt > 0u ? cnt : 1u;
}
__device__ __forceinline__ void xcd_barrier(const XcdBarrier& b, bool t0) {
    asm volatile("s_waitcnt vmcnt(0)" ::: "memory");
    __syncthreads();
    if (t0) {
        unsigned* bar = b.bar;
        __builtin_amdgcn_s_waitcnt(0);
        unsigned nloc = b.st[0], nx = b.st[1];
        if (nloc == 0u) { xcd_barrier_complete(bar, b.x, nloc, nx); b.st[0] = nloc; b.st[1] = nx; }
        const unsigned old = xb_add(&bar[XB_XSUB(b.x)], 1u);
        const unsigned gen = old / nloc;
        if (old + 1u == (gen + 1u) * nloc) {
            __builtin_amdgcn_fence(__ATOMIC_RELEASE, "agent");
            asm volatile("s_waitcnt vmcnt(0)" ::: "memory");
            const unsigned og = xb_add(&bar[XB_TOP], 1u);
            const unsigned tg = og / nx;
            if (og + 1u == (tg + 1u) * nx) xb_add(&bar[XB_TOPGEN], 1u);
            else XB_SPIN(xb_ld(&bar[XB_TOPGEN]) == tg, bar);
            __builtin_amdgcn_fence(__ATOMIC_ACQUIRE, "agent");
            xb_add(&bar[XB_XGEN(b.x)], 1u);
            asm volatile("s_waitcnt vmcnt(0)" ::: "memory");
        } else {
            XB_SPIN(xb_ld(&bar[XB_XGEN(b.x)]) == gen, bar);
            __builtin_amdgcn_fence(__ATOMIC_ACQUIRE, "agent");
            asm volatile("s_waitcnt vmcnt(0)" ::: "memory");
        }
    }
    __syncthreads();
}

struct Args {
    const float* in[24]; float* out; unsigned char* ws; int ph_lo, ph_hi, G, pad;
};
__device__ __forceinline__ float wave_sum(float v) {
#pragma unroll
    for (int o = 1; o < 64; o <<= 1) v += __shfl_xor(v, o);
    return v;
}
__device__ __forceinline__ f32x4 mfma16(bf16x8 a, bf16x8 b, f32x4 c) { return __builtin_amdgcn_mfma_f32_16x16x32_bf16(a, b, c, 0, 0, 0); }

__device__ __forceinline__ void tr_load(const float* W, int ldw, int k0, int n0, int lane, f32x4 (&v)[16]) {
    const float* src = W + (size_t)(k0 + (lane >> 4)) * ldw + n0 + 4 * (lane & 15);
#pragma unroll
    for (int i = 0; i < 16; ++i) v[i] = __builtin_nontemporal_load((const f32x4*)(src + (size_t)(4 * i) * ldw));
}
__device__ __forceinline__ void tr_finish(const f32x4 (&v)[16], int k0, bf16_t* WT, size_t drow0, int ldt, LAS float* scr, int lane, const float* gn  ) {
#pragma unroll
    for (int i = 0; i < 16; ++i) { LAS float* s = scr + ((lane >> 4) + 4 * i) * 65 + 4 * (lane & 15); s[0] = v[i][0]; s[1] = v[i][1]; s[2] = v[i][2]; s[3] = v[i][3]; }
    LDS_WAIT();
    const int c = lane & 7;
    f32x4 g0 = {1.f, 1.f, 1.f, 1.f}, g1 = {1.f, 1.f, 1.f, 1.f};
    if (gn) { g0 = *(const f32x4*)(gn + 8 * c); g1 = *(const f32x4*)(gn + 8 * c + 4); }
#pragma unroll
    for (int j = 0; j < 8; ++j) { const int n = (lane >> 3) + 8 * j; const LAS float* s = scr + (8 * c) * 65 + n;
        u32x4 o; o.x = cvt_pk_bf16(s[0 * 65] * g0[0], s[1 * 65] * g0[1]); o.y = cvt_pk_bf16(s[2 * 65] * g0[2], s[3 * 65] * g0[3]); o.z = cvt_pk_bf16(s[4 * 65] * g1[0], s[5 * 65] * g1[1]); o.w = cvt_pk_bf16(s[6 * 65] * g1[2], s[7 * 65] * g1[3]);
        if (ldt > 0) *(u32x4*)(WT + (drow0 + n) * (size_t)ldt + k0 + 8 * c) = o;
        else { const int row = (int)drow0 + n, k = k0 + 8 * c;
               *(u32x4*)(WT + ((size_t)((row >> 4) * ((-ldt) >> 5) + (k >> 5)) * 64 + ((k >> 3) & 3) * 16 + (row & 15)) * 8) = o; } }
    LDS_WAIT();
}
__device__ __forceinline__ void rms_row_bf16(const float* xrow, const float* gain, bf16_t* orow, int lane) {
    const f32x4* xr = (const f32x4*)xrow + lane; const f32x4* gr = (const f32x4*)gain + lane;
    f32x4 v[16]; float s = 0.f;
#pragma unroll
    for (int j = 0; j < 16; ++j) { v[j] = xr[64 * j]; s += (v[j][0] * v[j][0] + v[j][1] * v[j][1]) + (v[j][2] * v[j][2] + v[j][3] * v[j][3]); }
    const float r = 1.0f / sqrtf(wave_sum(s) * (1.0f / DM) + EPS);
    u32x2* o8 = (u32x2*)orow + lane;
#pragma unroll
    for (int j = 0; j < 16; ++j) { const f32x4 g = gr[64 * j]; u32x2 w; w.x = cvt_pk_bf16(v[j][0] * r * g[0], v[j][1] * r * g[1]); w.y = cvt_pk_bf16(v[j][2] * r * g[2], v[j][3] * r * g[3]); o8[64 * j] = w; }
}
__device__ __forceinline__ void rms_row_f32(const float* xrow, const float* gain, float* orow, int lane) {
    const f32x4* xr = (const f32x4*)xrow + lane; const f32x4* gr = (const f32x4*)gain + lane;
    f32x4 v[16]; float s = 0.f;
#pragma unroll
    for (int j = 0; j < 16; ++j) { v[j] = xr[64 * j]; s += (v[j][0] * v[j][0] + v[j][1] * v[j][1]) + (v[j][2] * v[j][2] + v[j][3] * v[j][3]); }
    const float r = 1.0f / sqrtf(wave_sum(s) * (1.0f / DM) + EPS);
    f32x4* o = (f32x4*)orow + lane;
#pragma unroll
    for (int j = 0; j < 16; ++j) { const f32x4 g = gr[64 * j]; o[64 * j] = v[j] * r * g; }
}

__device__ const float ROPE_INV_FREQ[16] = {1.0f, 0.44036659598350525f, 0.1939227432012558f, 0.08539710193872452f, 0.03760603070259094f, 0.01656043902039528f, 0.007292664609849453f,
    0.0032114458736032248f, 0.0014142135623842478f, 0.000622772378847003f, 0.00027424818836152554f, 0.00012076973507646471f, 5.318296098266728e-05f, 2.34199997066753e-05f,
    1.0313386155758053e-05f, 4.541670477919979e-06f};

__device__ __forceinline__ void compress_item(LAS unsigned char* lds, int which, int rt, const bf16_t* X0, const float* cb, const bf16_t* W1, const bf16_t* W2,
                                              bf16_t* KCMP, bf16_t* VCMPT, int wave, int lane) {
    const int fr = lane & 15, q4 = lane >> 4;
    const int bgi = (rt * 16) >> 8, n = ((rt * 16) & 255) + (lane >> 2), psrc = (fr << 2) | q4;
    const bf16_t* X = X0 + (size_t)bgi * T * HD + 8 * (lane & 3);
    f32x4 acc0 = {0.f, 0.f, 0.f, 0.f}, acc1 = {0.f, 0.f, 0.f, 0.f};
    const bf16_t* w1p = W1 + ((size_t)(2 * wave) * 128 * 64 + lane) * 8;
#define CMP_LOADG(gq, A, B0, B1) do { _Pragma("unroll") for (int j = 0; j < 8; ++j) { const int ks = 8 * (gq) + j; int tok = 16 * n + 2 * (gq) + (j >> 2); tok = tok > (T - 1) ? (T - 1) : tok; \
        A[j] = *(const bf16x8*)(X + (size_t)tok * HD + 32 * (j & 3)); B0[j] = *(const bf16x8*)(w1p + (size_t)ks * 512); B1[j] = *(const bf16x8*)(w1p + (size_t)(128 + ks) * 512); } } while (0)
#define CMP_COMPG(A, B0, B1) do { _Pragma("unroll") for (int j = 0; j < 8; ++j) { u32x4 t_ = __builtin_bit_cast(u32x4, A[j]); \
        t_.x = (unsigned)__shfl((int)t_.x, psrc); t_.y = (unsigned)__shfl((int)t_.y, psrc); t_.z = (unsigned)__shfl((int)t_.z, psrc); t_.w = (unsigned)__shfl((int)t_.w, psrc); \
        const bf16x8 a_ = __builtin_bit_cast(bf16x8, t_); acc0 = mfma16(a_, B0[j], acc0); acc1 = mfma16(a_, B1[j], acc1); } } while (0)
    bf16x8 a_0[8], b0_0[8], b1_0[8], a_1[8], b0_1[8], b1_1[8];
    CMP_LOADG(0, a_0, b0_0, b1_0);
    for (int gq = 0; gq < 16; gq += 2) {
        CMP_LOADG(gq + 1, a_1, b0_1, b1_1);
        CMP_COMPG(a_0, b0_0, b1_0);
        if (gq + 2 < 16) CMP_LOADG(gq + 2, a_0, b0_0, b1_0);
        CMP_COMPG(a_1, b0_1, b1_1);
    }
#undef CMP_LOADG
#undef CMP_COMPG
    const float cb0 = cb[32 * wave + fr], cb1 = cb[32 * wave + 16 + fr];
    LAS unsigned short* hid = (LAS unsigned short*)lds;
#pragma unroll
    for (int i = 0; i < 4; ++i) {
        hid[(4 * q4 + i) * 264 + 32 * wave + fr] = (unsigned short)(cvt_pk_bf16(gelu_tanh(acc0[i] + cb0), 0.f) & 0xffffu);
        hid[(4 * q4 + i) * 264 + 32 * wave + 16 + fr] = (unsigned short)(cvt_pk_bf16(gelu_tanh(acc1[i] + cb1), 0.f) & 0xffffu);
    }
    LDS_WAIT(); __syncthreads();
    f32x4 o = {0.f, 0.f, 0.f, 0.f};
    const bf16_t* w2p = W2 + (size_t)(16 * wave + fr) * 256 + 8 * q4;
#pragma unroll
    for (int ks = 0; ks < 8; ++ks) { const bf16x8 a2 = *(const LAS bf16x8*)(hid + fr * 264 + 32 * ks + 8 * q4); const bf16x8 b2 = *(const bf16x8*)(w2p + 32 * ks); o = mfma16(a2, b2, o); }
    const int nn = ((rt * 16) & 255) + 4 * q4, dcol = 16 * wave + fr;
    if (which == 0) {
#pragma unroll
        for (int i = 0; i < 4; ++i) { const int n_ = nn + i;
            KCMP[((size_t)((bgi * 16 + (n_ >> 4)) * 4 + (dcol >> 5)) * 64 + ((dcol >> 3) & 3) * 16 + (n_ & 15)) * 8 + (dcol & 7)] = (bf16_t)(cvt_pk_bf16(o[i], 0.f) & 0xffffu); }
    } else {
        u32x2 w; w.x = cvt_pk_bf16(o[0], o[1]); w.y = cvt_pk_bf16(o[2], o[3]);
        *(u32x2*)(VCMPT + ((size_t)((bgi * 8 + (dcol >> 4)) * 8 + (nn >> 5)) * 64 + ((nn >> 3) & 3) * 16 + (dcol & 15)) * 8 + (nn & 7)) = w;
    }
    __syncthreads();
}

__device__ __forceinline__ void cmp_attn_item(LAS unsigned char* lds, int bg, int tt, const bf16_t* QH, const bf16_t* KCMP, const bf16_t* VCMPT, const float* GATES,
                                              float* OACC, unsigned long long* SEL, int wave, int lane) {
    const int fr = lane & 15, q4 = lane >> 4, b = bg >> 2, g = bg & 3;
    const int t0w = tt * 32 + wave * 4;
    LAS unsigned short* pL = (LAS unsigned short*)(lds + wave * 8448);
    LAS float* impL = (LAS float*)(lds + 8 * 8448 + wave * 4160);
    LAS float* scL = (LAS float*)(lds + 8 * 8448 + 8 * 4160 + wave * 1024);
    const bf16_t* qrow = QH + ((size_t)((b * NH + g * 4 + (fr & 3)) * T + t0w + (fr >> 2))) * HD + 8 * q4;
    bf16x8 aq[4];
#pragma unroll
    for (int ks = 0; ks < 4; ++ks) aq[ks] = *(const bf16x8*)(qrow + 32 * ks);
    const bf16_t* kb = KCMP + ((size_t)bg * 16 * 4 * 64 + lane) * 8;
    const int nlast = (t0w + 3 >= 31) ? ((t0w + 3 - 31) >> 4) : -1, Tmax = nlast >> 4, Kmax = nlast >> 5;
    f32x4 s[16];
#pragma unroll
    for (int Tt = 0; Tt < 16; ++Tt) { f32x4 a = {0.f, 0.f, 0.f, 0.f};
        if (Tt <= Tmax) {
#pragma unroll
            for (int ks = 0; ks < 4; ++ks) { const bf16x8 bk = *(const bf16x8*)(kb + (size_t)(Tt * 4 + ks) * 512); a = mfma16(aq[ks], bk, a); } }
        s[Tt] = a; }
    const int t = t0w + q4;
    const int nmax = (t >= 31) ? ((t - 31) >> 4) : -1;
    const float NEGI = -__builtin_inff();
    float mx[4] = {NEGI, NEGI, NEGI, NEGI};
#pragma unroll
    for (int Tt = 0; Tt < 16; ++Tt) { const bool valid = (16 * Tt + fr) <= nmax;
#pragma unroll
        for (int i = 0; i < 4; ++i) mx[i] = valid ? fmaxf(mx[i], s[Tt][i]) : mx[i]; }
#pragma unroll
    for (int i = 0; i < 4; ++i) {
#pragma unroll
        for (int o = 1; o < 16; o <<= 1) mx[i] = fmaxf(mx[i], __shfl_xor(mx[i], o)); }
    constexpr float C2 = 1.4426950408889634f * 0.08838834764831845f;
    float sum[4] = {0.f, 0.f, 0.f, 0.f};
#pragma unroll
    for (int Tt = 0; Tt < 16; ++Tt) { const bool valid = (16 * Tt + fr) <= nmax;
#pragma unroll
        for (int i = 0; i < 4; ++i) { const float p = valid ? __builtin_amdgcn_exp2f((s[Tt][i] - mx[i]) * C2) : 0.f; s[Tt][i] = p; sum[i] += p; } }
#pragma unroll
    for (int i = 0; i < 4; ++i) {
#pragma unroll
        for (int o = 1; o < 16; o <<= 1) sum[i] += __shfl_xor(sum[i], o);
        sum[i] = sum[i] > 0.f ? 1.0f / sum[i] : 0.f; }
#pragma unroll
    for (int Tt = 0; Tt < 16; ++Tt) {
#pragma unroll
        for (int i = 0; i < 4; ++i) s[Tt][i] *= sum[i];
        impL[q4 * 260 + 16 * Tt + fr] = ((s[Tt][0] + s[Tt][1]) + s[Tt][2]) + s[Tt][3];
#pragma unroll
        for (int i = 0; i < 4; ++i) pL[(4 * q4 + i) * 264 + 16 * Tt + fr] = (unsigned short)(cvt_pk_bf16(s[Tt][i], 0.f) & 0xffffu);
    }
    LDS_WAIT();
    bf16x8 pf[8];
#pragma unroll
    for (int ks = 0; ks < 8; ++ks) pf[ks] = *(const LAS bf16x8*)(pL + fr * 264 + 32 * ks + 8 * q4);
    const bf16_t* vb = VCMPT + ((size_t)bg * 8 * 8 * 64 + lane) * 8;
    float gt[4];
#pragma unroll
    for (int i = 0; i < 4; ++i) gt[i] = GATES[(size_t)(b * T + t) * 48 + 3 * (g * 4 + i) + 0];
#pragma unroll
    for (int Dt = 0; Dt < 8; ++Dt) { f32x4 o = {0.f, 0.f, 0.f, 0.f};
#pragma unroll
        for (int ks = 0; ks < 8; ++ks) if (ks <= Kmax) { const bf16x8 bv = *(const bf16x8*)(vb + (size_t)(Dt * 8 + ks) * 512); o = mfma16(pf[ks], bv, o); }
#pragma unroll
        for (int i = 0; i < 4; ++i) OACC[((size_t)((b * NH + g * 4 + i) * T + t)) * HD + 16 * Dt + fr] = o[i] * gt[i]; }
    const LAS float* im = impL + q4 * 260;
    const int cur = t >> 6;
    float myv[4];
#pragma unroll
    for (int k = 0; k < 4; ++k) { const int jj = fr + 16 * k;
        const float m0 = jj > 0 ? im[4 * jj - 1] : 0.f, m1 = im[4 * jj], m2 = im[4 * jj + 1], m3 = im[4 * jj + 2], nx = im[4 * jj + 3];
        float sc = (((m0 + m1) + m2) + m3) - 0.5f * m0 + 0.5f * nx;
        sc = (jj == cur || jj == 0) ? 1e30f : (jj > cur ? -1e30f : sc);
        myv[k] = sc; scL[q4 * 64 + jj] = sc; }
    LDS_WAIT();
    int rank[4] = {0, 0, 0, 0};
#pragma unroll 8
    for (int i = 0; i < 64; ++i) { const float si = scL[q4 * 64 + i];
#pragma unroll
        for (int k = 0; k < 4; ++k) rank[k] += ((si > myv[k]) || (si == myv[k] && i < fr + 16 * k)) ? 1 : 0; }
    unsigned long long msk = 0ull;
#pragma unroll
    for (int k = 0; k < 4; ++k) { const unsigned long long bal = __ballot(rank[k] < 16); msk |= ((bal >> (16 * q4)) & 0xffffull) << (16 * k); }
    if (fr == 0) SEL[(size_t)bg * T + t] = msk;
    LDS_WAIT();
}

__device__ __forceinline__ void gate_task(LAS unsigned char* lds, int g, int dq, int bc0, int nbc, const bf16_t* V, bf16_t* U, const float* SUMS, const float* ln_g, const float* ln_b,
                                          const bf16_t* WM, const float* bs, int tid, int wave, int lane) {
    const int fr = lane & 15, q4 = lane >> 4;
    const int col0 = g * 768 + dq * 128;
    const int cc = tid & 15, s0 = tid >> 4;
    const f32x4 lg0 = *(const f32x4*)(ln_g + col0 + 8 * cc), lg1 = *(const f32x4*)(ln_g + col0 + 8 * cc + 4), lb0 = *(const f32x4*)(ln_b + col0 + 8 * cc), lb1 = *(const f32x4*)(ln_b + col0 + 8 * cc + 4);
    bf16x8 wf[4];
    const bf16_t* wp = WM + ((size_t)g * 128 + 16 * wave + fr) * 128 + 8 * q4;
#pragma unroll
    for (int ks = 0; ks < 4; ++ks) wf[ks] = *(const bf16x8*)(wp + 32 * ks);
    const int tt = 16 * wave + fr, kmax = wave >> 1;
    const float bias = bs[g * 128 + tt];
    const unsigned kf = (unsigned)((fr >> 3) ^ ((fr & 7) << 1)), rdl = ((unsigned)q4 ^ kf) << 4;
    u32x4 vraw[4]; f32x2 st[4];
    const bf16_t* vp = V + (size_t)(bc0 * 128 + s0) * GW + col0 + 8 * cc;
    const float* sp = SUMS + (size_t)(bc0 * 128 + s0) * 2;
#pragma unroll
    for (int j = 0; j < 4; ++j) { vraw[j] = *(const u32x4*)(vp + (size_t)(32 * j) * GW); st[j] = *(const f32x2*)(sp + 64 * j); }
    for (int i = 0; i < nbc; ++i) {
        const int row0 = (bc0 + i) * 128;
#pragma unroll
        for (int j = 0; j < 4; ++j) { const int sidx = s0 + 32 * j;
            const float mean = st[j][0] * (1.0f / GW); float var = st[j][1] * (1.0f / GW) - mean * mean; var = var > 0.f ? var : 0.f; const float rstd = 1.0f / sqrtf(var + EPS);
            const float x[8] = {bflo(vraw[j].x), bfhi(vraw[j].x), bflo(vraw[j].y), bfhi(vraw[j].y), bflo(vraw[j].z), bfhi(vraw[j].z), bflo(vraw[j].w), bfhi(vraw[j].w)};
#pragma unroll
            for (int e = 0; e < 8; ++e) { const float gg = e < 4 ? lg0[e & 3] : lg1[e & 3], bb = e < 4 ? lb0[e & 3] : lb1[e & 3];
                const float y = (x[e] - mean) * rstd * gg + bb;
                const unsigned off = (unsigned)(8 * cc + e) * 256u + ((((unsigned)(sidx >> 3)) ^ ((unsigned)cc ^ (unsigned)(2 * e))) & 15u) * 16u + (unsigned)(sidx & 7) * 2u;
                *(LAS unsigned short*)(lds + off) = (unsigned short)(cvt_pk_bf16(y, 0.f) & 0xffffu); } }
        if (i + 1 < nbc) {
            const bf16_t* vn = V + (size_t)(row0 + 128 + s0) * GW + col0 + 8 * cc; const float* sn = SUMS + (size_t)(row0 + 128 + s0) * 2;
#pragma unroll
            for (int j = 0; j < 4; ++j) { vraw[j] = *(const u32x4*)(vn + (size_t)(32 * j) * GW); st[j] = *(const f32x2*)(sn + 64 * j); } }
        bf16_t* up = U + (size_t)(row0 + 16 * wave + (lane >> 2)) * GW + col0 + 4 * (lane & 3);
        u32x2 u4[8];
#pragma unroll
        for (int nt = 0; nt < 8; ++nt) u4[nt] = *(const u32x2*)(up + 16 * nt);
        LDS_WAIT(); __syncthreads();
#pragma unroll
        for (int nt = 0; nt < 8; ++nt) { f32x4 acc = {0.f, 0.f, 0.f, 0.f};
#pragma unroll
            for (int ks = 0; ks < 4; ++ks) if (ks <= kmax) { const bf16x8 af = *(const LAS bf16x8*)(lds + (unsigned)(16 * nt + fr) * 256u + ((unsigned)(((4 * ks) ^ (2 * nt)) << 4) ^ rdl)); acc = mfma16(af, wf[ks], acc); }
            const unsigned ux = (unsigned)__shfl((int)u4[nt].x, (fr << 2) | q4), uy = (unsigned)__shfl((int)u4[nt].y, (fr << 2) | q4);
            u32x2 w; w.x = cvt_pk_bf16(bflo(ux) * (acc[0] + bias), bfhi(ux) * (acc[1] + bias)); w.y = cvt_pk_bf16(bflo(uy) * (acc[2] + bias), bfhi(uy) * (acc[3] + bias));
            w.x = (unsigned)__shfl((int)w.x, ((lane & 3) << 4) | (lane >> 2)); w.y = (unsigned)__shfl((int)w.y, ((lane & 3) << 4) | (lane >> 2));
            *(u32x2*)(up + 16 * nt) = w; }
        __syncthreads();
    }
}

template <int W> __device__ __forceinline__ void pool_chunk(const bf16_t* PIN, bf16_t* POOLED, int row, int c8) {
    const int t = row & (T - 1), cnt = (t + 1) < W ? (t + 1) : W;
    u32x4 v[W];
#pragma unroll
    for (int i = 0; i < W; ++i) { const int ri = (i <= t) ? row - i : row; v[i] = *(const u32x4*)(PIN + (size_t)ri * 2048 + c8); }
    float sm[8] = {0.f, 0.f, 0.f, 0.f, 0.f, 0.f, 0.f, 0.f};
#pragma unroll
    for (int i = 0; i < W; ++i) { const float k = (i <= t) ? 1.f : 0.f;
        sm[0] += k * bflo(v[i].x); sm[1] += k * bfhi(v[i].x); sm[2] += k * bflo(v[i].y); sm[3] += k * bfhi(v[i].y); sm[4] += k * bflo(v[i].z); sm[5] += k * bfhi(v[i].z); sm[6] += k * bflo(v[i].w); sm[7] += k * bfhi(v[i].w); }
    const float fc = (float)cnt; const u32x4 cur = v[0];
    u32x4 w; w.x = cvt_pk_bf16(sm[0] / fc - bflo(cur.x), sm[1] / fc - bfhi(cur.x)); w.y = cvt_pk_bf16(sm[2] / fc - bflo(cur.y), sm[3] / fc - bfhi(cur.y));
    w.z = cvt_pk_bf16(sm[4] / fc - bflo(cur.z), sm[5] / fc - bfhi(cur.z)); w.w = cvt_pk_bf16(sm[6] / fc - bflo(cur.w), sm[7] / fc - bfhi(cur.w));
    *(u32x4*)(POOLED + (size_t)row * 2048 + c8) = w;
}

constexpr int N_PHASES = 19;
constexpr int I_INE1 = 64 * 80, I_INE2 = 64 * 32, I_OUTE = 64 * 64, I_G = 64 * 172, I_DN = 172 * 64, I_INO = 64 * 384, I_OUTO = 192 * 64, I_POOL = 8 * 8, I_C1 = 64 * 4, I_C2 = 4 * 2;
constexpr int NIT_A = I_INE1 + I_INE2 + 4 * I_POOL + 2 * I_C1 + 2 * I_C2;
constexpr int NIT_P0 = NIT_A + 4 * I_G + I_INO;
constexpr int NIT_T1 = NIT_P0 + I_DN + I_OUTE;
constexpr int NIT_T8 = NIT_T1 + I_OUTO;
constexpr int NITEMS = NIT_T8 + I_DN;
#ifndef PH_MASK
#define PH_MASK 0x7FFFF
#endif
typedef const __attribute__((address_space(4))) Args* KArgs;
__device__ __forceinline__ KArgs kargs() { unsigned long long v = (unsigned long long)__builtin_amdgcn_kernarg_segment_ptr(); asm volatile("" : "+s"(v)); return (KArgs)v; }
#define WSP(type, off) ((type*)(ws + (off)))

struct ConvJob { int cnt, in_idx; unsigned src_off; unsigned long long dst_off; int ldw, K, nblk, col0, drow0, mode, gain_idx, gain_off; };
__device__ const ConvJob CONV_JOBS[19] = {
    {I_INE1, 2, 0u, O_W_INE, IN_EVEN, 4096, 80, 0, 0, 0, -1, 0},
    {I_INE2, 2, 0u, O_W_INE, IN_EVEN, 4096, 32, 5168, 5120, 0, -1, 0},
    {I_POOL, 9, 0u, O_W_POOL, 512, 512, 8, 0, 0, 0, -1, 0},
    {I_POOL, 9, 1u * 512 * 512, O_W_POOL + 1ull * 512 * 512 * 2, 512, 512, 8, 0, 0, 0, -1, 0},
    {I_POOL, 9, 2u * 512 * 512, O_W_POOL + 2ull * 512 * 512 * 2, 512, 512, 8, 0, 0, 0, -1, 0},
    {I_POOL, 9, 3u * 512 * 512, O_W_POOL + 3ull * 512 * 512 * 2, 512, 512, 8, 0, 0, 0, -1, 0},
    {I_C1, 5, 0u, O_W_C1K, 256, 4096, 4, 0, 0, 2, -1, 0},
    {I_C1, 7, 0u, O_W_C1V, 256, 4096, 4, 0, 0, 2, -1, 0},
    {I_C2, 6, 0u, O_W_C2K, 128, 256, 2, 0, 0, 0, -1, 0},
    {I_C2, 8, 0u, O_W_C2V, 128, 256, 2, 0, 0, 0, -1, 0},
    {I_G, 20, 0u, O_W_GU0, FF, 4096, 172, 0, 0, 1, 19, 0},
    {I_G, 21, 0u, O_W_GU0, FF, 4096, 172, 0, 128, 1, 19, 0},
    {I_G, 20, (unsigned)(DM * FF), O_W_GU1, FF, 4096, 172, 0, 0, 1, 19, DM},
    {I_G, 21, (unsigned)(DM * FF), O_W_GU1, FF, 4096, 172, 0, 128, 1, 19, DM},
    {I_INO, 13, 0u, O_W_INO, 2 * GW, 4096, 384, 0, 0, 0, 12, 0},
    {I_DN, 22, 0u, O_W_DN0, 4096, FF, 64, 0, 0, 0, -1, 0},
    {I_OUTE, 11, 0u, O_W_OUTE, 4096, 4096, 64, 0, 0, 0, -1, 0},
    {I_OUTO, 18, 0u, O_W_OUTO, 4096, GW, 64, 0, 0, 0, -1, 0},
    {I_DN, 22, (unsigned)(DM * FF), O_W_DN1, 4096, FF, 64, 0, 0, 0, -1, 0}};
#define CONV_DECODE(it_, osrc, odst, oldw, oK, k0, n0, drow, ogn) const float* osrc; bf16_t* odst; const float* ogn; int oldw, oK, k0, n0, drow; { \
            int r = (it_), j = 0; while (j < 18 && r >= CONV_JOBS[j].cnt) { r -= CONV_JOBS[j].cnt; ++j; } \
            const ConvJob jb = CONV_JOBS[j]; \
            const int kb = r / jb.nblk, nb = r - kb * jb.nblk, n0l = nb * 64; k0 = kb * 64; n0 = jb.col0 + n0l; \
            drow = jb.mode == 1 ? (256 * (n0l >> 7) + (n0l & 127) + jb.drow0) : (jb.drow0 + n0l); \
            osrc = ap->in[jb.in_idx] + jb.src_off; odst = (bf16_t*)(ws + jb.dst_off); oldw = jb.ldw; oK = jb.mode == 2 ? -jb.K : jb.K; ogn = jb.gain_idx >= 0 ? ap->in[jb.gain_idx] + jb.gain_off + k0 : nullptr; }
#define CONV_RANGE(lo_, hi_, first_, stride_) do { LAS float* scr = (LAS float*)(lds + RING_OFF + wave * 16640); \
        for (int it = (lo_) + (first_); it < (hi_); it += 2 * (stride_)) { f32x4 va[16], vb[16]; const bool hasb = it + (stride_) < (hi_); \
            CONV_DECODE(it, srcA, dstA, ldwA, KA, k0A, n0A, drowA, gnA) tr_load(srcA, ldwA, k0A, n0A, lane, va); \
            CONV_DECODE(hasb ? it + (stride_) : it, srcB, dstB, ldwB, KB, k0B, n0B, drowB, gnB) tr_load(srcB, ldwB, k0B, n0B, lane, vb);   \
            tr_finish(va, k0A, dstA, (size_t)drowA, KA, scr, lane, gnA); if (hasb) tr_finish(vb, k0B, dstB, (size_t)drowB, KB, scr, lane, gnB); } } while (0)
#define CONV_TAIL(nunits_, lo_, hi_) do { const int rounds_ = ((nunits_) + G - 1) / G, first_idle_ = (nunits_) - (rounds_ - 1) * G; \
        if (first_idle_ >= G) CONV_RANGE(lo_, hi_, bx * NWAVES + wave, G * NWAVES);   \
        else if (bx >= first_idle_) CONV_RANGE(lo_, hi_, (bx - first_idle_) * NWAVES + wave, (G - first_idle_) * NWAVES); } while (0)

__device__ __forceinline__ bool ph_in(int k) { KArgs ap = kargs(); return ap->ph_lo <= k && k < ap->ph_hi; }
__global__ void __launch_bounds__(NWAVES * 64, 2) fwd(Args args) {
    extern __shared__ __attribute__((aligned(16))) unsigned char lds_raw[];
    LAS unsigned char* lds = (LAS unsigned char*)lds_raw;
    const int wave = __builtin_amdgcn_readfirstlane((int)threadIdx.x >> 6);
    const int bx = blockIdx.x;
    { const int tid0 = threadIdx.x; for (int u = tid0; u < (LDS_BYTES - LDSCTL_OFF) / 4; u += NWAVES * 64) ((LAS unsigned*)(lds + LDSCTL_OFF))[u] = 0u; }
    __syncthreads();
#if MK_ONE_LAUNCH
    { KArgs ap = kargs(); (void)xcd_barrier_post((unsigned*)(ap->ws + O_CTL) + CW_BAR, (volatile LAS unsigned*)(lds + MISC_OFF) + 8, wave == 0 && lane_id() == 0); }
#define GRID_BAR() do { XcdBarrier bar_; bar_.bar = (unsigned*)(ws + O_CTL) + CW_BAR; bar_.x = xb_xcc_id(); bar_.st = (volatile LAS unsigned*)(lds + MISC_OFF) + 8; xcd_barrier(bar_, wave == 0 && lane_id() == 0); } while (0)
#else
#define GRID_BAR() do { } while (0)
#endif
#define IN(k) ((((PH_MASK) >> (k)) & 1) && ph_in(k))
#define BOTH(k) (IN(k) && IN((k) + 1))
#define PH_ARGS KArgs ap = kargs(); unsigned char* ws = ap->ws; (void)ws; const int G = ap->G; const int lane = lane_id(); const int tid = wave * 64 + lane; (void)tid; \
    const int vcu = (G % 8 == 0) ? (bx % 8) * (G / 8) + bx / 8 : bx; (void)vcu; const int gw = vcu * NWAVES + wave, NGW = G * NWAVES; (void)gw; (void)NGW; \
    const int gtid = vcu * (NWAVES * 64) + tid, NT_ALL = G * NWAVES * 64; (void)gtid; (void)NT_ALL

    if (IN(0)) {
        PH_ARGS;
        CONV_RANGE(0, NIT_A, gw, NGW);
        { const float* w_in = ap->in[2]; bf16_t* W_INE = WSP(bf16_t, O_W_INE);
          for (int idx = gtid; idx < 256 * 4096; idx += NT_ALL) { const int rr = idx >> 12, k = idx & 4095;
            const float v = rr < 48 ? w_in[(size_t)k * IN_EVEN + 5120 + rr] : 0.f;
            W_INE[(size_t)(7168 + rr) * 4096 + k] = (bf16_t)(cvt_pk_bf16(v, 0.f) & 0xffffu); } }
        { float* CB = WSP(float, O_CTL + O_CBIAS);
          for (int o = gw; o < 512; o += NGW) { const int which = o >> 8, h = o & 255; const float* pe = which ? ap->in[4] : ap->in[3]; const float* w1 = which ? ap->in[7] : ap->in[5]; float a = 0.f;
            for (int k = lane; k < 4096; k += 64) a += pe[k] * w1[(size_t)k * 256 + h];
            a = wave_sum(a); if (lane == 0) CB[o] = a; } }
        { const float* gws = ap->in[16]; bf16_t* WM = WSP(bf16_t, O_WM);
          for (int idx = gtid; idx < 16 * 128 * 128; idx += NT_ALL) { const int t = (idx >> 7) & 127, s = idx & 127;
            const float v = s <= t ? gws[idx] : 0.f; WM[idx] = (bf16_t)(cvt_pk_bf16(v, 0.f) & 0xffffu); } }
        { float* ROPE = WSP(float, O_ROPE);
          for (int idx = gtid; idx < 4096 * 16; idx += NT_ALL) { const int t = idx >> 4, i = idx & 15;
            const float ang = (float)t * ROPE_INV_FREQ[i];
            const double xr = (double)ang; const double nrev = __builtin_rint(xr * 0.15915494309189535); const double rr = __builtin_fma(-nrev, 6.283185307179586, xr) - nrev * 2.4492935982947064e-16;
            const double r2 = rr * rr; double ts = 1.0, tc = 1.0, sn = 1.0, cs = 1.0;
#pragma unroll
            for (int k = 1; k <= 15; ++k) { ts *= -r2 / (double)((2 * k) * (2 * k + 1)); sn += ts; tc *= -r2 / (double)((2 * k - 1) * (2 * k)); cs += tc; }
            ROPE[idx] = (float)cs; ROPE[65536 + idx] = (float)(sn * rr); } }
        { const float* x = ap->in[0]; const float* gn = ap->in[1]; bf16_t* HN = WSP(bf16_t, O_HN);
          for (int m = gw; m < M; m += NGW) rms_row_bf16(x + (size_t)m * DM, gn, HN + (size_t)m * DM, lane); }
        if (BOTH(0)) GRID_BAR();
    }

    if (IN(1)) {
        PH_ARGS;
        pg8::Gemm g{WSP(bf16_t, O_HN), WSP(bf16_t, O_W_INE), M, IN_EVEN_P, DM, DM, DM}; pg8::StaticOrder S; S.init(M, IN_EVEN_P, G, bx);
        pg8::EpiInEven E{WSP(bf16_t, O_QH), WSP(bf16_t, O_KV), WSP(bf16_t, O_PIN), WSP(float, O_GATES), WSP(float, O_ROPE)};
        pg8::gemm_phase<pg8::EpiInEven, pg8::StaticOrder, true, true>(lds + RING_OFF, g, S, E, wave, lane);
        CONV_TAIL((M / 256) * (IN_EVEN_P / 256), NIT_P0, NIT_T1);
        if (BOTH(1)) GRID_BAR();
    }
    if (IN(2)) {
        PH_ARGS;
        for (int id = vcu; id < 256; id += G) { const int which = id >> 7, rt = id & 127;
            compress_item(lds + RING_OFF, which, rt, WSP(bf16_t, O_KV) + (size_t)which * KVSZ, WSP(float, O_CTL + O_CBIAS) + 256 * which, which ? WSP(bf16_t, O_W_C1V) : WSP(bf16_t, O_W_C1K),
                          which ? WSP(bf16_t, O_W_C2V) : WSP(bf16_t, O_W_C2K), WSP(bf16_t, O_KCMP), WSP(bf16_t, O_VCMPT), wave, lane); }
        const bf16_t* PIN = WSP(bf16_t, O_PIN); bf16_t* POOLED = WSP(bf16_t, O_POOLED);
        for (int idx = gtid; idx < M * 256; idx += NT_ALL) { const int row = idx >> 8, c8 = (idx & 255) * 8, grp = __builtin_amdgcn_readfirstlane(c8 >> 9);
            if (grp == 0) pool_chunk<2>(PIN, POOLED, row, c8); else if (grp == 1) pool_chunk<4>(PIN, POOLED, row, c8); else if (grp == 2) pool_chunk<8>(PIN, POOLED, row, c8); else pool_chunk<16>(PIN, POOLED, row, c8); }
        if (BOTH(2)) GRID_BAR();
    }
    if (IN(3)) {
        PH_ARGS;
        { const int grp = bx >> 6, loc = bx & 63;
          pg8::Gemm g{WSP(bf16_t, O_POOLED) + 512 * grp, WSP(bf16_t, O_W_POOL) + (size_t)grp * 512 * 512, M, 512, 512, 2048, 512}; pg8::StaticOrder S; S.init(M, 512, 64, loc);
          pg8::EpiScaleBf16 E{WSP(bf16_t, O_CAT) + 2048 + 512 * grp, DM, ap->in[10] + 512 * grp};
          if (grp < 4) pg8::gemm_phase<pg8::EpiScaleBf16, pg8::StaticOrder, false, true>(lds + RING_OFF, g, S, E, wave, lane); }
        __syncthreads();
        for (int id = vcu; id < 1024; id += G) cmp_attn_item(lds + RING_OFF, 2 * (id >> 8) + ((id >> 7) & 1), (id + 32 * (id >> 8)) & 127, WSP(bf16_t, O_QH), WSP(bf16_t, O_KCMP), WSP(bf16_t, O_VCMPT), WSP(float, O_GATES),
                                                             WSP(float, O_OACC), WSP(unsigned long long, O_SEL), wave, lane);
        if (BOTH(3)) GRID_BAR();
    }
    if (IN(4)) {
        PH_ARGS;
        const bool conv_first = ((bx >> 3) & 1) != 0;
        if (conv_first) { CONV_RANGE(NIT_A, NIT_P0, bx * NWAVES + wave, G * NWAVES); VM_WAIT(); __syncthreads(); }
        const swa::Ctx X{WSP(float, O_OACC), WSP(bf16_t, O_CAT), WSP(float, O_GATES), WSP(unsigned long long, O_SEL)};
        swa::swa_phase<1, false>((char*)lds_raw + RING_OFF, WSP(bf16_t, O_QH), WSP(bf16_t, O_KV) + 2 * KVSZ, WSP(bf16_t, O_KV) + 3 * KVSZ, X, 1 << 28, 1 << 28, bx, G, wave, lane);
        if (!conv_first) { __syncthreads(); CONV_RANGE(NIT_A, NIT_P0, bx * NWAVES + wave, G * NWAVES); }
        VM_WAIT(); __syncthreads();
        swa::swa_phase<0, true>((char*)lds_raw + RING_OFF, WSP(bf16_t, O_QH), WSP(bf16_t, O_KV) + 4 * KVSZ, WSP(bf16_t, O_KV) + 5 * KVSZ, X, 512, 1 << 28, bx, G, wave, lane);
        if (BOTH(4)) GRID_BAR();
    }
    if (IN(6)) {
        PH_ARGS;
        pg8::Gemm g{WSP(bf16_t, O_CAT), WSP(bf16_t, O_W_OUTE), M, DM, DM, DM, DM}; pg8::StaticOrder S; S.init(M, DM, G, bx);
        pg8::EpiResid<true> E{ap->in[0], WSP(bf16_t, O_XB), DM, WSP(float, O_SSQP)};
        pg8::gemm_phase<pg8::EpiResid<true>, pg8::StaticOrder, true, true>(lds + RING_OFF, g, S, E, wave, lane);
        if (BOTH(6)) GRID_BAR();
    }
    for (int l = 0; l < 2; ++l) {
        if (l == 1) {
            if (IN(11)) {
                PH_ARGS;
                pg8::Gemm g{WSP(bf16_t, O_XB1), WSP(bf16_t, O_W_INO), M, 2 * GW, DM, DM, DM}; pg8::StaticOrder S; S.init(M, 2 * GW, G, bx);
                pg8::Unit u0; LAS float* tab = (LAS float*)(lds + ROWSC_OFF); int pm0 = -1;
                if (S.next(0, u0)) { pm0 = u0.pm; pg8::build_row_scale(tab, WSP(float, O_SSQP), pm0, tid); }
                LDS_WAIT(); __syncthreads();
                pg8::EpiGeluSplit E{WSP(bf16_t, O_U), WSP(bf16_t, O_V), GW, GW, WSP(float, O_VPART), pg8::RowScale{tab, pm0}};
                pg8::gemm_phase<pg8::EpiGeluSplit, pg8::StaticOrder, true, true>(lds + RING_OFF, g, S, E, wave, lane);
                if (BOTH(11)) GRID_BAR();
            }
            if (IN(12)) { PH_ARGS; const float* part = WSP(float, O_VPART); float* SUMS = WSP(float, O_CTL + O_VSUMS);
                for (int m = gw; m < M; m += NGW) { const f32x2* pr = (const f32x2*)(part + (size_t)m * 384) + lane; const f32x2 a = pr[0], b = pr[64], c = pr[128];
                    const float s1 = wave_sum((a[0] + b[0]) + c[0]), s2 = wave_sum((a[1] + b[1]) + c[1]); if (lane == 0) *(f32x2*)(SUMS + (size_t)m * 2) = (f32x2){s1, s2}; }
                if (BOTH(12)) GRID_BAR(); }
            if (IN(13)) {
                PH_ARGS;
                for (int task = vcu; task < 96 * 8; task += G) { const int pnl = 3 * (task & 31) + ((task >> 5) % 3), bq = (task >> 5) / 3;
                    gate_task(lds + RING_OFF, pnl / 6, pnl % 6, 8 * bq, 8, WSP(bf16_t, O_V), WSP(bf16_t, O_U), WSP(float, O_CTL + O_VSUMS), ap->in[14], ap->in[15], WSP(bf16_t, O_WM), ap->in[17], tid, wave, lane); }
                if (BOTH(13)) GRID_BAR();
            }
            if (IN(14)) {
                PH_ARGS;
                pg8::Gemm g{WSP(bf16_t, O_U), WSP(bf16_t, O_W_OUTO), M, DM, GW, GW, GW}; pg8::StaticOrder S; S.init(M, DM, G, bx);
                pg8::EpiResid<false> E{WSP(bf16_t, O_XB1), WSP(bf16_t, O_XB), DM, WSP(float, O_SSQP)};
                pg8::gemm_phase<pg8::EpiResid<false>, pg8::StaticOrder, true, true>(lds + RING_OFF, g, S, E, wave, lane);
                if (BOTH(14)) GRID_BAR();
            }
        }
        const int pb = 7 + 8 * l;
        if (IN(pb + 1)) {
            PH_ARGS;
            pg8::Gemm g{WSP(bf16_t, O_XB), (const bf16_t*)(ws + (l ? O_W_GU1 : O_W_GU0)), M, 2 * FF, DM, DM, DM}; pg8::StaticOrder S; S.init(M, 2 * FF, G, bx);
            pg8::Unit u0; LAS float* tab = (LAS float*)(lds + ROWSC_OFF); int pm0 = -1;
            if (S.next(0, u0)) { pm0 = u0.pm; pg8::build_row_scale(tab, WSP(float, O_SSQP), pm0, tid); }
            LDS_WAIT(); __syncthreads();
            pg8::EpiSwiGLU E{WSP(bf16_t, O_H), FF, pg8::RowScale{tab, pm0}};
            pg8::gemm_phase<pg8::EpiSwiGLU, pg8::StaticOrder, true, true>(lds + RING_OFF, g, S, E, wave, lane);
            if (l == 0) CONV_TAIL((M / 256) * (2 * FF / 256), NIT_T1, NIT_T8); else CONV_TAIL((M / 256) * (2 * FF / 256), NIT_T8, NITEMS);
            if (BOTH(pb + 1)) GRID_BAR();
        }
        if (IN(pb + 2)) {
            PH_ARGS;
            pg8::Gemm g{WSP(bf16_t, O_H), (const bf16_t*)(ws + (l ? O_W_DN1 : O_W_DN0)), M, DM, FF, FF, FF}; pg8::StaticOrder S; S.init(M, DM, G, bx);
            pg8::EpiResid<false> E{WSP(bf16_t, O_XB), WSP(bf16_t, O_XB1), DM, WSP(float, O_SSQP)};
            pg8::gemm_phase<pg8::EpiResid<false>, pg8::StaticOrder, true, true>(lds + RING_OFF, g, S, E, wave, lane);
            if (BOTH(pb + 2)) GRID_BAR();
        }
    }
    if (IN(18)) { PH_ARGS; const bf16_t* XB = WSP(bf16_t, O_XB1); const float* gn = ap->in[23]; float* out = ap->out; const float* pp = WSP(float, O_SSQP);
        for (int m = gw; m < M; m += NGW) { const float r = 1.0f / sqrtf(wave_sum(pp[(size_t)m * 64 + lane]) * (1.0f / DM) + EPS); const u32x2* xr = (const u32x2*)(XB + (size_t)m * DM) + lane; const f32x4* gr = (const f32x4*)gn + lane; f32x4* o = (f32x4*)(out + (size_t)m * DM) + lane;
#pragma unroll 8
            for (int j = 0; j < 16; ++j) { const u32x2 w = xr[64 * j]; o[64 * j] = (f32x4){bflo(w.x), bfhi(w.x), bflo(w.y), bfhi(w.y)} * r * gr[64 * j]; } } }
#undef IN
#undef BOTH
}

extern "C" void kernel_launch(void* const* d_in, const int* in_sizes, int n_in, void* d_out, int out_size, void* d_ws, size_t ws_size, hipStream_t stream) {
    static int grid = 0;
    if (grid == 0) {
        if (n_in != 24 || in_sizes[0] != M * DM || out_size != M * DM || ws_size < WS_END) {
            fprintf(stderr, "kernel_launch: built for 24 inputs, x/out of %d floats, >= %zu bytes of workspace; got n_in %d, in0 %d, out %d, ws %zu; nothing launched\n", M * DM, (size_t)WS_END, n_in, n_in > 0 ? in_sizes[0] : -1, out_size, ws_size);
            grid = -1; return; }
        int dev = 0, cus = 0;
        if (hipGetDevice(&dev) != hipSuccess || hipDeviceGetAttribute(&cus, hipDeviceAttributeMultiprocessorCount, dev) != hipSuccess) { fprintf(stderr, "kernel_launch: device query failed\n"); grid = -1; return; }
        if (hipFuncSetAttribute((const void*)fwd, hipFuncAttributeMaxDynamicSharedMemorySize, LDS_BYTES) != hipSuccess) { fprintf(stderr, "kernel_launch: hipFuncSetAttribute failed\n"); grid = -1; return; }
        int per_cu = 0;
        if (hipOccupancyMaxActiveBlocksPerMultiprocessor(&per_cu, (const void*)fwd, NWAVES * 64, LDS_BYTES) != hipSuccess || per_cu < 1) fprintf(stderr, "kernel_launch: note: occupancy query reports %d\n", per_cu);
        (void)hipGetLastError();
        if (cus != 256) { fprintf(stderr, "kernel_launch: built for a 256-CU device, found %d CUs; nothing launched\n", cus); grid = -1; return; }
        grid = cus;
    }
    if (grid < 0) return;
    (void)hipMemsetAsync((char*)d_ws + O_CTL, 0, CTL_ZERO_BYTES, stream);
    Args a{};
    for (int i = 0; i < 24; ++i) a.in[i] = (const float*)d_in[i];
    a.out = (float*)d_out; a.ws = (unsigned char*)d_ws; a.G = grid; a.pad = 0;
#if MK_ONE_LAUNCH
    a.ph_lo = 0; a.ph_hi = N_PHASES;
    hipLaunchKernelGGL(fwd, dim3(grid), dim3(NWAVES * 64), LDS_BYTES, stream, a);
#else
    for (int p = 0; p < N_PHASES; ++p) { a.ph_lo = p; a.ph_hi = p + 1; hipLaunchKernelGGL(fwd, dim3(grid), dim3(NWAVES * 64), LDS_BYTES, stream, a); }
#endif
}
```
